# Optimizing an MI355X kernel written in HIP

```python
import jax, jax.numpy as jnp
from jax import lax
import numpy as np


D_MODEL = 2048
BATCH = 4
SEQ = 4096
DEPTH = 4

D_MIX = D_MODEL
CHUNK = 128
SGU_WIDTH = D_MIX // 4
SGU_GROUPS = 4
SGU_GROUP_DIM = SGU_WIDTH // SGU_GROUPS
HGRN_WIDTH = D_MIX // 4
HGRN_HEADS = 4
HGRN_HEAD_DIM = HGRN_WIDTH // HGRN_HEADS
MLA_HEADS = 8
MLA_V_DIM = (D_MIX - SGU_WIDTH - HGRN_WIDTH) // MLA_HEADS
MLA_NOPE_DIM = 128
MLA_ROPE_DIM = 64
MLA_QK_DIM = MLA_NOPE_DIM + MLA_ROPE_DIM
Q_LORA_RANK = D_MODEL // 4
KV_LORA_RANK = D_MODEL // 4
ROPE_THETA = 10000.0
ATTN_BLOCK = 128
N_GROUPS = 4
EXPERTS_PER_GROUP = 8
N_EXPERTS = N_GROUPS * EXPERTS_PER_GROUP
TOP_K = 2
D_EXPERT = D_MODEL // 4
MOE_BLOCK = 128
NORM_EPS = 1e-5
DEEPNORM_ALPHA = (2 * DEPTH) ** 0.25
DEEPNORM_BETA = (8 * DEPTH) ** -0.25
IN_SPLITS = (SGU_WIDTH, SGU_WIDTH, HGRN_WIDTH, HGRN_WIDTH, HGRN_WIDTH, HGRN_WIDTH, Q_LORA_RANK, KV_LORA_RANK, MLA_ROPE_DIM)
D_IN = SGU_WIDTH * 2 + HGRN_WIDTH * 4 + Q_LORA_RANK + KV_LORA_RANK + MLA_ROPE_DIM

kernel_name = 'hybrid_sgu_hgrn2_mla_hmoe_deepnorm'


def _split_points():
    pts, acc = [], 0
    for w in IN_SPLITS[:-1]:
        acc += w
        pts.append(acc)
    return pts


def layer_norm(x, g, b):
    xf = x.astype(jnp.float32)
    mu = jnp.mean(xf, axis=-1, keepdims=True)
    var = jnp.mean(jnp.square(xf - mu), axis=-1, keepdims=True)
    return ((xf - mu) * lax.rsqrt(var + NORM_EPS) * g.astype(jnp.float32) + b.astype(jnp.float32)).astype(x.dtype)


def rms_norm(x, g):
    xf = x.astype(jnp.float32)
    ms = jnp.mean(jnp.square(xf), axis=-1, keepdims=True)
    return (xf * lax.rsqrt(ms + NORM_EPS) * g.astype(jnp.float32)).astype(x.dtype)


def rope_tables(positions):
    inv = 1.0 / (ROPE_THETA ** (jnp.arange(0, MLA_ROPE_DIM, 2, dtype=jnp.float32) / MLA_ROPE_DIM))
    ang = positions.astype(jnp.float32)[..., None] * inv
    return jnp.cos(ang), jnp.sin(ang)


def apply_rope(x, cos, sin):
    x1, x2 = jnp.split(x.astype(jnp.float32), 2, axis=-1)
    return jnp.concatenate([x1 * cos - x2 * sin, x2 * cos + x1 * sin], axis=-1).astype(x.dtype)


def chunked_spatial_gating(u, v, ln_g, ln_b, ws, bs):
    B, S, _ = u.shape
    nc = S // CHUNK
    v = layer_norm(v, ln_g, ln_b).reshape(B, nc, CHUNK, SGU_GROUPS, SGU_GROUP_DIM)
    causal = jnp.tril(jnp.ones((CHUNK, CHUNK), dtype=bool))
    ws = jnp.where(causal[None], ws, jnp.zeros_like(ws))
    mixed = jnp.einsum('gts,bcsgd->bctgd', ws, v) + bs.T[:, :, None]
    return u * mixed.reshape(B, S, SGU_WIDTH).astype(u.dtype)


def _to_chunks(t):
    B, S, H, D = t.shape
    return t.reshape(B, S // CHUNK, CHUNK, H, D).transpose(1, 0, 3, 2, 4)


def gated_chunk_recurrence(q, k, v, log_f):
    B, S, H, K = q.shape
    V = v.shape[-1]
    causal = jnp.tril(jnp.ones((CHUNK, CHUNK), dtype=bool))

    def step(state, inp):
        qc, kc, vc, gc = inp
        G = jnp.cumsum(gc, axis=2)
        diff = G[:, :, :, None, :] - G[:, :, None, :, :]
        decay = jnp.exp(jnp.where(causal[None, None, :, :, None], diff, -jnp.inf))
        A = jnp.einsum('bhtk,bhtsk,bhsk->bhts', qc, decay, kc)
        o = jnp.einsum('bhts,bhsv->bhtv', A, vc) + jnp.einsum('bhtk,bhkv->bhtv', qc * jnp.exp(G), state)
        G_last = G[:, :, -1:, :]
        new_state = jnp.exp(G_last[:, :, 0, :])[..., None] * state + jnp.einsum('bhsk,bhsv->bhkv', kc * jnp.exp(G_last - G), vc)
        return new_state, o

    init = jnp.zeros((B, H, K, V), jnp.float32)
    _, o = lax.scan(step, init, (_to_chunks(q), _to_chunks(k), _to_chunks(v), _to_chunks(log_f)))
    return o.transpose(1, 0, 3, 2, 4).reshape(B, S, H, V)


def hgrn2_mixer(q_in, f_in, i_in, g_in, lb, norm_g):
    B, S, _ = q_in.shape
    H, K = HGRN_HEADS, HGRN_HEAD_DIM
    q = jax.nn.silu(q_in.astype(jnp.float32))
    fx = f_in.astype(jnp.float32)
    lb = lb.astype(jnp.float32)
    log_f = jnp.logaddexp(jnp.log(lb), jnp.log1p(-lb) + jax.nn.log_sigmoid(fx))
    k = (1.0 - lb) * jax.nn.sigmoid(-fx)
    v = i_in.astype(jnp.float32)
    heads = lambda t: t.reshape(B, S, H, K)
    o = gated_chunk_recurrence(heads(q), heads(k), heads(v), heads(log_f))
    o = rms_norm(o, norm_g.reshape(H, K)).reshape(B, S, HGRN_WIDTH)
    return (o * jax.nn.silu(g_in.astype(jnp.float32))).astype(q_in.dtype)


def causal_block_attention(q, k, v):
    B, S, H, DQK = q.shape
    nq = S // ATTN_BLOCK
    scale = DQK ** -0.5
    qb = q.reshape(B, nq, ATTN_BLOCK, H, DQK).transpose(1, 0, 2, 3, 4)
    key_pos = jnp.arange(S)

    def one_block(args):
        q_blk, blk = args
        s = jnp.einsum('bqhd,bkhd->bhqk', q_blk, k).astype(jnp.float32) * scale
        q_pos = blk * ATTN_BLOCK + jnp.arange(ATTN_BLOCK)
        s = jnp.where(key_pos[None, :] <= q_pos[:, None], s, -jnp.inf)
        p = jax.nn.softmax(s, axis=-1).astype(v.dtype)
        return jnp.einsum('bhqk,bkhd->bqhd', p, v)

    o = lax.map(one_block, (qb, jnp.arange(nq)))
    return o.transpose(1, 0, 2, 3, 4).reshape(B, S, H, v.shape[-1])


def mla_mixer(c_q, c_kv, k_rope, qn_g, w_uq, kvn_g, w_ukv, cos, sin):
    B, S, _ = c_q.shape
    q = (rms_norm(c_q, qn_g) @ w_uq).reshape(B, S, MLA_HEADS, MLA_QK_DIM)
    q_nope, q_rope = q[..., :MLA_NOPE_DIM], q[..., MLA_NOPE_DIM:]
    q_rope = apply_rope(q_rope, cos[:, :, None, :], sin[:, :, None, :])
    kv = (rms_norm(c_kv, kvn_g) @ w_ukv).reshape(B, S, MLA_HEADS, MLA_NOPE_DIM + MLA_V_DIM)
    k_nope, v = kv[..., :MLA_NOPE_DIM], kv[..., MLA_NOPE_DIM:]
    k_rope = apply_rope(k_rope, cos, sin)
    q = jnp.concatenate([q_nope, q_rope], axis=-1)
    k = jnp.concatenate([k_nope, jnp.broadcast_to(k_rope[:, :, None, :], (B, S, MLA_HEADS, MLA_ROPE_DIM))], axis=-1)
    o = causal_block_attention(q, k, v)
    return o.reshape(B, S, MLA_HEADS * MLA_V_DIM)


def hierarchical_moe(x, wg_r, bg_r, we_r, be_r, w_gate, w_up, w_down):
    B, S, D = x.shape
    N = B * S
    xt = x.reshape(N, D)
    group_prob = jax.nn.softmax((xt @ wg_r + bg_r).astype(jnp.float32), axis=-1)
    g_val, g_idx = lax.top_k(group_prob, 1)
    exp_logits = (xt @ we_r + be_r).astype(jnp.float32).reshape(N, N_GROUPS, EXPERTS_PER_GROUP)
    in_group = exp_logits[jnp.arange(N), g_idx[:, 0]]
    e_val, e_idx = lax.top_k(in_group, TOP_K)
    gates = g_val * jax.nn.softmax(e_val, axis=-1)
    experts = g_idx * EXPERTS_PER_GROUP + e_idx
    NK = N * TOP_K
    flat_e = experts.reshape(NK)
    flat_tok = jnp.repeat(jnp.arange(N, dtype=jnp.int32), TOP_K)
    flat_g = gates.reshape(NK)
    order = jnp.argsort(flat_e)
    se = flat_e[order]
    counts = jnp.bincount(flat_e, length=N_EXPERTS)
    padded = ((counts + MOE_BLOCK - 1) // MOE_BLOCK) * MOE_BLOCK
    pad_end = jnp.cumsum(padded)
    pad_start = pad_end - padded
    raw_start = jnp.cumsum(counts) - counts
    dest = pad_start[se] + jnp.arange(NK) - raw_start[se]
    P = ((NK + MOE_BLOCK - 1) // MOE_BLOCK) * MOE_BLOCK + N_EXPERTS * MOE_BLOCK
    nb = P // MOE_BLOCK
    slot_tok = jnp.full((P,), N, dtype=jnp.int32).at[dest].set(flat_tok[order])
    slot_gate = jnp.zeros((P,), jnp.float32).at[dest].set(flat_g[order])
    blk_exp = jnp.minimum(jnp.searchsorted(pad_end, jnp.arange(nb) * MOE_BLOCK, side='right'), N_EXPERTS - 1)
    x_pad = jnp.concatenate([xt, jnp.zeros((1, D), xt.dtype)], axis=0)
    xs = x_pad[slot_tok].reshape(nb, MOE_BLOCK, D)

    def run_block(args):
        xb, e = args
        h = jax.nn.silu(xb @ w_gate[e]) * (xb @ w_up[e])
        return h @ w_down[e]

    ys = lax.map(run_block, (xs, blk_exp)).reshape(P, D)
    out = jnp.zeros((N + 1, D), x.dtype).at[slot_tok].add(ys * slot_gate[:, None].astype(ys.dtype))
    return out[:N].reshape(B, S, D)


def setup_inputs(seed: int = 0) -> dict:
    key = jax.random.key(seed)
    ks = jax.random.split(key, 26)
    f32 = jnp.float32
    L = DEPTH

    def nrm(k, shape, scale):
        return jax.random.normal(k, shape, f32) * scale

    x = nrm(ks[0], (BATCH, SEQ, D_MODEL), 1.0)
    offset = jax.random.randint(ks[1], (BATCH, 1), 0, 1024, dtype=jnp.int32)
    positions = offset + jnp.arange(SEQ, dtype=jnp.int32)[None, :]
    return {
        'x': x,
        'positions': positions,
        'w_in': nrm(ks[2], (L, D_MODEL, D_IN), D_MODEL ** -0.5),
        'sgu_ln_g': 1.0 + nrm(ks[3], (L, SGU_WIDTH), 0.02),
        'sgu_ln_b': nrm(ks[4], (L, SGU_WIDTH), 0.02),
        'sgu_ws': nrm(ks[5], (L, SGU_GROUPS, CHUNK, CHUNK), CHUNK ** -0.5),
        'sgu_b': 1.0 + nrm(ks[6], (L, SGU_GROUPS, CHUNK), 0.1),
        'hgrn_lb_logits': nrm(ks[7], (L, HGRN_WIDTH), 1.0),
        'hgrn_norm_g': 1.0 + nrm(ks[8], (L, HGRN_WIDTH), 0.02),
        'mla_qn_g': 1.0 + nrm(ks[9], (L, Q_LORA_RANK), 0.02),
        'mla_w_uq': nrm(ks[10], (L, Q_LORA_RANK, MLA_HEADS * MLA_QK_DIM), Q_LORA_RANK ** -0.5),
        'mla_kvn_g': 1.0 + nrm(ks[11], (L, KV_LORA_RANK), 0.02),
        'mla_w_ukv': nrm(ks[12], (L, KV_LORA_RANK, MLA_HEADS * (MLA_NOPE_DIM + MLA_V_DIM)), KV_LORA_RANK ** -0.5),
        'w_out': nrm(ks[13], (L, D_MIX, D_MODEL), DEEPNORM_BETA * D_MIX ** -0.5),
        'ln1_g': 1.0 + nrm(ks[14], (L, D_MODEL), 0.02),
        'ln1_b': nrm(ks[15], (L, D_MODEL), 0.02),
        'router_group_w': nrm(ks[16], (L, D_MODEL, N_GROUPS), D_MODEL ** -0.5),
        'router_group_b': nrm(ks[17], (L, N_GROUPS), 0.01),
        'router_expert_w': nrm(ks[18], (L, D_MODEL, N_EXPERTS), D_MODEL ** -0.5),
        'router_expert_b': nrm(ks[19], (L, N_EXPERTS), 0.01),
        'expert_w_gate': nrm(ks[20], (L, N_EXPERTS, D_MODEL, D_EXPERT), D_MODEL ** -0.5),
        'expert_w_up': nrm(ks[21], (L, N_EXPERTS, D_MODEL, D_EXPERT), DEEPNORM_BETA * D_MODEL ** -0.5),
        'expert_w_down': nrm(ks[22], (L, N_EXPERTS, D_EXPERT, D_MODEL), DEEPNORM_BETA * D_EXPERT ** -0.5),
        'ln2_g': 1.0 + nrm(ks[23], (L, D_MODEL), 0.02),
        'ln2_b': nrm(ks[24], (L, D_MODEL), 0.02),
    }


def reference(x, positions, w_in, sgu_ln_g, sgu_ln_b, sgu_ws, sgu_b, hgrn_lb_logits, hgrn_norm_g, mla_qn_g, mla_w_uq, mla_kvn_g, mla_w_ukv, w_out, ln1_g, ln1_b, router_group_w, router_group_b, router_expert_w, router_expert_b, expert_w_gate, expert_w_up, expert_w_down, ln2_g, ln2_b):
    cos, sin = rope_tables(positions)
    lb_cum = jnp.cumsum(jax.nn.softmax(hgrn_lb_logits.astype(jnp.float32), axis=0), axis=0)
    lower_bounds = lb_cum - lb_cum[0:1]
    split_points = _split_points()
    for l in range(DEPTH):
        h = x @ w_in[l]
        a_u, a_v, b_q, b_f, b_i, b_g, c_q, c_kv, c_kr = jnp.split(h, split_points, axis=-1)
        y_a = chunked_spatial_gating(jax.nn.gelu(a_u), jax.nn.gelu(a_v), sgu_ln_g[l], sgu_ln_b[l], sgu_ws[l], sgu_b[l])
        y_b = hgrn2_mixer(b_q, b_f, b_i, b_g, lower_bounds[l], hgrn_norm_g[l])
        y_c = mla_mixer(c_q, c_kv, c_kr, mla_qn_g[l], mla_w_uq[l], mla_kvn_g[l], mla_w_ukv[l], cos, sin)
        mix = jnp.concatenate([y_a, y_b.astype(y_a.dtype), y_c.astype(y_a.dtype)], axis=-1) @ w_out[l]
        x = layer_norm(DEEPNORM_ALPHA * x + mix, ln1_g[l], ln1_b[l])
        ffn = hierarchical_moe(x, router_group_w[l], router_group_b[l], router_expert_w[l], router_expert_b[l], expert_w_gate[l], expert_w_up[l], expert_w_down[l])
        x = layer_norm(DEEPNORM_ALPHA * x + ffn, ln2_g[l], ln2_b[l])
    return x
```

```cpp
#include <hip/hip_runtime.h>
#include <cstdio>
#include <cstdint>

#define DI __device__ __forceinline__
#define LAS __attribute__((address_space(3)))
typedef unsigned short bf16_t;
typedef short bf16x8 __attribute__((ext_vector_type(8)));
typedef short s16x4 __attribute__((ext_vector_type(4)));
typedef float f32x2 __attribute__((ext_vector_type(2)));
typedef float f32x4 __attribute__((ext_vector_type(4)));
typedef float f32x16 __attribute__((ext_vector_type(16)));
typedef unsigned u32x2 __attribute__((ext_vector_type(2)));
typedef unsigned u32x4 __attribute__((ext_vector_type(4)));
typedef __bf16 bf2_t __attribute__((ext_vector_type(2)));

constexpr int DM = 2048, BATCH = 4, SEQ = 4096, NT = BATCH * SEQ, DEPTH = 4;
constexpr int DIN = 4160, DIN_MAIN = 4096;
constexpr int NEXP = 32, DEXP = 512;
constexpr int MAXSLOT = 40960;
constexpr float ALPHA = 1.681792830507429f;
constexpr float EPS = 1e-5f;
constexpr float QSCALE = 0.07216878364870323f * 1.4426950408889634f;

constexpr size_t MiB = 1u << 20;
constexpr size_t al(size_t x) { return (x + MiB - 1) / MiB * MiB; }
constexpr size_t WS_CTL = 0, CTL_BYTES = 1 * MiB;
constexpr size_t WS_WIN = WS_CTL + CTL_BYTES;
constexpr size_t WS_WUQ = WS_WIN + al((size_t)DEPTH * DIN * DM * 2);
constexpr size_t WS_WUK = WS_WUQ + al((size_t)DEPTH * 1536 * 512 * 2);
constexpr size_t WS_WUV = WS_WUK + al((size_t)DEPTH * 1024 * 512 * 2);
constexpr size_t WS_WOUT = WS_WUV + al((size_t)DEPTH * 1024 * 512 * 2);
constexpr size_t WS_WGU = WS_WOUT + al((size_t)DEPTH * DM * DM * 2);
constexpr size_t WS_WD = WS_WGU + al((size_t)DEPTH * NEXP * 1024 * DM * 2);
constexpr size_t WS_SGUW = WS_WD + al((size_t)DEPTH * NEXP * DM * DEXP * 2);
constexpr size_t WS_ROUTW = WS_SGUW + al((size_t)DEPTH * 4 * 128 * 128 * 2);
constexpr size_t WS_ROUTC = WS_ROUTW + al((size_t)DEPTH * 48 * DM * 4);
constexpr size_t WS_LB = WS_ROUTC + MiB;
constexpr size_t WS_COS = WS_LB + MiB;
constexpr size_t WS_XB = WS_COS + al((size_t)NT * 64 * 4);
constexpr size_t WS_Y = WS_XB + al((size_t)NT * DM * 2);
constexpr size_t WS_X1B = WS_Y + al((size_t)NT * DM * 4);
constexpr size_t WS_HB = WS_X1B + al((size_t)NT * DM * 2);
constexpr size_t WS_LOGF = WS_HB + al((size_t)NT * 4096 * 2);
constexpr size_t WS_KR = WS_LOGF + al((size_t)NT * 512 * 4);
constexpr size_t WS_SSQ = WS_KR + al((size_t)NT * 64 * 2);
constexpr size_t WS_Q = WS_SSQ + al((size_t)NT * 16 * 4);
constexpr size_t WS_KN = WS_Q + al((size_t)NT * 1536 * 2);
constexpr size_t WS_VT = WS_KN + al((size_t)NT * 1024 * 2);
constexpr size_t WS_OH = WS_VT + al((size_t)NT * 1024 * 2);
constexpr size_t WS_CAT = WS_OH + al((size_t)NT * 512 * 4);
constexpr size_t WS_ROUTE = WS_CAT + al((size_t)NT * DM * 2);
constexpr size_t WS_TOK = WS_ROUTE + al((size_t)NT * 8 * 4);
constexpr size_t WS_HM = WS_TOK + al((size_t)NEXP * NT * 4);
constexpr size_t WS_YB = WS_HM + al((size_t)MAXSLOT * DEXP * 2);
constexpr size_t WS_END = WS_YB + al((size_t)MAXSLOT * DM * 2);

constexpr int CW_TMO = 0;
constexpr int CW_CNT = 1024;
constexpr int CW_BAR = 8192;

constexpr int LDS_BYTES = 147456;
constexpr int NTHR = 512;

DI unsigned pk2(float lo, float hi) { bf2_t b = __builtin_convertvector((f32x2){lo, hi}, bf2_t); return __builtin_bit_cast(unsigned, b); }
DI bf16_t f2bf(float f) { return (bf16_t)(pk2(f, 0.f) & 0xffffu); }
DI float bflo(unsigned u) { return __uint_as_float(u << 16); }
DI float bfhi(unsigned u) { return __uint_as_float(u & 0xffff0000u); }
DI float bf2f(bf16_t h) { return __uint_as_float((unsigned)h << 16); }
DI float wave_sum(float v) {
#pragma unroll
    for (int o = 1; o < 64; o <<= 1) v += __shfl_xor(v, o);
    return v;
}
DI float sigmoidf_(float x) { return 1.0f / (1.0f + __expf(-x)); }
DI float siluf_(float x) { return x / (1.0f + __expf(-x)); }
DI float geluf_(float x) { const float u = 1.5957691216057308f * (x + 0.044715f * x * x * x); return x / (1.0f + __expf(-u)); }

struct Params {
    const float* in[25];
    float* out;
    unsigned char* ws;
    int layer;
    int pad;
};

namespace g8 {
constexpr int BM = 256, BK = 64, HALF = 128, HTB = HALF * BK * 2, STAGE_BYTES = 8 * HTB, NXCD = 8, WGM = 8;
DI int lds_byte(int r, int c) { const int st = (r >> 4) * 2 + (c >> 5), rr = r & 15, cc = c & 31, ob = rr * 64 + cc * 2; return st * 1024 + (ob ^ (((ob >> 9) & 1) << 5)); }
DI void stage_rc(int b, int& R, int& C) { const int st = b / 1024, sb = b % 1024, swz = sb ^ (((sb >> 9) & 1) << 5); R = (st >> 1) * 16 + swz / 64; C = (st & 1) * 32 + (swz % 64) / 2; }
DI int perm32(int rho) { const int n = rho >> 4, i = rho & 15; return 8 * (i >> 2) + 4 * n + (i & 3); }

struct Unit { const char* a; const char* b; int pm, pn, x0, x1; };

struct StaticSched {
    const char* A; const char* Bt; int lda, ldb, nM, nN, nwg, G, c;
    DI void init(const void* A_, const void* Bt_, int M, int N, int lda_, int ldb_, int G_, int c_) { A = (const char*)A_; Bt = (const char*)Bt_; lda = lda_; ldb = ldb_; nM = M / BM; nN = N / BM; nwg = nM * nN; G = G_; c = c_; }
    DI bool next(int i, Unit& u) const {
        const long L = (long)i * G + c; if (L >= nwg) return false;
        int wgid = (int)L; { const int q = nwg / NXCD, r = nwg % NXCD, xcd = wgid % NXCD, off = wgid / NXCD; wgid = (xcd < r ? xcd * (q + 1) : r * (q + 1) + (xcd - r) * q) + off; }
        const int nig = WGM * nN, gid = wgid / nig, fm = gid * WGM, gsz = (nM - fm) < WGM ? (nM - fm) : WGM;
        u.pm = fm + ((wgid % nig) % gsz); u.pn = (wgid % nig) / gsz; u.x0 = 0; u.x1 = 0;
        u.a = A + (size_t)u.pm * BM * lda * 2; u.b = Bt + (size_t)u.pn * BM * ldb * 2; return true;
    }
    DI int tok(const Unit&, int) const { return 0; }
};

template <class Epi, class Sched, bool GATHER>
DI void gemm_phase(LAS unsigned char* lds, const int K, const int lda, const int ldb, const Sched& S, const Epi& E) {
    const int tid = threadIdx.x, wid = __builtin_amdgcn_readfirstlane(tid >> 6), lane = tid & 63, wr = wid >> 2, wc = wid & 3, fr = lane & 15, fq = lane >> 4;
    const int nt = K / BK;
    unsigned voffA[2], voffB[2]; int RA[2], CA[2];
#pragma unroll
    for (int i = 0; i < 2; ++i) { int R, C; stage_rc(tid * 16 + i * 8192, R, C); const int Rb = Epi::PERM ? ((R & ~31) + perm32(R & 31)) : R;
        voffA[i] = (unsigned)(R * lda + C) * 2u; voffB[i] = (unsigned)(Rb * ldb + C) * 2u; RA[i] = R; CA[i] = C; }
    const size_t kstep = (size_t)(BK * 2);
    const size_t hstepA = (size_t)HALF * lda * 2, hstep = (size_t)HALF * ldb * 2;
    const unsigned ldsw = (unsigned)wid * 1024u;
    const int aoff = lds_byte(wr * 64 + fr, fq * 8), boff = lds_byte(wc * 32 + fr, fq * 8);
    unsigned gC[2][2], gN[2][2], g2[2][2];
#define G8_SA(b, h) (((b) * 2 + (h)) * HTB)
#define G8_SB(b, h) ((4 + (b) * 2 + (h)) * HTB)
#define G8_DMA(bufoff, ptr, _i) __builtin_amdgcn_global_load_lds((const unsigned*)(ptr), (LAS unsigned*)(lds + (bufoff) + ldsw + (_i) * 8192), 16, 0, 0)
#define G8_STAGE_B(bufoff, gbase) do { _Pragma("unroll") for (int _i = 0; _i < 2; ++_i) G8_DMA(bufoff, (const char*)(gbase) + voffB[_i], _i); } while (0)
#define G8_STAGE_A(bufoff, gbase, h, GO) do { _Pragma("unroll") for (int _i = 0; _i < 2; ++_i) { \
        if constexpr (GATHER) G8_DMA(bufoff, (const char*)(gbase) + GO[h][_i], _i); else G8_DMA(bufoff, (const char*)(gbase) + (h) * hstepA + voffA[_i], _i); } } while (0)
#define G8_LDA(dst, b, h) do { _Pragma("unroll") for (int m = 0; m < 4; ++m) _Pragma("unroll") for (int k = 0; k < 2; ++k) dst[m][k] = *(const LAS bf16x8*)(lds + G8_SA(b, h) + aoff + m * 2048 + k * 1024); } while (0)
#define G8_LDB(dst, b, h) do { _Pragma("unroll") for (int n = 0; n < 2; ++n) _Pragma("unroll") for (int k = 0; k < 2; ++k) dst[n][k] = *(const LAS bf16x8*)(lds + G8_SB(b, h) + boff + n * 2048 + k * 1024); } while (0)
#define G8_MMA(ai, bj, At, Bt) do { __builtin_amdgcn_s_setprio(1); _Pragma("unroll") for (int m = 0; m < 4; ++m) _Pragma("unroll") for (int n = 0; n < 2; ++n) _Pragma("unroll") for (int k = 0; k < 2; ++k) \
        acc[ai][bj][m][n] = __builtin_amdgcn_mfma_f32_16x16x32_bf16(Bt[n][k], At[m][k], acc[ai][bj][m][n], 0, 0, 0); __builtin_amdgcn_s_setprio(0); } while (0)
#define G8_WAIT_V(n) asm volatile("s_waitcnt vmcnt(" #n ")" ::: "memory")
#define G8_WAIT_L(n) asm volatile("s_waitcnt lgkmcnt(" #n ")" ::: "memory")
#define G8_BAR __builtin_amdgcn_s_barrier()
#define G8_SCHED __builtin_amdgcn_sched_barrier(0)
#define G8_GOFF(dst, u) do { if constexpr (GATHER) { _Pragma("unroll") for (int _h = 0; _h < 2; ++_h) _Pragma("unroll") for (int _i = 0; _i < 2; ++_i) \
        dst[_h][_i] = (unsigned)(S.tok(u, _h * HALF + RA[_i]) * lda + CA[_i]) * 2u; } } while (0)
    Unit cur, nxt; int ui = 0;
    if (!S.next(0, cur)) return;
    f32x4 acc[2][2][4][2];
#pragma unroll
    for (int a = 0; a < 2; ++a)
#pragma unroll
        for (int b = 0; b < 2; ++b)
#pragma unroll
            for (int m = 0; m < 4; ++m)
#pragma unroll
                for (int n = 0; n < 2; ++n) acc[a][b][m][n] = (f32x4){0.f, 0.f, 0.f, 0.f};
    bf16x8 At[4][2], B0[2][2], B1[2][2];
    const char* cA = cur.a; const char* cB = cur.b;
#pragma unroll
    for (int h = 0; h < 2; ++h)
#pragma unroll
        for (int i = 0; i < 2; ++i) { gC[h][i] = 0u; gN[h][i] = 0u; g2[h][i] = 0u; }
    G8_GOFF(gC, cur);
    G8_STAGE_B(G8_SB(0, 0), cB); G8_STAGE_B(G8_SB(0, 1), cB + hstep); G8_STAGE_A(G8_SA(0, 0), cA, 0, gC); G8_STAGE_A(G8_SA(0, 1), cA, 1, gC);
    if (wr == 1) G8_BAR;
    G8_WAIT_V(2); G8_BAR;
    G8_STAGE_B(G8_SB(1, 0), cB + kstep); G8_STAGE_A(G8_SA(1, 0), cA + kstep, 0, gC); G8_STAGE_B(G8_SB(1, 1), cB + hstep + kstep);
    G8_WAIT_V(6); G8_BAR;
    for (;;) {
        const bool has_next = S.next(ui + 1, nxt);
        const char* nA = has_next ? nxt.a : cA; const char* nB = has_next ? nxt.b : cB;
        if constexpr (GATHER) { if (has_next) { G8_GOFF(gN, nxt); } else {
#pragma unroll
            for (int h = 0; h < 2; ++h)
#pragma unroll
                for (int i = 0; i < 2; ++i) gN[h][i] = gC[h][i]; } }
        for (int t = 0; t < nt; t += 2) {
            const bool last = (t == nt - 2);
            const char* a1 = cA + (size_t)(t + 1) * kstep;
            const char* a2 = last ? nA : cA + (size_t)(t + 2) * kstep; const char* b2 = last ? nB : cB + (size_t)(t + 2) * kstep;
            const char* a3 = a2 + kstep; const char* b3 = b2 + kstep;
            if constexpr (GATHER) {
#pragma unroll
                for (int h = 0; h < 2; ++h)
#pragma unroll
                    for (int i = 0; i < 2; ++i) g2[h][i] = last ? gN[h][i] : gC[h][i]; }
            G8_LDB(B0, 0, 0); G8_LDB(B1, 0, 1); G8_SCHED; G8_LDA(At, 0, 0); G8_STAGE_A(G8_SA(1, 1), a1, 1, gC);
            G8_WAIT_V(8); G8_WAIT_L(0); G8_BAR; G8_MMA(0, 0, At, B0); G8_MMA(0, 1, At, B1); G8_BAR; G8_SCHED;
            G8_LDA(At, 0, 1); G8_STAGE_B(G8_SB(0, 0), b2); G8_STAGE_B(G8_SB(0, 1), b2 + hstep); G8_STAGE_A(G8_SA(0, 0), a2, 0, g2);
            G8_WAIT_V(8); G8_WAIT_L(0); G8_BAR; G8_MMA(1, 0, At, B0); G8_MMA(1, 1, At, B1); G8_BAR; G8_SCHED;
            G8_LDB(B0, 1, 0); G8_LDB(B1, 1, 1); G8_SCHED; G8_LDA(At, 1, 0); G8_STAGE_A(G8_SA(0, 1), a2, 1, g2);
            G8_WAIT_V(8); G8_WAIT_L(0); G8_BAR; G8_MMA(0, 0, At, B0); G8_MMA(0, 1, At, B1); G8_BAR; G8_SCHED;
            G8_LDA(At, 1, 1); G8_STAGE_B(G8_SB(1, 0), b3); G8_STAGE_B(G8_SB(1, 1), b3 + hstep); G8_STAGE_A(G8_SA(1, 0), a3, 0, g2);
            G8_WAIT_V(8); G8_WAIT_L(0); G8_BAR; G8_MMA(1, 0, At, B0); G8_MMA(1, 1, At, B1); G8_BAR; G8_SCHED;
        }
        if (wr == 0) G8_BAR;
        E(acc, cur, wr, wc, fr, fq);
        if (!has_next) break;
#pragma unroll
        for (int a = 0; a < 2; ++a)
#pragma unroll
            for (int b = 0; b < 2; ++b)
#pragma unroll
                for (int m = 0; m < 4; ++m)
#pragma unroll
                    for (int n = 0; n < 2; ++n) acc[a][b][m][n] = (f32x4){0.f, 0.f, 0.f, 0.f};
        cur = nxt; cA = nA; cB = nB; ++ui;
        if constexpr (GATHER) {
#pragma unroll
            for (int h = 0; h < 2; ++h)
#pragma unroll
                for (int i = 0; i < 2; ++i) gC[h][i] = gN[h][i]; }
        if (wr == 1) G8_BAR;
    }
    G8_WAIT_V(0);
    G8_BAR;
#undef G8_SA
#undef G8_SB
#undef G8_DMA
#undef G8_STAGE_A
#undef G8_STAGE_B
#undef G8_LDA
#undef G8_LDB
#undef G8_MMA
#undef G8_WAIT_V
#undef G8_WAIT_L
#undef G8_BAR
#undef G8_SCHED
#undef G8_GOFF
}
}

enum { I_X = 0, I_POS, I_WIN, I_SGU_LNG, I_SGU_LNB, I_SGU_WS, I_SGU_B, I_LBLOG, I_HNORM, I_QNG, I_WUQ, I_KVNG, I_WUKV, I_WOUT, I_LN1G, I_LN1B,
       I_RGW, I_RGB, I_REW, I_REB, I_EWG, I_EWU, I_EWD, I_LN2G, I_LN2B };

enum { TK_WIN = 0, TK_WUQ, TK_WUKV, TK_WOUT, TK_GATE, TK_UP, TK_DOWN };
DI void transpose_item(const float* W, int K, int N, int kind, bf16_t* dst0, bf16_t* dst1, const float* sc, LAS float* scr, int item, int lane) {
    const int nblk = N / 32, kb = item / nblk, nb = item % nblk, k0 = 64 * kb, n0 = 32 * nb;
#pragma unroll 8
    for (int i = 0; i < 32; ++i) { const int kk = 2 * i + (lane >> 5); scr[kk * 33 + (lane & 31)] = W[(size_t)(k0 + kk) * N + n0 + (lane & 31)]; }
    asm volatile("s_waitcnt lgkmcnt(0)" ::: "memory");
    const int c = lane & 7;
    float s8[8];
#pragma unroll
    for (int i = 0; i < 8; ++i) s8[i] = sc ? sc[k0 + 8 * c + i] : 1.0f;
#pragma unroll
    for (int j = 0; j < 4; ++j) {
        const int nl = (lane >> 3) + 8 * j, n = n0 + nl; const LAS float* s = scr + (8 * c) * 33 + nl;
        u32x4 o; o.x = pk2(s[0 * 33] * s8[0], s[1 * 33] * s8[1]); o.y = pk2(s[2 * 33] * s8[2], s[3 * 33] * s8[3]); o.z = pk2(s[4 * 33] * s8[4], s[5 * 33] * s8[5]); o.w = pk2(s[6 * 33] * s8[6], s[7 * 33] * s8[7]);
        bf16_t* d = dst0; int row = n;
        if (kind == TK_WIN) { if (n >= 4096) { const int jj = n - 4096; row = 4096 + 2 * (jj & 31) + (jj >> 5); } }
        else if (kind == TK_WUQ) { const int h = n / 192, cc = n % 192; if (cc >= 128) { const int jj = cc - 128; row = h * 192 + 128 + 2 * (jj & 31) + (jj >> 5); } }
        else if (kind == TK_WUKV) { const int h = n >> 8, cc = n & 255; if (cc < 128) row = h * 128 + cc; else { d = dst1; row = h * 128 + cc - 128; } }
        else if (kind == TK_GATE) row = (n >> 7) * 256 + (n & 127);
        else if (kind == TK_UP) row = (n >> 7) * 256 + 128 + (n & 127);
        *(u32x4*)(d + (size_t)row * K + k0 + 8 * c) = o;
    }
    asm volatile("s_waitcnt lgkmcnt(0)" ::: "memory");
}

DI void phase_prologue(const Params& p, LAS unsigned char* lds, int bid, int G) {
    const int tid = threadIdx.x, lane = tid & 63, wave = tid >> 6;
    unsigned char* ws = p.ws;
    LAS float* scr = (LAS float*)(lds + wave * 16384);
    const int gw = bid * 8 + wave, NGW = G * 8;
    constexpr int IT_WIN = 32 * 130, IT_WUQ = 8 * 48, IT_WUKV = 8 * 64, IT_WOUT = 32 * 64, IT_E = 512, IT_LAYER = IT_WIN + IT_WUQ + IT_WUKV + IT_WOUT + NEXP * 3 * IT_E;
    for (int it = gw; it < DEPTH * IT_LAYER; it += NGW) {
        const int l = it / IT_LAYER; int r = it % IT_LAYER;
        if (r < IT_WIN) { transpose_item(p.in[I_WIN] + (size_t)l * DM * DIN, DM, DIN, TK_WIN, (bf16_t*)(ws + WS_WIN) + (size_t)l * DIN * DM, nullptr, nullptr, scr, r, lane); continue; } r -= IT_WIN;
        if (r < IT_WUQ) { transpose_item(p.in[I_WUQ] + (size_t)l * 512 * 1536, 512, 1536, TK_WUQ, (bf16_t*)(ws + WS_WUQ) + (size_t)l * 1536 * 512, nullptr, p.in[I_QNG] + l * 512, scr, r, lane); continue; } r -= IT_WUQ;
        if (r < IT_WUKV) { transpose_item(p.in[I_WUKV] + (size_t)l * 512 * 2048, 512, 2048, TK_WUKV, (bf16_t*)(ws + WS_WUK) + (size_t)l * 1024 * 512, (bf16_t*)(ws + WS_WUV) + (size_t)l * 1024 * 512, p.in[I_KVNG] + l * 512, scr, r, lane); continue; } r -= IT_WUKV;
        if (r < IT_WOUT) { transpose_item(p.in[I_WOUT] + (size_t)l * DM * DM, DM, DM, TK_WOUT, (bf16_t*)(ws + WS_WOUT) + (size_t)l * DM * DM, nullptr, nullptr, scr, r, lane); continue; } r -= IT_WOUT;
        const int e = r / (3 * IT_E), r2 = r % (3 * IT_E), ty = r2 / IT_E, r3 = r2 % IT_E; const size_t le = (size_t)l * NEXP + e;
        if (ty == 0) transpose_item(p.in[I_EWG] + le * DM * DEXP, DM, DEXP, TK_GATE, (bf16_t*)(ws + WS_WGU) + le * 1024 * DM, nullptr, nullptr, scr, r3, lane);
        else if (ty == 1) transpose_item(p.in[I_EWU] + le * DM * DEXP, DM, DEXP, TK_UP, (bf16_t*)(ws + WS_WGU) + le * 1024 * DM, nullptr, nullptr, scr, r3, lane);
        else transpose_item(p.in[I_EWD] + le * DEXP * DM, DEXP, DM, TK_DOWN, (bf16_t*)(ws + WS_WD) + le * DM * DEXP, nullptr, nullptr, scr, r3, lane);
    }
    const int gt = bid * NTHR + tid, NG = G * NTHR;
    {
        const f32x4* x4 = (const f32x4*)p.in[I_X]; u32x2* xb = (u32x2*)(ws + WS_XB);
        for (int i = gt; i < NT * DM / 4; i += NG) { const f32x4 v = x4[i]; xb[i] = (u32x2){pk2(v.x, v.y), pk2(v.z, v.w)}; }
    }
    {
        float* cs = (float*)(ws + WS_COS); const int* pos = (const int*)p.in[I_POS];
        for (int i = gt; i < NT * 32; i += NG) {
            const int tok = i >> 5, j = i & 31;
            const float inv = 1.0f / powf(10000.0f, (float)(2 * j) / 64.0f);
            const float ang = (float)pos[tok] * inv;
            const double a = (double)ang; const double k = rint(a * 0.15915494309189535); const double rr = a - k * 6.283185307179586476925;
            const float rf = (float)rr;
            cs[i] = cosf(rf); cs[NT * 32 + i] = sinf(rf);
        }
    }
    {
        float* lb = (float*)(ws + WS_LB); const float* lg = p.in[I_LBLOG];
        for (int c = gt; c < 512; c += NG) {
            float v[DEPTH], mx = -3.0e38f;
            for (int l = 0; l < DEPTH; ++l) { v[l] = lg[l * 512 + c]; mx = fmaxf(mx, v[l]); }
            float s = 0.f; for (int l = 0; l < DEPTH; ++l) { v[l] = expf(v[l] - mx); s += v[l]; }
            float cum = 0.f, first = 0.f;
            for (int l = 0; l < DEPTH; ++l) { cum += v[l] / s; if (l == 0) first = cum; lb[l * 512 + c] = cum - first; }
        }
    }
    {
        bf16_t* o = (bf16_t*)(ws + WS_SGUW); const float* w = p.in[I_SGU_WS];
        for (int i = gt; i < DEPTH * 4 * 128 * 128; i += NG) { const int s = i & 127, t = (i >> 7) & 127; o[i] = f2bf(s <= t ? w[i] : 0.f); }
    }
    {
        float* rw = (float*)(ws + WS_ROUTW);
        for (int i = gt; i < DEPTH * 48 * DM; i += NG) {
            const int k = i % DM, n = (i / DM) % 48, l = i / (DM * 48);
            float w = 0.f;
            if (n < 4) w = p.in[I_RGW][((size_t)l * DM + k) * 4 + n]; else if (n < 36) w = p.in[I_REW][((size_t)l * DM + k) * 32 + (n - 4)];
            rw[i] = w * p.in[I_LN1G][l * DM + k];
        }
        float* rc = (float*)(ws + WS_ROUTC);
        for (int it = gw; it < DEPTH * 48; it += NGW) {
            const int l = it / 48, n = it % 48; float s1 = 0.f, s0 = 0.f;
            if (n < 36) for (int k = lane; k < DM; k += 64) {
                const float w = (n < 4) ? p.in[I_RGW][((size_t)l * DM + k) * 4 + n] : p.in[I_REW][((size_t)l * DM + k) * 32 + (n - 4)];
                s1 += w * p.in[I_LN1G][l * DM + k]; s0 += w * p.in[I_LN1B][l * DM + k]; }
            s1 = wave_sum(s1); s0 = wave_sum(s0);
            if (lane == 0) { const float bias = (n < 4) ? p.in[I_RGB][l * 4 + n] : (n < 36 ? p.in[I_REB][l * 32 + n - 4] : 0.f); rc[(l * 2 + 0) * 48 + n] = s0 + bias; rc[(l * 2 + 1) * 48 + n] = s1; }
        }
    }
}

struct EpiInProj {
    static constexpr bool PERM = true;
    bf16_t* HB; float* LOGF; float* SSQ; const float* lb;
    template <int KIND> DI void run(const f32x4 (&acc)[2][2][4][2], const g8::Unit& u, int wr, int wc, int fr, int fq) const {
        const int row0 = u.pm * 256 + wr * 64 + fr, col0 = u.pn * 256 + wc * 32 + 8 * fq;
        float lbv[2][8];
        if constexpr (KIND == 2) {
#pragma unroll
            for (int bj = 0; bj < 2; ++bj)
#pragma unroll
                for (int i = 0; i < 8; ++i) lbv[bj][i] = lb[col0 - 1536 + bj * 128 + i];
        }
#pragma unroll
        for (int ai = 0; ai < 2; ++ai)
#pragma unroll
            for (int m = 0; m < 4; ++m) {
                const int row = row0 + ai * 128 + m * 16; float ssq = 0.f;
#pragma unroll
                for (int bj = 0; bj < 2; ++bj) {
                    float v[8];
#pragma unroll
                    for (int i = 0; i < 4; ++i) { v[i] = acc[ai][bj][m][0][i]; v[4 + i] = acc[ai][bj][m][1][i]; }
                    const int col = col0 + bj * 128;
                    if constexpr (KIND == 0) {
#pragma unroll
                        for (int i = 0; i < 8; ++i) v[i] = geluf_(v[i]);
                    } else if constexpr (KIND == 1) {
#pragma unroll
                        for (int i = 0; i < 8; ++i) v[i] = siluf_(v[i]);
                    } else if constexpr (KIND == 2) {
                        float lf[8];
#pragma unroll
                        for (int i = 0; i < 8; ++i) { const float e = __expf(v[i]); const float sg = e / (1.0f + e); const float l_ = lbv[bj][i];
                            const float f = l_ + (1.0f - l_) * (1.0f / (1.0f + __expf(-v[i])));
                            lf[i] = logf(f); v[i] = (1.0f - l_) / (1.0f + e); (void)sg; }
                        float* lp = LOGF + (size_t)row * 512 + (col - 1536);
                        *(f32x4*)lp = (f32x4){lf[0], lf[1], lf[2], lf[3]}; *(f32x4*)(lp + 4) = (f32x4){lf[4], lf[5], lf[6], lf[7]};
                    } else if constexpr (KIND == 4) {
#pragma unroll
                        for (int i = 0; i < 8; ++i) ssq += v[i] * v[i];
                    }
                    u32x4 w; w.x = pk2(v[0], v[1]); w.y = pk2(v[2], v[3]); w.z = pk2(v[4], v[5]); w.w = pk2(v[6], v[7]);
                    *(u32x4*)(HB + (size_t)row * 4096 + col) = w;
                }
                if constexpr (KIND == 4) {
                    ssq += __shfl_xor(ssq, 16); ssq += __shfl_xor(ssq, 32);
                    if (fq == 0) SSQ[(size_t)row * 16 + (u.pn - 12) * 4 + wc] = ssq;
                }
            }
    }
    DI void operator()(const f32x4 (&acc)[2][2][4][2], const g8::Unit& u, int wr, int wc, int fr, int fq) const {
        const int pn = u.pn;
        if (pn < 4) run<0>(acc, u, wr, wc, fr, fq);
        else if (pn < 6) run<1>(acc, u, wr, wc, fr, fq);
        else if (pn < 8) run<2>(acc, u, wr, wc, fr, fq);
        else if (pn < 10) run<3>(acc, u, wr, wc, fr, fq);
        else if (pn < 12) run<1>(acc, u, wr, wc, fr, fq);
        else run<4>(acc, u, wr, wc, fr, fq);
    }
};
DI void phase_inproj(const Params& p, LAS unsigned char* lds, int bid, int G, int l) {
    unsigned char* ws = p.ws;
    g8::StaticSched S; S.init(ws + WS_XB, (bf16_t*)(ws + WS_WIN) + (size_t)l * DIN * DM, NT, DIN_MAIN, DM, DM, G, bid);
    EpiInProj E{(bf16_t*)(ws + WS_HB), (float*)(ws + WS_LOGF), (float*)(ws + WS_SSQ), (const float*)(ws + WS_LB) + l * 512};
    g8::gemm_phase<EpiInProj, g8::StaticSched, false>(lds, DM, DM, DM, S, E);
}

DI void phase_krope(const Params& p, int bid, int G, int l) {
    unsigned char* ws = p.ws;
    const int tid = threadIdx.x, lane = tid & 63, wave = tid >> 6, fr = lane & 15, fq = lane >> 4;
    const bf16_t* X = (const bf16_t*)(ws + WS_XB); const bf16_t* W = (const bf16_t*)(ws + WS_WIN) + ((size_t)l * DIN + 4096) * DM;
    const float* cs = (const float*)(ws + WS_COS); bf16_t* KR = (bf16_t*)(ws + WS_KR);
    for (int task = bid * 8 + wave; task < NT / 16; task += G * 8) {
        const int r0 = task * 16;
        f32x4 acc[4];
#pragma unroll
        for (int n = 0; n < 4; ++n) acc[n] = (f32x4){0.f, 0.f, 0.f, 0.f};
        const bf16_t* ap = X + (size_t)(r0 + fr) * DM + 8 * fq;
        const bf16_t* bp = W + (size_t)fr * DM + 8 * fq;
#pragma unroll 4
        for (int s = 0; s < DM / 32; ++s) {
            const bf16x8 a = *(const bf16x8*)(ap + 32 * s);
#pragma unroll
            for (int n = 0; n < 4; ++n) { const bf16x8 b = *(const bf16x8*)(bp + (size_t)(16 * n) * DM + 32 * s); acc[n] = __builtin_amdgcn_mfma_f32_16x16x32_bf16(a, b, acc[n], 0, 0, 0); }
        }
#pragma unroll
        for (int n = 0; n < 4; ++n)
#pragma unroll
            for (int i = 0; i < 4; ++i) {
                const int row = r0 + 4 * fq + i, col = 16 * n + fr, j = col >> 1;
                const float v = acc[n][i], o = __shfl_xor(v, 1);
                const float c = cs[(size_t)row * 32 + j], s = cs[(size_t)NT * 32 + (size_t)row * 32 + j];
                const float y = (col & 1) ? (v * c + o * s) : (v * c - o * s);
                KR[(size_t)row * 64 + col] = f2bf(y);
            }
    }
}

DI void phase_sgu(const Params& p, LAS unsigned char* lds, int bid, int G, int l) {
    unsigned char* ws = p.ws;
    const int tid = threadIdx.x, lane = tid & 63, wave = tid >> 6, fr = lane & 15, fq = lane >> 4;
    const bf16_t* HB = (const bf16_t*)(ws + WS_HB); bf16_t* CAT = (bf16_t*)(ws + WS_CAT);
    const bf16_t* SW = (const bf16_t*)(ws + WS_SGUW) + (size_t)l * 4 * 128 * 128;
    const float* lng = p.in[I_SGU_LNG] + l * 512; const float* lnb = p.in[I_SGU_LNB] + l * 512; const float* sb = p.in[I_SGU_B] + l * 512;
    constexpr int TS = 272;
    LAS unsigned char* T = lds;
    for (int unit = bid; unit < 128 * 4; unit += G) {
        const int ci = unit >> 2, g = unit & 3, rbase = ci * 128;
        __syncthreads();
        for (int rr = 0; rr < 16; ++rr) {
            const int s = wave * 16 + rr, row = rbase + s;
            const u32x4 raw = *(const u32x4*)(HB + (size_t)row * 4096 + 512 + 8 * lane);
            float v[8] = {bflo(raw.x), bfhi(raw.x), bflo(raw.y), bfhi(raw.y), bflo(raw.z), bfhi(raw.z), bflo(raw.w), bfhi(raw.w)};
            float sm = 0.f;
#pragma unroll
            for (int i = 0; i < 8; ++i) sm += v[i];
            const float mean = wave_sum(sm) * (1.0f / 512.0f);
            float sq = 0.f;
#pragma unroll
            for (int i = 0; i < 8; ++i) { v[i] -= mean; sq += v[i] * v[i]; }
            const float rstd = 1.0f / sqrtf(wave_sum(sq) * (1.0f / 512.0f) + EPS);
            if ((lane >> 4) == g) {
#pragma unroll
                for (int i = 0; i < 8; ++i) { const int c = 8 * lane + i, d = c & 127; const float y = v[i] * rstd * lng[c] + lnb[c];
                    *(LAS bf16_t*)(T + d * TS + s * 2) = f2bf(y); }
            }
        }
        __syncthreads();
        f32x4 acc[8];
#pragma unroll
        for (int n = 0; n < 8; ++n) acc[n] = (f32x4){0.f, 0.f, 0.f, 0.f};
        const bf16_t* wp = SW + ((size_t)g * 128 + wave * 16 + fr) * 128 + 8 * fq;
        const int ksmax = wave >> 1;
        for (int ks = 0; ks <= ksmax; ++ks) {
            const bf16x8 a = *(const bf16x8*)(wp + 32 * ks);
#pragma unroll
            for (int n = 0; n < 8; ++n) { const bf16x8 b = *(const LAS bf16x8*)(T + (16 * n + fr) * TS + (32 * ks + 8 * fq) * 2); acc[n] = __builtin_amdgcn_mfma_f32_16x16x32_bf16(a, b, acc[n], 0, 0, 0); }
        }
#pragma unroll
        for (int i = 0; i < 4; ++i) {
            const int t = wave * 16 + 4 * fq + i, row = rbase + t; const float bias = sb[g * 128 + t];
#pragma unroll
            for (int n = 0; n < 8; ++n) { const int c = g * 128 + 16 * n + fr; const float uu = bf2f(HB[(size_t)row * 4096 + c]);
                CAT[(size_t)row * DM + c] = f2bf(uu * (acc[n][i] + bias)); }
        }
    }
}

DI void phase_hgrn_simple(const Params& p, LAS unsigned char* lds, int bid, int G, int l) {
    unsigned char* ws = p.ws;
    const int tid = threadIdx.x, vi = tid >> 5, kg = tid & 31;
    const bf16_t* HB = (const bf16_t*)(ws + WS_HB); const float* LOGF = (const float*)(ws + WS_LOGF); float* OH = (float*)(ws + WS_OH);
    LAS float* Lf = (LAS float*)lds;
    LAS float* Lk = Lf + 64 * 128;
    LAS float* Lq = Lk + 64 * 128;
    LAS float* Lv = Lq + 64 * 128;
    LAS float* Lo = Lv + 64 * 16;
    for (int unit = bid; unit < 16 * 8; unit += G) {
        const int bh = unit >> 3, vs = unit & 7, b = bh >> 2, h = bh & 3;
        float S[4] = {0.f, 0.f, 0.f, 0.f};
        for (int ch = 0; ch < SEQ / 64; ++ch) {
            const int row0 = b * SEQ + ch * 64;
            __syncthreads();
            for (int e = tid; e < 64 * 32; e += NTHR) {
                const int t = e >> 5, k4 = (e & 31) * 4; const size_t row = (size_t)(row0 + t);
                const f32x4 lf = *(const f32x4*)(LOGF + row * 512 + h * 128 + k4);
                *(LAS f32x4*)(Lf + t * 128 + k4) = (f32x4){__expf(lf.x), __expf(lf.y), __expf(lf.z), __expf(lf.w)};
                const u32x2 kr = *(const u32x2*)(HB + row * 4096 + 1536 + h * 128 + k4);
                *(LAS f32x4*)(Lk + t * 128 + k4) = (f32x4){bflo(kr.x), bfhi(kr.x), bflo(kr.y), bfhi(kr.y)};
                const u32x2 qr = *(const u32x2*)(HB + row * 4096 + 1024 + h * 128 + k4);
                *(LAS f32x4*)(Lq + t * 128 + k4) = (f32x4){bflo(qr.x), bfhi(qr.x), bflo(qr.y), bfhi(qr.y)};
            }
            for (int e = tid; e < 64 * 16; e += NTHR) { const int t = e >> 4, j = e & 15; Lv[e] = bf2f(HB[(size_t)(row0 + t) * 4096 + 2048 + h * 128 + vs * 16 + j]); }
            __syncthreads();
#pragma unroll 4
            for (int t = 0; t < 64; ++t) {
                const f32x4 f = *(const LAS f32x4*)(Lf + t * 128 + 4 * kg), kk = *(const LAS f32x4*)(Lk + t * 128 + 4 * kg), q = *(const LAS f32x4*)(Lq + t * 128 + 4 * kg);
                const float v = Lv[t * 16 + vi];
                S[0] = f.x * S[0] + kk.x * v; S[1] = f.y * S[1] + kk.y * v; S[2] = f.z * S[2] + kk.z * v; S[3] = f.w * S[3] + kk.w * v;
                float o = q.x * S[0] + q.y * S[1] + q.z * S[2] + q.w * S[3];
                o += __shfl_xor(o, 1); o += __shfl_xor(o, 2); o += __shfl_xor(o, 4); o += __shfl_xor(o, 8); o += __shfl_xor(o, 16);
                if (kg == 0) Lo[t * 16 + vi] = o;
            }
            __syncthreads();
            for (int e = tid; e < 64 * 16; e += NTHR) { const int t = e >> 4, j = e & 15; OH[(size_t)(row0 + t) * 512 + h * 128 + vs * 16 + j] = Lo[e]; }
        }
    }
}
DI void phase_hgrn_finish(const Params& p, int bid, int G, int l) {
    unsigned char* ws = p.ws;
    const int tid = threadIdx.x, lane = tid & 63, wave = tid >> 6;
    const float* OH = (const float*)(ws + WS_OH); const bf16_t* HB = (const bf16_t*)(ws + WS_HB); bf16_t* CAT = (bf16_t*)(ws + WS_CAT);
    const float* ng = p.in[I_HNORM] + l * 512;
    for (int row = bid * 8 + wave; row < NT; row += G * 8) {
        const f32x4 a = *(const f32x4*)(OH + (size_t)row * 512 + 8 * lane), b = *(const f32x4*)(OH + (size_t)row * 512 + 8 * lane + 4);
        float v[8] = {a.x, a.y, a.z, a.w, b.x, b.y, b.z, b.w};
        float sq = 0.f;
#pragma unroll
        for (int i = 0; i < 8; ++i) sq += v[i] * v[i];
        sq += __shfl_xor(sq, 1); sq += __shfl_xor(sq, 2); sq += __shfl_xor(sq, 4); sq += __shfl_xor(sq, 8);
        const float rstd = 1.0f / sqrtf(sq * (1.0f / 128.0f) + EPS);
        const u32x4 gr = *(const u32x4*)(HB + (size_t)row * 4096 + 2560 + 8 * lane);
        const float gs[8] = {bflo(gr.x), bfhi(gr.x), bflo(gr.y), bfhi(gr.y), bflo(gr.z), bfhi(gr.z), bflo(gr.w), bfhi(gr.w)};
        float y[8];
#pragma unroll
        for (int i = 0; i < 8; ++i) y[i] = v[i] * rstd * ng[8 * lane + i] * gs[i];
        u32x4 w; w.x = pk2(y[0], y[1]); w.y = pk2(y[2], y[3]); w.z = pk2(y[4], y[5]); w.w = pk2(y[6], y[7]);
        *(u32x4*)(CAT + (size_t)row * DM + 512 + 8 * lane) = w;
    }
}

DI float rstd_from_ssq(const float* SSQ, int row, int which) {
    const f32x4 a = *(const f32x4*)(SSQ + (size_t)row * 16 + which * 8), b = *(const f32x4*)(SSQ + (size_t)row * 16 + which * 8 + 4);
    const float s = (a.x + a.y) + (a.z + a.w) + (b.x + b.y) + (b.z + b.w);
    return 1.0f / sqrtf(s * (1.0f / 512.0f) + EPS);
}
struct EpiQ {
    static constexpr bool PERM = true;
    bf16_t* Q; const float* SSQ; const float* cs;
    DI void operator()(const f32x4 (&acc)[2][2][4][2], const g8::Unit& u, int wr, int wc, int fr, int fq) const {
        const int row0 = u.pm * 256 + wr * 64 + fr, col0 = u.pn * 256 + wc * 32 + 8 * fq;
#pragma unroll
        for (int ai = 0; ai < 2; ++ai)
#pragma unroll
            for (int m = 0; m < 4; ++m) {
                const int row = row0 + ai * 128 + m * 16; const float sc = rstd_from_ssq(SSQ, row, 0) * QSCALE;
#pragma unroll
                for (int bj = 0; bj < 2; ++bj) {
                    const int col = col0 + bj * 128, cc = col % 192;
                    float v[8];
#pragma unroll
                    for (int i = 0; i < 4; ++i) { v[i] = acc[ai][bj][m][0][i] * sc; v[4 + i] = acc[ai][bj][m][1][i] * sc; }
                    if (cc >= 128) {
                        const int j0 = (cc - 128) >> 1;
                        const f32x4 c = *(const f32x4*)(cs + (size_t)row * 32 + j0), s = *(const f32x4*)(cs + (size_t)NT * 32 + (size_t)row * 32 + j0);
#pragma unroll
                        for (int i = 0; i < 4; ++i) { const float x1 = v[2 * i], x2 = v[2 * i + 1]; v[2 * i] = x1 * c[i] - x2 * s[i]; v[2 * i + 1] = x2 * c[i] + x1 * s[i]; }
                    }
                    u32x4 w; w.x = pk2(v[0], v[1]); w.y = pk2(v[2], v[3]); w.z = pk2(v[4], v[5]); w.w = pk2(v[6], v[7]);
                    *(u32x4*)(Q + (size_t)row * 1536 + col) = w;
                }
            }
    }
};
struct EpiK {
    static constexpr bool PERM = true;
    bf16_t* KN; const float* SSQ;
    DI void operator()(const f32x4 (&acc)[2][2][4][2], const g8::Unit& u, int wr, int wc, int fr, int fq) const {
        const int row0 = u.pm * 256 + wr * 64 + fr, col0 = u.pn * 256 + wc * 32 + 8 * fq;
#pragma unroll
        for (int ai = 0; ai < 2; ++ai)
#pragma unroll
            for (int m = 0; m < 4; ++m) {
                const int row = row0 + ai * 128 + m * 16; const float sc = rstd_from_ssq(SSQ, row, 1);
#pragma unroll
                for (int bj = 0; bj < 2; ++bj) {
                    const f32x4 v0 = acc[ai][bj][m][0] * sc, v1 = acc[ai][bj][m][1] * sc;
                    u32x4 w; w.x = pk2(v0[0], v0[1]); w.y = pk2(v0[2], v0[3]); w.z = pk2(v1[0], v1[1]); w.w = pk2(v1[2], v1[3]);
                    *(u32x4*)(KN + (size_t)row * 1024 + col0 + bj * 128) = w;
                }
            }
    }
};
struct EpiVT {
    static constexpr bool PERM = true;
    bf16_t* VT; const float* SSQ;
    DI void operator()(const f32x4 (&acc)[2][2][4][2], const g8::Unit& u, int wr, int wc, int fr, int fq) const {
        const int row0 = u.pm * 256 + wr * 64 + fr, col0 = u.pn * 256 + wc * 32 + 8 * fq;
        float sc[2][8];
#pragma unroll
        for (int bj = 0; bj < 2; ++bj)
#pragma unroll
            for (int i = 0; i < 8; ++i) sc[bj][i] = rstd_from_ssq(SSQ, col0 + bj * 128 + i, 1);
#pragma unroll
        for (int ai = 0; ai < 2; ++ai)
#pragma unroll
            for (int m = 0; m < 4; ++m) {
                const int row = row0 + ai * 128 + m * 16, h = row >> 7, d = row & 127;
#pragma unroll
                for (int bj = 0; bj < 2; ++bj) {
                    const int tok = col0 + bj * 128, b = tok >> 12, s = tok & 4095;
                    const f32x4 a0 = acc[ai][bj][m][0], a1 = acc[ai][bj][m][1];
                    u32x4 w; w.x = pk2(a0[0] * sc[bj][0], a0[1] * sc[bj][1]); w.y = pk2(a0[2] * sc[bj][2], a0[3] * sc[bj][3]);
                    w.z = pk2(a1[0] * sc[bj][4], a1[1] * sc[bj][5]); w.w = pk2(a1[2] * sc[bj][6], a1[3] * sc[bj][7]);
                    *(u32x4*)(VT + ((size_t)((b * 8 + h) * 128 + d)) * SEQ + s) = w;
                }
            }
    }
};
DI void phase_mla_proj(const Params& p, LAS unsigned char* lds, int bid, int G, int l) {
    unsigned char* ws = p.ws;
    const float* SSQ = (const float*)(ws + WS_SSQ); const bf16_t* HB = (const bf16_t*)(ws + WS_HB);
    {
        g8::StaticSched S; S.init(HB + 3072, (const bf16_t*)(ws + WS_WUQ) + (size_t)l * 1536 * 512, NT, 1536, 4096, 512, G, bid);
        EpiQ E{(bf16_t*)(ws + WS_Q), SSQ, (const float*)(ws + WS_COS)};
        g8::gemm_phase<EpiQ, g8::StaticSched, false>(lds, 512, 4096, 512, S, E);
    }
    {
        g8::StaticSched S; S.init(HB + 3584, (const bf16_t*)(ws + WS_WUK) + (size_t)l * 1024 * 512, NT, 1024, 4096, 512, G, bid);
        EpiK E{(bf16_t*)(ws + WS_KN), SSQ};
        g8::gemm_phase<EpiK, g8::StaticSched, false>(lds, 512, 4096, 512, S, E);
    }
    {
        g8::StaticSched S; S.init((const bf16_t*)(ws + WS_WUV) + (size_t)l * 1024 * 512, HB + 3584, 1024, NT, 512, 4096, G, bid);
        EpiVT E{(bf16_t*)(ws + WS_VT), SSQ};
        g8::gemm_phase<EpiVT, g8::StaticSched, false>(lds, 512, 512, 4096, S, E);
    }
}

constexpr int AT_KS = 400, AT_VS = 144;
constexpr int AT_KBUF = 64 * AT_KS, AT_VBUF = 128 * AT_VS;
DI void attn_unit(const bf16_t* Qg, const bf16_t* KNg, const bf16_t* KRg, const bf16_t* VTg, bf16_t* CAT, LAS unsigned char* lds, int b, int h, int qb) {
    const int tid = threadIdx.x, lane = tid & 63, wave = __builtin_amdgcn_readfirstlane(tid >> 6), c = lane & 31, hi = lane >> 5;
    const int q0 = qb * 256, qmin = q0 + 32 * wave, qrow = qmin + c, ntile = 4 * (qb + 1), jmax = (qmin + 31) >> 6;
    LAS unsigned char* Kb = lds; LAS unsigned char* Vb = lds + 2 * AT_KBUF;
    bf16x8 qf[12];
    { const bf16_t* qp = Qg + (size_t)(b * SEQ + qrow) * 1536 + h * 192 + 8 * hi;
#pragma unroll
      for (int ks = 0; ks < 12; ++ks) qf[ks] = *(const bf16x8*)(qp + 16 * ks); }
    f32x16 o[4];
#pragma unroll
    for (int d = 0; d < 4; ++d)
#pragma unroll
        for (int r = 0; r < 16; ++r) o[d][r] = 0.f;
    float m_run = -1.0e30f, l_run = 0.f;
    int ksrc_off[3], kdst[3]; bool kfromR[3];
#pragma unroll
    for (int i = 0; i < 3; ++i) { const int id = tid + 512 * i, key = id / 24, cc = id % 24; kdst[i] = key * AT_KS + cc * 16; kfromR[i] = cc >= 16;
        ksrc_off[i] = kfromR[i] ? (key * 64 + 8 * (cc - 16)) : (key * 1024 + h * 128 + 8 * cc); }
    int vsrc_off[2], vdst[2];
#pragma unroll
    for (int i = 0; i < 2; ++i) { const int id = tid + 512 * i, d = id >> 3, cc = id & 7; vdst[i] = d * AT_VS + cc * 16; vsrc_off[i] = d * SEQ + 8 * cc; }
    const bf16_t* KNb = KNg + (size_t)b * SEQ * 1024; const bf16_t* KRb = KRg + (size_t)b * SEQ * 64; const bf16_t* VTb = VTg + (size_t)(b * 8 + h) * 128 * SEQ;
    u32x4 kreg[3], vreg[2];
#define AT_LOAD(j) do { _Pragma("unroll") for (int i = 0; i < 3; ++i) kreg[i] = kfromR[i] ? *(const u32x4*)(KRb + (size_t)(j) * 64 * 64 + ksrc_off[i]) : *(const u32x4*)(KNb + (size_t)(j) * 64 * 1024 + ksrc_off[i]); \
                        _Pragma("unroll") for (int i = 0; i < 2; ++i) vreg[i] = *(const u32x4*)(VTb + (size_t)(j) * 64 + vsrc_off[i]); } while (0)
#define AT_STORE(buf) do { _Pragma("unroll") for (int i = 0; i < 3; ++i) *(LAS u32x4*)(Kb + (buf) * AT_KBUF + kdst[i]) = kreg[i]; \
                           _Pragma("unroll") for (int i = 0; i < 2; ++i) *(LAS u32x4*)(Vb + (buf) * AT_VBUF + vdst[i]) = vreg[i]; } while (0)
    __syncthreads();
    AT_LOAD(0); AT_STORE(0);
    __syncthreads();
    for (int j = 0; j < ntile; ++j) {
        const int buf = j & 1;
        if (j + 1 < ntile) AT_LOAD(j + 1);
        if (j <= jmax) {
            const LAS unsigned char* kb_ = Kb + buf * AT_KBUF + c * AT_KS + 16 * hi;
            f32x16 s0, s1;
#pragma unroll
            for (int r = 0; r < 16; ++r) { s0[r] = 0.f; s1[r] = 0.f; }
#pragma unroll
            for (int ks = 0; ks < 12; ++ks) {
                const bf16x8 a0 = *(const LAS bf16x8*)(kb_ + 32 * ks), a1 = *(const LAS bf16x8*)(kb_ + 32 * AT_KS + 32 * ks);
                s0 = __builtin_amdgcn_mfma_f32_32x32x16_bf16(a0, qf[ks], s0, 0, 0, 0);
                s1 = __builtin_amdgcn_mfma_f32_32x32x16_bf16(a1, qf[ks], s1, 0, 0, 0);
            }
            if (64 * j + 63 > qmin) {
                const int dq = qrow - 64 * j - 4 * hi;
#pragma unroll
                for (int r = 0; r < 16; ++r) { const int kk = (r & 3) + 8 * (r >> 2);
                    if (kk > dq) s0[r] = -__builtin_inff();
                    if (kk + 32 > dq) s1[r] = -__builtin_inff(); }
            }
            float mx = s0[0];
#pragma unroll
            for (int r = 1; r < 16; ++r) mx = fmaxf(mx, s0[r]);
#pragma unroll
            for (int r = 0; r < 16; ++r) mx = fmaxf(mx, s1[r]);
            mx = fmaxf(mx, __shfl_xor(mx, 32));
            const float m_new = fmaxf(m_run, mx), alpha = __builtin_amdgcn_exp2f(m_run - m_new);
            m_run = m_new;
            float ps = 0.f;
#pragma unroll
            for (int r = 0; r < 16; ++r) { s0[r] = __builtin_amdgcn_exp2f(s0[r] - m_new); s1[r] = __builtin_amdgcn_exp2f(s1[r] - m_new); ps += s0[r] + s1[r]; }
            l_run = l_run * alpha + ps;
#pragma unroll
            for (int d = 0; d < 4; ++d)
#pragma unroll
                for (int r = 0; r < 16; ++r) o[d][r] *= alpha;
            bf16x8 pb[4];
#pragma unroll
            for (int s2 = 0; s2 < 2; ++s2) {
                u32x4 w0, w1;
                w0.x = pk2(s0[8 * s2 + 0], s0[8 * s2 + 1]); w0.y = pk2(s0[8 * s2 + 2], s0[8 * s2 + 3]); w0.z = pk2(s0[8 * s2 + 4], s0[8 * s2 + 5]); w0.w = pk2(s0[8 * s2 + 6], s0[8 * s2 + 7]);
                w1.x = pk2(s1[8 * s2 + 0], s1[8 * s2 + 1]); w1.y = pk2(s1[8 * s2 + 2], s1[8 * s2 + 3]); w1.z = pk2(s1[8 * s2 + 4], s1[8 * s2 + 5]); w1.w = pk2(s1[8 * s2 + 6], s1[8 * s2 + 7]);
                pb[s2] = __builtin_bit_cast(bf16x8, w0); pb[2 + s2] = __builtin_bit_cast(bf16x8, w1);
            }
            const LAS unsigned char* vb_ = Vb + buf * AT_VBUF + c * AT_VS + 8 * hi;
#pragma unroll
            for (int d = 0; d < 4; ++d)
#pragma unroll
                for (int kk = 0; kk < 4; ++kk) {
                    const LAS unsigned char* vp = vb_ + d * 32 * AT_VS + kk * 32;
                    const u32x2 lo = *(const LAS u32x2*)vp, hi2 = *(const LAS u32x2*)(vp + 16);
                    const u32x4 av = {lo.x, lo.y, hi2.x, hi2.y};
                    o[d] = __builtin_amdgcn_mfma_f32_32x32x16_bf16(__builtin_bit_cast(bf16x8, av), pb[kk], o[d], 0, 0, 0);
                }
        }
        if (j + 1 < ntile) AT_STORE(buf ^ 1);
        __syncthreads();
    }
#undef AT_LOAD
#undef AT_STORE
    const float l_tot = l_run + __shfl_xor(l_run, 32), inv = 1.0f / l_tot;
    bf16_t* op = CAT + (size_t)(b * SEQ + qrow) * DM + 1024 + h * 128 + 4 * hi;
#pragma unroll
    for (int d = 0; d < 4; ++d)
#pragma unroll
        for (int g = 0; g < 4; ++g) {
            const u32x2 w = {pk2(o[d][4 * g] * inv, o[d][4 * g + 1] * inv), pk2(o[d][4 * g + 2] * inv, o[d][4 * g + 3] * inv)};
            *(u32x2*)(op + 32 * d + 8 * g) = w;
        }
}
DI void phase_attn(const Params& p, LAS unsigned char* lds, int bid, int G) {
    unsigned char* ws = p.ws;
    const bf16_t* Q = (const bf16_t*)(ws + WS_Q); const bf16_t* KN = (const bf16_t*)(ws + WS_KN); const bf16_t* KR = (const bf16_t*)(ws + WS_KR); const bf16_t* VT = (const bf16_t*)(ws + WS_VT);
    bf16_t* CAT = (bf16_t*)(ws + WS_CAT);
    for (int it = bid; it < 256; it += G) {
        const int x = it & 7, y = it >> 3, bh = (x * 4 + (y >> 3)) & 31, pair = y & 7, b = bh >> 3, h = bh & 7;
        attn_unit(Q, KN, KR, VT, CAT, lds, b, h, 15 - pair);
        attn_unit(Q, KN, KR, VT, CAT, lds, b, h, pair);
    }
}

struct EpiOut {
    static constexpr bool PERM = false;
    const float* xres; float* Y;
    DI void operator()(const f32x4 (&acc)[2][2][4][2], const g8::Unit& u, int wr, int wc, int fr, int fq) const {
        const int row0 = u.pm * 256 + wr * 64 + fr, col0 = u.pn * 256 + wc * 32 + 4 * fq;
#pragma unroll
        for (int ai = 0; ai < 2; ++ai)
#pragma unroll
            for (int m = 0; m < 4; ++m) {
                const size_t rb = (size_t)(row0 + ai * 128 + m * 16) * DM;
#pragma unroll
                for (int bj = 0; bj < 2; ++bj)
#pragma unroll
                    for (int n = 0; n < 2; ++n) { const int col = col0 + bj * 128 + 16 * n; const f32x4 x = *(const f32x4*)(xres + rb + col); *(f32x4*)(Y + rb + col) = x * ALPHA + acc[ai][bj][m][n]; }
            }
    }
};
DI void phase_outproj(const Params& p, LAS unsigned char* lds, int bid, int G, int l) {
    unsigned char* ws = p.ws;
    g8::StaticSched S; S.init(ws + WS_CAT, (const bf16_t*)(ws + WS_WOUT) + (size_t)l * DM * DM, NT, DM, DM, DM, G, bid);
    EpiOut E{l == 0 ? p.in[I_X] : p.out, (float*)(ws + WS_Y)};
    g8::gemm_phase<EpiOut, g8::StaticSched, false>(lds, DM, DM, DM, S, E);
}

DI void phase_ln1_router(const Params& p, LAS unsigned char* lds, int bid, int G, int l) {
    unsigned char* ws = p.ws;
    const int tid = threadIdx.x, lane = tid & 63, wave = tid >> 6, fr = lane & 15, fq = lane >> 4;
    float* Y = (float*)(ws + WS_Y); bf16_t* X1B = (bf16_t*)(ws + WS_X1B);
    const float* RW = (const float*)(ws + WS_ROUTW) + (size_t)l * 48 * DM; const float* rc0 = (const float*)(ws + WS_ROUTC) + (l * 2 + 0) * 48; const float* rc1 = rc0 + 48;
    const float* g = p.in[I_LN1G] + l * DM; const float* bt = p.in[I_LN1B] + l * DM;
    unsigned* cnt = (unsigned*)(ws + WS_CTL) + CW_CNT + l * 32 * 16;
    int* TOK = (int*)(ws + WS_TOK); int* ROUTE = (int*)(ws + WS_ROUTE);
    LAS float* lg = (LAS float*)(lds + wave * 4096);
    for (int task = bid * 8 + wave; task < NT / 16; task += G * 8) {
        const int r0 = task * 16;
        float* yp = Y + (size_t)(r0 + fr) * DM + 4 * fq;
        const float* wp = RW + (size_t)fr * DM + 4 * fq;
        f32x4 acc[3]; float sm = 0.f, sq = 0.f;
#pragma unroll
        for (int n = 0; n < 3; ++n) acc[n] = (f32x4){0.f, 0.f, 0.f, 0.f};
#pragma unroll 2
        for (int s = 0; s < DM / 16; ++s) {
            const f32x4 xa = *(const f32x4*)(yp + 16 * s);
            sm += (xa.x + xa.y) + (xa.z + xa.w); sq += (xa.x * xa.x + xa.y * xa.y) + (xa.z * xa.z + xa.w * xa.w);
#pragma unroll
            for (int n = 0; n < 3; ++n) { const f32x4 wb = *(const f32x4*)(wp + (size_t)(16 * n) * DM + 16 * s);
#pragma unroll
                for (int i = 0; i < 4; ++i) acc[n] = __builtin_amdgcn_mfma_f32_16x16x4f32(xa[i], wb[i], acc[n], 0, 0, 0); }
        }
        sm += __shfl_xor(sm, 16); sm += __shfl_xor(sm, 32); sq += __shfl_xor(sq, 16); sq += __shfl_xor(sq, 32);
        const float mean = sm * (1.0f / DM), var = fmaxf(sq * (1.0f / DM) - mean * mean, 0.f), rstd = 1.0f / sqrtf(var + EPS);
#pragma unroll
        for (int i = 0; i < 4; ++i) {
            const float mr = __shfl(mean, 4 * fq + i), rs = __shfl(rstd, 4 * fq + i);
#pragma unroll
            for (int n = 0; n < 3; ++n) { const int col = 16 * n + fr; lg[(4 * fq + i) * 48 + col] = rs * (acc[n][i] - mr * rc1[col]) + rc0[col]; }
        }
        asm volatile("s_waitcnt lgkmcnt(0)" ::: "memory");
        if (lane < 16) {
            const LAS float* L = lg + lane * 48; const int token = r0 + lane;
            float gm = L[0]; int gi = 0;
#pragma unroll
            for (int j = 1; j < 4; ++j) if (L[j] > gm) { gm = L[j]; gi = j; }
            float gs = 0.f;
#pragma unroll
            for (int j = 0; j < 4; ++j) gs += expf(L[j] - gm);
            const float gval = 1.0f / gs;
            const LAS float* E = L + 4 + gi * 8;
            float v1 = E[0]; int i1 = 0;
#pragma unroll
            for (int j = 1; j < 8; ++j) if (E[j] > v1) { v1 = E[j]; i1 = j; }
            float v2 = -3.0e38f; int i2 = 0;
#pragma unroll
            for (int j = 0; j < 8; ++j) if (j != i1 && E[j] > v2) { v2 = E[j]; i2 = j; }
            const float ex = expf(v2 - v1), p1 = 1.0f / (1.0f + ex), p2 = ex / (1.0f + ex);
            const int e0 = gi * 8 + i1, e1 = gi * 8 + i2;
            const int pos0 = (int)atomicAdd(cnt + e0 * 16, 1u), pos1 = (int)atomicAdd(cnt + e1 * 16, 1u);
            TOK[(size_t)e0 * NT + pos0] = token; TOK[(size_t)e1 * NT + pos1] = token;
            int* rp = ROUTE + (size_t)token * 8;
            rp[0] = e0; rp[1] = pos0; rp[2] = e1; rp[3] = pos1; rp[4] = __float_as_int(gval * p1); rp[5] = __float_as_int(gval * p2);
        }
        bf16_t* xb = X1B + (size_t)(r0 + fr) * DM + 4 * fq;
#pragma unroll 4
        for (int s = 0; s < DM / 16; ++s) {
            const f32x4 xa = *(const f32x4*)(yp + 16 * s); const f32x4 gg = *(const f32x4*)(g + 16 * s + 4 * fq), bb = *(const f32x4*)(bt + 16 * s + 4 * fq);
            const f32x4 y = (xa - mean) * rstd * gg + bb;
            *(f32x4*)(yp + 16 * s) = y; *(u32x2*)(xb + 16 * s) = (u32x2){pk2(y.x, y.y), pk2(y.z, y.w)};
        }
        asm volatile("s_waitcnt lgkmcnt(0)" ::: "memory");
    }
}

constexpr int MOE_LDS_OFF = 131072;
DI void moe_tables(const Params& p, LAS unsigned char* lds, int l) {
    LAS int* mc = (LAS int*)(lds + MOE_LDS_OFF); LAS int* mp = mc + 32;
    __syncthreads();
    if (threadIdx.x == 0) {
        const unsigned* cnt = (const unsigned*)(p.ws + WS_CTL) + CW_CNT + l * 32 * 16; int acc = 0;
        for (int e = 0; e < 32; ++e) { int c = (int)__hip_atomic_load(cnt + e * 16, __ATOMIC_RELAXED, __HIP_MEMORY_SCOPE_AGENT); if (c > NT) c = NT; mc[e] = c; mp[e] = acc; acc += (c + 255) >> 8; }
        mp[32] = acc;
    }
    __syncthreads();
}
template <int NCT_SHIFT> struct MoeSched {
    const char* A; const char* Bt; const int* TOK; LAS const int* mc; LAS const int* mp; size_t bexp, btile, atile; int G, c;
    DI bool next(int i, g8::Unit& u) const {
        const int L = i * G + c, T = mp[32]; if (L >= (T << NCT_SHIFT)) return false;
        const int rt = L >> NCT_SHIFT, ct = L & ((1 << NCT_SHIFT) - 1); int e = 0;
        for (int j = 1; j < 32; ++j) if (mp[j] <= rt) e = j;
        u.pm = rt; u.pn = ct; u.x0 = e; u.x1 = rt - mp[e];
        u.a = A + (size_t)rt * atile; u.b = Bt + (size_t)e * bexp + (size_t)ct * btile; return true;
    }
    DI int tok(const g8::Unit& u, int R) const { const int idx = u.x1 * 256 + R; return idx < mc[u.x0] ? TOK[(size_t)u.x0 * NT + idx] : 0; }
};
struct EpiMoe1 {
    static constexpr bool PERM = true;
    bf16_t* HM;
    DI void operator()(const f32x4 (&acc)[2][2][4][2], const g8::Unit& u, int wr, int wc, int fr, int fq) const {
        const int row0 = u.pm * 256 + wr * 64 + fr, col0 = u.pn * 128 + wc * 32 + 8 * fq;
#pragma unroll
        for (int ai = 0; ai < 2; ++ai)
#pragma unroll
            for (int m = 0; m < 4; ++m) {
                float v[8];
#pragma unroll
                for (int i = 0; i < 4; ++i) { v[i] = siluf_(acc[ai][0][m][0][i]) * acc[ai][1][m][0][i]; v[4 + i] = siluf_(acc[ai][0][m][1][i]) * acc[ai][1][m][1][i]; }
                u32x4 w; w.x = pk2(v[0], v[1]); w.y = pk2(v[2], v[3]); w.z = pk2(v[4], v[5]); w.w = pk2(v[6], v[7]);
                *(u32x4*)(HM + (size_t)(row0 + ai * 128 + m * 16) * DEXP + col0) = w;
            }
    }
};
struct EpiMoe2 {
    static constexpr bool PERM = true;
    bf16_t* YB;
    DI void operator()(const f32x4 (&acc)[2][2][4][2], const g8::Unit& u, int wr, int wc, int fr, int fq) const {
        const int row0 = u.pm * 256 + wr * 64 + fr, col0 = u.pn * 256 + wc * 32 + 8 * fq;
#pragma unroll
        for (int ai = 0; ai < 2; ++ai)
#pragma unroll
            for (int m = 0; m < 4; ++m)
#pragma unroll
                for (int bj = 0; bj < 2; ++bj) {
                    const f32x4 v0 = acc[ai][bj][m][0], v1 = acc[ai][bj][m][1];
                    u32x4 w; w.x = pk2(v0[0], v0[1]); w.y = pk2(v0[2], v0[3]); w.z = pk2(v1[0], v1[1]); w.w = pk2(v1[2], v1[3]);
                    *(u32x4*)(YB + (size_t)(row0 + ai * 128 + m * 16) * DM + col0 + bj * 128) = w;
                }
    }
};
DI void phase_moe1(const Params& p, LAS unsigned char* lds, int bid, int G, int l) {
    unsigned char* ws = p.ws;
    moe_tables(p, lds, l);
    MoeSched<2> S{(const char*)(ws + WS_X1B), (const char*)(ws + WS_WGU) + (size_t)l * NEXP * 1024 * DM * 2, (const int*)(ws + WS_TOK), (LAS const int*)(lds + MOE_LDS_OFF), (LAS const int*)(lds + MOE_LDS_OFF) + 32,
                  (size_t)1024 * DM * 2, (size_t)256 * DM * 2, 0, G, bid};
    EpiMoe1 E{(bf16_t*)(ws + WS_HM)};
    g8::gemm_phase<EpiMoe1, MoeSched<2>, true>(lds, DM, DM, DM, S, E);
}
DI void phase_moe2(const Params& p, LAS unsigned char* lds, int bid, int G, int l) {
    unsigned char* ws = p.ws;
    moe_tables(p, lds, l);
    MoeSched<3> S{(const char*)(ws + WS_HM), (const char*)(ws + WS_WD) + (size_t)l * NEXP * DM * DEXP * 2, nullptr, (LAS const int*)(lds + MOE_LDS_OFF), (LAS const int*)(lds + MOE_LDS_OFF) + 32,
                  (size_t)DM * DEXP * 2, (size_t)256 * DEXP * 2, (size_t)256 * DEXP * 2, G, bid};
    EpiMoe2 E{(bf16_t*)(ws + WS_YB)};
    g8::gemm_phase<EpiMoe2, MoeSched<3>, false>(lds, DEXP, DEXP, DEXP, S, E);
}

DI void phase_ln2(const Params& p, LAS unsigned char* lds, int bid, int G, int l) {
    unsigned char* ws = p.ws;
    moe_tables(p, lds, l);
    LAS const int* mp = (LAS const int*)(lds + MOE_LDS_OFF) + 32;
    const int tid = threadIdx.x, lane = tid & 63, wave = tid >> 6;
    const float* X1 = (const float*)(ws + WS_Y); const bf16_t* YB = (const bf16_t*)(ws + WS_YB); const int* ROUTE = (const int*)(ws + WS_ROUTE);
    const float* g = p.in[I_LN2G] + l * DM; const float* bt = p.in[I_LN2B] + l * DM;
    float* out = p.out; bf16_t* XB = (bf16_t*)(ws + WS_XB);
    for (int row = bid * 8 + wave; row < NT; row += G * 8) {
        const int* rp = ROUTE + (size_t)row * 8;
        const int e0 = rp[0], pos0 = rp[1], e1 = rp[2], pos1 = rp[3]; const float g0 = __int_as_float(rp[4]), g1 = __int_as_float(rp[5]);
        const size_t s0 = (size_t)(256 * mp[e0] + pos0), s1 = (size_t)(256 * mp[e1] + pos1);
        f32x4 v[8]; float sm = 0.f;
#pragma unroll
        for (int j = 0; j < 8; ++j) {
            const int col = 4 * lane + 256 * j;
            const f32x4 x = *(const f32x4*)(X1 + (size_t)row * DM + col);
            const u32x2 a = *(const u32x2*)(YB + s0 * DM + col), b = *(const u32x2*)(YB + s1 * DM + col);
            const f32x4 ya = {bflo(a.x), bfhi(a.x), bflo(a.y), bfhi(a.y)}, yb = {bflo(b.x), bfhi(b.x), bflo(b.y), bfhi(b.y)};
            v[j] = x * ALPHA + (ya * g0 + yb * g1);
            sm += (v[j].x + v[j].y) + (v[j].z + v[j].w);
        }
        const float mean = wave_sum(sm) * (1.0f / DM); float sq = 0.f;
#pragma unroll
        for (int j = 0; j < 8; ++j) { v[j] = v[j] - mean; sq += (v[j].x * v[j].x + v[j].y * v[j].y) + (v[j].z * v[j].z + v[j].w * v[j].w); }
        const float rstd = 1.0f / sqrtf(wave_sum(sq) * (1.0f / DM) + EPS);
#pragma unroll
        for (int j = 0; j < 8; ++j) {
            const int col = 4 * lane + 256 * j;
            const f32x4 y = v[j] * rstd * *(const f32x4*)(g + col) + *(const f32x4*)(bt + col);
            *(f32x4*)(out + (size_t)row * DM + col) = y;
            *(u32x2*)(XB + (size_t)row * DM + col) = (u32x2){pk2(y.x, y.y), pk2(y.z, y.w)};
        }
    }
}

#define DEF_KERNEL(name, body) __global__ void __launch_bounds__(NTHR, 2) name(Params p) { \
    extern __shared__ __attribute__((aligned(16))) unsigned char lds_[]; LAS unsigned char* lds = (LAS unsigned char*)lds_; \
    const int bid = blockIdx.x, G = gridDim.x, l = p.layer; (void)lds; (void)bid; (void)G; (void)l; body; }
DEF_KERNEL(k_prologue, phase_prologue(p, lds, bid, G))
DEF_KERNEL(k_inproj, phase_inproj(p, lds, bid, G, l))
DEF_KERNEL(k_krope, phase_krope(p, bid, G, l))
DEF_KERNEL(k_sgu, phase_sgu(p, lds, bid, G, l))
DEF_KERNEL(k_hgrn, phase_hgrn_simple(p, lds, bid, G, l))
DEF_KERNEL(k_mla, phase_mla_proj(p, lds, bid, G, l))
DEF_KERNEL(k_attn, (phase_hgrn_finish(p, bid, G, l), phase_attn(p, lds, bid, G)))
DEF_KERNEL(k_outproj, phase_outproj(p, lds, bid, G, l))
DEF_KERNEL(k_ln1, phase_ln1_router(p, lds, bid, G, l))
DEF_KERNEL(k_moe1, phase_moe1(p, lds, bid, G, l))
DEF_KERNEL(k_moe2, phase_moe2(p, lds, bid, G, l))
DEF_KERNEL(k_ln2, phase_ln2(p, lds, bid, G, l))

extern "C" void kernel_launch(void* const* d_in, const int* in_sizes, int n_in, void* d_out, int out_size, void* d_ws, size_t ws_size, hipStream_t stream) {
    static int grid = 0;
    typedef void (*kfn)(Params);
    static const kfn all[] = {k_prologue, k_inproj, k_krope, k_sgu, k_hgrn, k_mla, k_attn, k_outproj, k_ln1, k_moe1, k_moe2, k_ln2};
    if (grid == 0) {
        if (n_in != 25 || out_size != NT * DM || ws_size < WS_END) { fprintf(stderr, "kernel_launch: unexpected sizes n_in %d out %d ws %zu (need %zu)\n", n_in, out_size, ws_size, (size_t)WS_END); grid = -1; return; }
        int dev = 0, cus = 0;
        if (hipGetDevice(&dev) != hipSuccess || hipDeviceGetAttribute(&cus, hipDeviceAttributeMultiprocessorCount, dev) != hipSuccess) { grid = -1; return; }
        for (kfn f : all) if (hipFuncSetAttribute((const void*)f, hipFuncAttributeMaxDynamicSharedMemorySize, LDS_BYTES) != hipSuccess) { fprintf(stderr, "kernel_launch: hipFuncSetAttribute failed\n"); grid = -1; return; }
        grid = cus;
    }
    if (grid < 0) return;
    (void)hipMemsetAsync((char*)d_ws + WS_CTL, 0, CTL_BYTES, stream);
    Params p{};
    for (int i = 0; i < 25; ++i) p.in[i] = (const float*)d_in[i];
    p.out = (float*)d_out; p.ws = (unsigned char*)d_ws; p.layer = 0; p.pad = 0;
    hipLaunchKernelGGL(k_prologue, dim3(grid), dim3(NTHR), LDS_BYTES, stream, p);
    for (int l = 0; l < DEPTH; ++l) {
        p.layer = l;
        hipLaunchKernelGGL(k_inproj, dim3(grid), dim3(NTHR), LDS_BYTES, stream, p);
        hipLaunchKernelGGL(k_krope, dim3(grid), dim3(NTHR), LDS_BYTES, stream, p);
        hipLaunchKernelGGL(k_sgu, dim3(grid), dim3(NTHR), LDS_BYTES, stream, p);
        hipLaunchKernelGGL(k_hgrn, dim3(grid), dim3(NTHR), LDS_BYTES, stream, p);
        hipLaunchKernelGGL(k_mla, dim3(grid), dim3(NTHR), LDS_BYTES, stream, p);
        hipLaunchKernelGGL(k_attn, dim3(grid), dim3(NTHR), LDS_BYTES, stream, p);
        hipLaunchKernelGGL(k_outproj, dim3(grid), dim3(NTHR), LDS_BYTES, stream, p);
        hipLaunchKernelGGL(k_ln1, dim3(grid), dim3(NTHR), LDS_BYTES, stream, p);
        hipLaunchKernelGGL(k_moe1, dim3(grid), dim3(NTHR), LDS_BYTES, stream, p);
        hipLaunchKernelGGL(k_moe2, dim3(grid), dim3(NTHR), LDS_BYTES, stream, p);
        hipLaunchKernelGGL(k_ln2, dim3(grid), dim3(NTHR), LDS_BYTES, stream, p);
    }
}
```

```cpp
#include <hip/hip_runtime.h>
#include <cstdio>
#include <cstdint>

#define DI __device__ __forceinline__
#define LAS __attribute__((address_space(3)))
typedef unsigned short bf16_t;
typedef short bf16x8 __attribute__((ext_vector_type(8)));
typedef short s16x4 __attribute__((ext_vector_type(4)));
typedef float f32x2 __attribute__((ext_vector_type(2)));
typedef float f32x4 __attribute__((ext_vector_type(4)));
typedef float f32x16 __attribute__((ext_vector_type(16)));
typedef unsigned u32x2 __attribute__((ext_vector_type(2)));
typedef unsigned u32x4 __attribute__((ext_vector_type(4)));
typedef __bf16 bf2_t __attribute__((ext_vector_type(2)));

constexpr int DM = 2048, BATCH = 4, SEQ = 4096, NT = BATCH * SEQ, DEPTH = 4;
constexpr int DIN = 4160, DIN_MAIN = 4096;
constexpr int NEXP = 32, DEXP = 512;
constexpr int MAXSLOT = 40960;
constexpr float ALPHA = 1.681792830507429f;
constexpr float EPS = 1e-5f;
constexpr float QSCALE = 0.07216878364870323f * 1.4426950408889634f;

constexpr size_t MiB = 1u << 20;
constexpr size_t al(size_t x) { return (x + MiB - 1) / MiB * MiB; }
constexpr size_t WS_CTL = 0, CTL_BYTES = 1 * MiB;
constexpr size_t WS_WIN = WS_CTL + CTL_BYTES;
constexpr size_t WS_WUQ = WS_WIN + al((size_t)DEPTH * DIN * DM * 2);
constexpr size_t WS_WUK = WS_WUQ + al((size_t)DEPTH * 1536 * 512 * 2);
constexpr size_t WS_WUV = WS_WUK + al((size_t)DEPTH * 1024 * 512 * 2);
constexpr size_t WS_WOUT = WS_WUV + al((size_t)DEPTH * 1024 * 512 * 2);
constexpr size_t WS_WGU = WS_WOUT + al((size_t)DEPTH * DM * DM * 2);
constexpr size_t WS_WD = WS_WGU + al((size_t)DEPTH * NEXP * 1024 * DM * 2);
constexpr size_t WS_SGUW = WS_WD + al((size_t)DEPTH * NEXP * DM * DEXP * 2);
constexpr size_t WS_ROUTW = WS_SGUW + al((size_t)DEPTH * 4 * 128 * 128 * 2);
constexpr size_t WS_ROUTC = WS_ROUTW + al((size_t)DEPTH * 48 * DM * 4);
constexpr size_t WS_LB = WS_ROUTC + MiB;
constexpr size_t WS_COS = WS_LB + MiB;
constexpr size_t WS_XB = WS_COS + al((size_t)NT * 64 * 4);
constexpr size_t WS_Y = WS_XB + al((size_t)NT * DM * 2);
constexpr size_t WS_X1B = WS_Y + al((size_t)NT * DM * 4);
constexpr size_t WS_HB = WS_X1B + al((size_t)NT * DM * 2);
constexpr size_t WS_LOGF = WS_HB + al((size_t)NT * 4096 * 2);
constexpr size_t WS_KR = WS_LOGF + al((size_t)NT * 512 * 4);
constexpr size_t WS_SSQ = WS_KR + al((size_t)NT * 64 * 2);
constexpr size_t WS_Q = WS_SSQ + al((size_t)NT * 16 * 4);
constexpr size_t WS_KN = WS_Q + al((size_t)NT * 1536 * 2);
constexpr size_t WS_VT = WS_KN + al((size_t)NT * 1024 * 2);
constexpr size_t WS_OH = WS_VT + al((size_t)NT * 1024 * 2);
constexpr size_t WS_CAT = WS_OH + al((size_t)NT * 512 * 4);
constexpr size_t WS_ROUTE = WS_CAT + al((size_t)NT * DM * 2);
constexpr size_t WS_TOK = WS_ROUTE + al((size_t)NT * 8 * 4);
constexpr size_t WS_HM = WS_TOK + al((size_t)NEXP * NT * 4);
constexpr size_t WS_YB = WS_HM + al((size_t)MAXSLOT * DEXP * 2);
constexpr size_t WS_END = WS_YB + al((size_t)MAXSLOT * DM * 2);

constexpr int CW_TMO = 0;
constexpr int CW_CNT = 1024;
constexpr int CW_BAR = 8192;

constexpr int LDS_BYTES = 147456;
constexpr int NTHR = 512;

DI unsigned pk2(float lo, float hi) { bf2_t b = __builtin_convertvector((f32x2){lo, hi}, bf2_t); return __builtin_bit_cast(unsigned, b); }
DI bf16_t f2bf(float f) { return (bf16_t)(pk2(f, 0.f) & 0xffffu); }
DI float bflo(unsigned u) { return __uint_as_float(u << 16); }
DI float bfhi(unsigned u) { return __uint_as_float(u & 0xffff0000u); }
DI float bf2f(bf16_t h) { return __uint_as_float((unsigned)h << 16); }
DI float wave_sum(float v) {
#pragma unroll
    for (int o = 1; o < 64; o <<= 1) v += __shfl_xor(v, o);
    return v;
}
DI int otid() { int t = (int)threadIdx.x; asm volatile("" : "+v"(t)); return t; }
DI float sigmoidf_(float x) { return 1.0f / (1.0f + __expf(-x)); }
DI float siluf_(float x) { return x / (1.0f + __expf(-x)); }
DI float geluf_(float x) { const float u = 1.5957691216057308f * (x + 0.044715f * x * x * x); return x / (1.0f + __expf(-u)); }

struct Params {
    const float* in[25];
    float* out;
    unsigned char* ws;
    int layer;
    int pad;
};
DI unsigned char* ows(const Params& p) { unsigned char* w = p.ws; asm volatile("" : "+s"(w)); return w; }

namespace g8 {
constexpr int BM = 256, BK = 64, HALF = 128, HTB = HALF * BK * 2, STAGE_BYTES = 8 * HTB, NXCD = 8, WGM = 8;
DI int lds_byte(int r, int c) { const int st = (r >> 4) * 2 + (c >> 5), rr = r & 15, cc = c & 31, ob = rr * 64 + cc * 2; return st * 1024 + (ob ^ (((ob >> 9) & 1) << 5)); }
DI void stage_rc(int b, int& R, int& C) { const int st = b / 1024, sb = b % 1024, swz = sb ^ (((sb >> 9) & 1) << 5); R = (st >> 1) * 16 + swz / 64; C = (st & 1) * 32 + (swz % 64) / 2; }
DI int perm32(int rho) { const int n = rho >> 4, i = rho & 15; return 8 * (i >> 2) + 4 * n + (i & 3); }

struct Unit { const char* a; const char* b; int pm, pn, x0, x1; };

struct StaticSched {
    const char* A; const char* Bt; int lda, ldb, nM, nN, nwg, G, c;
    DI void init(const void* A_, const void* Bt_, int M, int N, int lda_, int ldb_, int G_, int c_) { A = (const char*)A_; Bt = (const char*)Bt_; lda = lda_; ldb = ldb_; nM = M / BM; nN = N / BM; nwg = nM * nN; G = G_; c = c_; }
    DI bool next(int i, Unit& u) const {
        const long L = (long)i * G + c; if (L >= nwg) return false;
        int wgid = (int)L; { const int q = nwg / NXCD, r = nwg % NXCD, xcd = wgid % NXCD, off = wgid / NXCD; wgid = (xcd < r ? xcd * (q + 1) : r * (q + 1) + (xcd - r) * q) + off; }
        const int nig = WGM * nN, gid = wgid / nig, fm = gid * WGM, gsz = (nM - fm) < WGM ? (nM - fm) : WGM;
        u.pm = fm + ((wgid % nig) % gsz); u.pn = (wgid % nig) / gsz; u.x0 = 0; u.x1 = 0;
        u.a = A + (size_t)u.pm * BM * lda * 2; u.b = Bt + (size_t)u.pn * BM * ldb * 2; return true;
    }
    DI int tok(const Unit&, int) const { return 0; }
};

template <class Epi, class Sched, bool GATHER>
DI void gemm_phase(LAS unsigned char* lds, const int K, const int lda, const int ldb, const Sched& S, const Epi& E) {
    const int tid = otid(), wid = __builtin_amdgcn_readfirstlane(tid >> 6), lane = tid & 63, wr = wid >> 2, wc = wid & 3, fr = lane & 15, fq = lane >> 4;
    const int nt = K / BK;
    unsigned voffA[2], voffB[2]; int RA[2], CA[2];
#pragma unroll
    for (int i = 0; i < 2; ++i) { int R, C; stage_rc(tid * 16 + i * 8192, R, C); const int Rb = Epi::PERM ? ((R & ~31) + perm32(R & 31)) : R;
        voffA[i] = (unsigned)(R * lda + C) * 2u; voffB[i] = (unsigned)(Rb * ldb + C) * 2u; RA[i] = R; CA[i] = C; }
    const size_t kstep = (size_t)(BK * 2);
    const size_t hstepA = (size_t)HALF * lda * 2, hstep = (size_t)HALF * ldb * 2;
    const unsigned ldsw = (unsigned)wid * 1024u;
    const int aoff = lds_byte(wr * 64 + fr, fq * 8), boff = lds_byte(wc * 32 + fr, fq * 8);
    unsigned gC[2][2], gN[2][2], g2[2][2];
#define G8_SA(b, h) (((b) * 2 + (h)) * HTB)
#define G8_SB(b, h) ((4 + (b) * 2 + (h)) * HTB)
#define G8_DMA(bufoff, ptr, _i) __builtin_amdgcn_global_load_lds((const unsigned*)(ptr), (LAS unsigned*)(lds + (bufoff) + ldsw + (_i) * 8192), 16, 0, 0)
#define G8_STAGE_B(bufoff, gbase) do { _Pragma("unroll") for (int _i = 0; _i < 2; ++_i) G8_DMA(bufoff, (const char*)(gbase) + voffB[_i], _i); } while (0)
#define G8_STAGE_A(bufoff, gbase, h, GO) do { _Pragma("unroll") for (int _i = 0; _i < 2; ++_i) { \
        if constexpr (GATHER) G8_DMA(bufoff, (const char*)(gbase) + GO[h][_i], _i); else G8_DMA(bufoff, (const char*)(gbase) + (h) * hstepA + voffA[_i], _i); } } while (0)
#define G8_LDA(dst, b, h) do { _Pragma("unroll") for (int m = 0; m < 4; ++m) _Pragma("unroll") for (int k = 0; k < 2; ++k) dst[m][k] = *(const LAS bf16x8*)(lds + G8_SA(b, h) + aoff + m * 2048 + k * 1024); } while (0)
#define G8_LDB(dst, b, h) do { _Pragma("unroll") for (int n = 0; n < 2; ++n) _Pragma("unroll") for (int k = 0; k < 2; ++k) dst[n][k] = *(const LAS bf16x8*)(lds + G8_SB(b, h) + boff + n * 2048 + k * 1024); } while (0)
#define G8_MMA(ai, bj, At, Bt) do { __builtin_amdgcn_s_setprio(1); _Pragma("unroll") for (int m = 0; m < 4; ++m) _Pragma("unroll") for (int n = 0; n < 2; ++n) _Pragma("unroll") for (int k = 0; k < 2; ++k) \
        acc[ai][bj][m][n] = __builtin_amdgcn_mfma_f32_16x16x32_bf16(Bt[n][k], At[m][k], acc[ai][bj][m][n], 0, 0, 0); __builtin_amdgcn_s_setprio(0); } while (0)
#define G8_WAIT_V(n) asm volatile("s_waitcnt vmcnt(" #n ")" ::: "memory")
#define G8_WAIT_L(n) asm volatile("s_waitcnt lgkmcnt(" #n ")" ::: "memory")
#define G8_BAR __builtin_amdgcn_s_barrier()
#define G8_SCHED __builtin_amdgcn_sched_barrier(0)
#define G8_GOFF(dst, u) do { if constexpr (GATHER) { _Pragma("unroll") for (int _h = 0; _h < 2; ++_h) _Pragma("unroll") for (int _i = 0; _i < 2; ++_i) \
        dst[_h][_i] = (unsigned)(S.tok(u, _h * HALF + RA[_i]) * lda + CA[_i]) * 2u; } } while (0)
    Unit cur, nxt; int ui = 0;
    if (!S.next(0, cur)) return;
    f32x4 acc[2][2][4][2];
#pragma unroll
    for (int a = 0; a < 2; ++a)
#pragma unroll
        for (int b = 0; b < 2; ++b)
#pragma unroll
            for (int m = 0; m < 4; ++m)
#pragma unroll
                for (int n = 0; n < 2; ++n) acc[a][b][m][n] = (f32x4){0.f, 0.f, 0.f, 0.f};
    bf16x8 At[4][2], B0[2][2], B1[2][2];
    const char* cA = cur.a; const char* cB = cur.b;
#pragma unroll
    for (int h = 0; h < 2; ++h)
#pragma unroll
        for (int i = 0; i < 2; ++i) { gC[h][i] = 0u; gN[h][i] = 0u; g2[h][i] = 0u; }
    G8_GOFF(gC, cur);
    G8_STAGE_B(G8_SB(0, 0), cB); G8_STAGE_B(G8_SB(0, 1), cB + hstep); G8_STAGE_A(G8_SA(0, 0), cA, 0, gC); G8_STAGE_A(G8_SA(0, 1), cA, 1, gC);
    if (wr == 1) G8_BAR;
    G8_WAIT_V(2); G8_BAR;
    G8_STAGE_B(G8_SB(1, 0), cB + kstep); G8_STAGE_A(G8_SA(1, 0), cA + kstep, 0, gC); G8_STAGE_B(G8_SB(1, 1), cB + hstep + kstep);
    G8_WAIT_V(6); G8_BAR;
    for (;;) {
        const bool has_next = S.next(ui + 1, nxt);
        const char* nA = has_next ? nxt.a : cA; const char* nB = has_next ? nxt.b : cB;
        if constexpr (GATHER) { if (has_next) { G8_GOFF(gN, nxt); } else {
#pragma unroll
            for (int h = 0; h < 2; ++h)
#pragma unroll
                for (int i = 0; i < 2; ++i) gN[h][i] = gC[h][i]; } }
        for (int t = 0; t < nt; t += 2) {
            const bool last = (t == nt - 2);
            const char* a1 = cA + (size_t)(t + 1) * kstep;
            const char* a2 = last ? nA : cA + (size_t)(t + 2) * kstep; const char* b2 = last ? nB : cB + (size_t)(t + 2) * kstep;
            const char* a3 = a2 + kstep; const char* b3 = b2 + kstep;
            if constexpr (GATHER) {
#pragma unroll
                for (int h = 0; h < 2; ++h)
#pragma unroll
                    for (int i = 0; i < 2; ++i) g2[h][i] = last ? gN[h][i] : gC[h][i]; }
            G8_LDB(B0, 0, 0); G8_LDB(B1, 0, 1); G8_SCHED; G8_LDA(At, 0, 0); G8_STAGE_A(G8_SA(1, 1), a1, 1, gC);
            G8_WAIT_V(8); G8_WAIT_L(0); G8_BAR; G8_MMA(0, 0, At, B0); G8_MMA(0, 1, At, B1); G8_BAR; G8_SCHED;
            G8_LDA(At, 0, 1); G8_STAGE_B(G8_SB(0, 0), b2); G8_STAGE_B(G8_SB(0, 1), b2 + hstep); G8_STAGE_A(G8_SA(0, 0), a2, 0, g2);
            G8_WAIT_V(8); G8_WAIT_L(0); G8_BAR; G8_MMA(1, 0, At, B0); G8_MMA(1, 1, At, B1); G8_BAR; G8_SCHED;
            G8_LDB(B0, 1, 0); G8_LDB(B1, 1, 1); G8_SCHED; G8_LDA(At, 1, 0); G8_STAGE_A(G8_SA(0, 1), a2, 1, g2);
            G8_WAIT_V(8); G8_WAIT_L(0); G8_BAR; G8_MMA(0, 0, At, B0); G8_MMA(0, 1, At, B1); G8_BAR; G8_SCHED;
            G8_LDA(At, 1, 1); G8_STAGE_B(G8_SB(1, 0), b3); G8_STAGE_B(G8_SB(1, 1), b3 + hstep); G8_STAGE_A(G8_SA(1, 0), a3, 0, g2);
            G8_WAIT_V(8); G8_WAIT_L(0); G8_BAR; G8_MMA(1, 0, At, B0); G8_MMA(1, 1, At, B1); G8_BAR; G8_SCHED;
        }
        if (wr == 0) G8_BAR;
        E(acc, cur, wr, wc, fr, fq);
        if (!has_next) break;
#pragma unroll
        for (int a = 0; a < 2; ++a)
#pragma unroll
            for (int b = 0; b < 2; ++b)
#pragma unroll
                for (int m = 0; m < 4; ++m)
#pragma unroll
                    for (int n = 0; n < 2; ++n) acc[a][b][m][n] = (f32x4){0.f, 0.f, 0.f, 0.f};
        cur = nxt; cA = nA; cB = nB; ++ui;
        if constexpr (GATHER) {
#pragma unroll
            for (int h = 0; h < 2; ++h)
#pragma unroll
                for (int i = 0; i < 2; ++i) gC[h][i] = gN[h][i]; }
        if (wr == 1) G8_BAR;
    }
    G8_WAIT_V(0);
    G8_BAR;
#undef G8_SA
#undef G8_SB
#undef G8_DMA
#undef G8_STAGE_A
#undef G8_STAGE_B
#undef G8_LDA
#undef G8_LDB
#undef G8_MMA
#undef G8_WAIT_V
#undef G8_WAIT_L
#undef G8_BAR
#undef G8_SCHED
#undef G8_GOFF
}
}

enum { I_X = 0, I_POS, I_WIN, I_SGU_LNG, I_SGU_LNB, I_SGU_WS, I_SGU_B, I_LBLOG, I_HNORM, I_QNG, I_WUQ, I_KVNG, I_WUKV, I_WOUT, I_LN1G, I_LN1B,
       I_RGW, I_RGB, I_REW, I_REB, I_EWG, I_EWU, I_EWD, I_LN2G, I_LN2B };

enum { TK_WIN = 0, TK_WUQ, TK_WUKV, TK_WOUT, TK_GATE, TK_UP, TK_DOWN };
DI void transpose_item(const float* W, int K, int N, int kind, bf16_t* dst0, bf16_t* dst1, const float* sc, LAS float* scr, int item, int lane) {
    const int nblk = N / 32, kb = item / nblk, nb = item % nblk, k0 = 64 * kb, n0 = 32 * nb;
#pragma unroll 8
    for (int i = 0; i < 32; ++i) { const int kk = 2 * i + (lane >> 5); scr[kk * 33 + (lane & 31)] = W[(size_t)(k0 + kk) * N + n0 + (lane & 31)]; }
    asm volatile("s_waitcnt lgkmcnt(0)" ::: "memory");
    const int c = lane & 7;
    float s8[8];
#pragma unroll
    for (int i = 0; i < 8; ++i) s8[i] = sc ? sc[k0 + 8 * c + i] : 1.0f;
#pragma unroll
    for (int j = 0; j < 4; ++j) {
        const int nl = (lane >> 3) + 8 * j, n = n0 + nl; const LAS float* s = scr + (8 * c) * 33 + nl;
        u32x4 o; o.x = pk2(s[0 * 33] * s8[0], s[1 * 33] * s8[1]); o.y = pk2(s[2 * 33] * s8[2], s[3 * 33] * s8[3]); o.z = pk2(s[4 * 33] * s8[4], s[5 * 33] * s8[5]); o.w = pk2(s[6 * 33] * s8[6], s[7 * 33] * s8[7]);
        bf16_t* d = dst0; int row = n;
        if (kind == TK_WIN) { if (n >= 4096) { const int jj = n - 4096; row = 4096 + 2 * (jj & 31) + (jj >> 5); } }
        else if (kind == TK_WUQ) { const int h = n / 192, cc = n % 192; if (cc >= 128) { const int jj = cc - 128; row = h * 192 + 128 + 2 * (jj & 31) + (jj >> 5); } }
        else if (kind == TK_WUKV) { const int h = n >> 8, cc = n & 255; if (cc < 128) row = h * 128 + cc; else { d = dst1; row = h * 128 + cc - 128; } }
        else if (kind == TK_GATE) row = (n >> 7) * 256 + (n & 127);
        else if (kind == TK_UP) row = (n >> 7) * 256 + 128 + (n & 127);
        *(u32x4*)(d + (size_t)row * K + k0 + 8 * c) = o;
    }
    asm volatile("s_waitcnt lgkmcnt(0)" ::: "memory");
}

DI void phase_prologue(const Params& p, LAS unsigned char* lds, int bid, int G) {
    const int tid = otid(), lane = tid & 63, wave = tid >> 6;
    unsigned char* ws = ows(p);
    LAS float* scr = (LAS float*)(lds + wave * 16384);
    const int gw = bid * 8 + wave, NGW = G * 8;
    constexpr int IT_WIN = 32 * 130, IT_WUQ = 8 * 48, IT_WUKV = 8 * 64, IT_WOUT = 32 * 64, IT_E = 512, IT_LAYER = IT_WIN + IT_WUQ + IT_WUKV + IT_WOUT + NEXP * 3 * IT_E;
    for (int it = gw; it < DEPTH * IT_LAYER; it += NGW) {
        const int l = it / IT_LAYER; int r = it % IT_LAYER;
        if (r < IT_WIN) { transpose_item(p.in[I_WIN] + (size_t)l * DM * DIN, DM, DIN, TK_WIN, (bf16_t*)(ws + WS_WIN) + (size_t)l * DIN * DM, nullptr, nullptr, scr, r, lane); continue; } r -= IT_WIN;
        if (r < IT_WUQ) { transpose_item(p.in[I_WUQ] + (size_t)l * 512 * 1536, 512, 1536, TK_WUQ, (bf16_t*)(ws + WS_WUQ) + (size_t)l * 1536 * 512, nullptr, p.in[I_QNG] + l * 512, scr, r, lane); continue; } r -= IT_WUQ;
        if (r < IT_WUKV) { transpose_item(p.in[I_WUKV] + (size_t)l * 512 * 2048, 512, 2048, TK_WUKV, (bf16_t*)(ws + WS_WUK) + (size_t)l * 1024 * 512, (bf16_t*)(ws + WS_WUV) + (size_t)l * 1024 * 512, p.in[I_KVNG] + l * 512, scr, r, lane); continue; } r -= IT_WUKV;
        if (r < IT_WOUT) { transpose_item(p.in[I_WOUT] + (size_t)l * DM * DM, DM, DM, TK_WOUT, (bf16_t*)(ws + WS_WOUT) + (size_t)l * DM * DM, nullptr, nullptr, scr, r, lane); continue; } r -= IT_WOUT;
        const int e = r / (3 * IT_E), r2 = r % (3 * IT_E), ty = r2 / IT_E, r3 = r2 % IT_E; const size_t le = (size_t)l * NEXP + e;
        if (ty == 0) transpose_item(p.in[I_EWG] + le * DM * DEXP, DM, DEXP, TK_GATE, (bf16_t*)(ws + WS_WGU) + le * 1024 * DM, nullptr, nullptr, scr, r3, lane);
        else if (ty == 1) transpose_item(p.in[I_EWU] + le * DM * DEXP, DM, DEXP, TK_UP, (bf16_t*)(ws + WS_WGU) + le * 1024 * DM, nullptr, nullptr, scr, r3, lane);
        else transpose_item(p.in[I_EWD] + le * DEXP * DM, DEXP, DM, TK_DOWN, (bf16_t*)(ws + WS_WD) + le * DM * DEXP, nullptr, nullptr, scr, r3, lane);
    }
    const int gt = bid * NTHR + tid, NG = G * NTHR;
    {
        const f32x4* x4 = (const f32x4*)p.in[I_X]; u32x2* xb = (u32x2*)(ws + WS_XB);
        for (int i = gt; i < NT * DM / 4; i += NG) { const f32x4 v = x4[i]; xb[i] = (u32x2){pk2(v.x, v.y), pk2(v.z, v.w)}; }
    }
    {
        float* cs = (float*)(ws + WS_COS); const int* pos = (const int*)p.in[I_POS];
        for (int i = gt; i < NT * 32; i += NG) {
            const int tok = i >> 5, j = i & 31;
            const float inv = 1.0f / powf(10000.0f, (float)(2 * j) / 64.0f);
            const float ang = (float)pos[tok] * inv;
            const double a = (double)ang; const double k = rint(a * 0.15915494309189535); const double rr = a - k * 6.283185307179586476925;
            const float rf = (float)rr;
            cs[i] = cosf(rf); cs[NT * 32 + i] = sinf(rf);
        }
    }
    {
        float* lb = (float*)(ws + WS_LB); const float* lg = p.in[I_LBLOG];
        for (int c = gt; c < 512; c += NG) {
            float v[DEPTH], mx = -3.0e38f;
            for (int l = 0; l < DEPTH; ++l) { v[l] = lg[l * 512 + c]; mx = fmaxf(mx, v[l]); }
            float s = 0.f; for (int l = 0; l < DEPTH; ++l) { v[l] = expf(v[l] - mx); s += v[l]; }
            float cum = 0.f, first = 0.f;
            for (int l = 0; l < DEPTH; ++l) { cum += v[l] / s; if (l == 0) first = cum; lb[l * 512 + c] = cum - first; }
        }
    }
    {
        bf16_t* o = (bf16_t*)(ws + WS_SGUW); const float* w = p.in[I_SGU_WS];
        for (int i = gt; i < DEPTH * 4 * 128 * 128; i += NG) { const int s = i & 127, t = (i >> 7) & 127; o[i] = f2bf(s <= t ? w[i] : 0.f); }
    }
    {
        float* rw = (float*)(ws + WS_ROUTW);
        for (int i = gt; i < DEPTH * 48 * DM; i += NG) {
            const int k = i % DM, n = (i / DM) % 48, l = i / (DM * 48);
            float w = 0.f;
            if (n < 4) w = p.in[I_RGW][((size_t)l * DM + k) * 4 + n]; else if (n < 36) w = p.in[I_REW][((size_t)l * DM + k) * 32 + (n - 4)];
            rw[i] = w * p.in[I_LN1G][l * DM + k];
        }
        float* rc = (float*)(ws + WS_ROUTC);
        for (int it = gw; it < DEPTH * 48; it += NGW) {
            const int l = it / 48, n = it % 48; float s1 = 0.f, s0 = 0.f;
            if (n < 36) for (int k = lane; k < DM; k += 64) {
                const float w = (n < 4) ? p.in[I_RGW][((size_t)l * DM + k) * 4 + n] : p.in[I_REW][((size_t)l * DM + k) * 32 + (n - 4)];
                s1 += w * p.in[I_LN1G][l * DM + k]; s0 += w * p.in[I_LN1B][l * DM + k]; }
            s1 = wave_sum(s1); s0 = wave_sum(s0);
            if (lane == 0) { const float bias = (n < 4) ? p.in[I_RGB][l * 4 + n] : (n < 36 ? p.in[I_REB][l * 32 + n - 4] : 0.f); rc[(l * 2 + 0) * 48 + n] = s0 + bias; rc[(l * 2 + 1) * 48 + n] = s1; }
        }
    }
}

struct EpiInProj {
    static constexpr bool PERM = true;
    bf16_t* HB; float* LOGF; float* SSQ; const float* lb;
    template <int KIND> DI void run(const f32x4 (&acc)[2][2][4][2], const g8::Unit& u, int wr, int wc, int fr, int fq) const {
        const int row0 = u.pm * 256 + wr * 64 + fr, col0 = u.pn * 256 + wc * 32 + 8 * fq;
        float lbv[2][8];
        if constexpr (KIND == 2) {
#pragma unroll
            for (int bj = 0; bj < 2; ++bj)
#pragma unroll
                for (int i = 0; i < 8; ++i) lbv[bj][i] = lb[col0 - 1536 + bj * 128 + i];
        }
#pragma unroll
        for (int ai = 0; ai < 2; ++ai)
#pragma unroll
            for (int m = 0; m < 4; ++m) {
                const int row = row0 + ai * 128 + m * 16; float ssq = 0.f;
#pragma unroll
                for (int bj = 0; bj < 2; ++bj) {
                    float v[8];
#pragma unroll
                    for (int i = 0; i < 4; ++i) { v[i] = acc[ai][bj][m][0][i]; v[4 + i] = acc[ai][bj][m][1][i]; }
                    const int col = col0 + bj * 128;
                    if constexpr (KIND == 0) {
#pragma unroll
                        for (int i = 0; i < 8; ++i) v[i] = geluf_(v[i]);
                    } else if constexpr (KIND == 1) {
#pragma unroll
                        for (int i = 0; i < 8; ++i) v[i] = siluf_(v[i]);
                    } else if constexpr (KIND == 2) {
                        float lf[8];
#pragma unroll
                        for (int i = 0; i < 8; ++i) { const float e = __expf(v[i]); const float sg = e / (1.0f + e); const float l_ = lbv[bj][i];
                            const float f = l_ + (1.0f - l_) * (1.0f / (1.0f + __expf(-v[i])));
                            lf[i] = logf(f); v[i] = (1.0f - l_) / (1.0f + e); (void)sg; }
                        float* lp = LOGF + (size_t)row * 512 + (col - 1536);
                        *(f32x4*)lp = (f32x4){lf[0], lf[1], lf[2], lf[3]}; *(f32x4*)(lp + 4) = (f32x4){lf[4], lf[5], lf[6], lf[7]};
                    } else if constexpr (KIND == 4) {
#pragma unroll
                        for (int i = 0; i < 8; ++i) ssq += v[i] * v[i];
                    }
                    u32x4 w; w.x = pk2(v[0], v[1]); w.y = pk2(v[2], v[3]); w.z = pk2(v[4], v[5]); w.w = pk2(v[6], v[7]);
                    *(u32x4*)(HB + (size_t)row * 4096 + col) = w;
                }
                if constexpr (KIND == 4) {
                    ssq += __shfl_xor(ssq, 16); ssq += __shfl_xor(ssq, 32);
                    if (fq == 0) SSQ[(size_t)row * 16 + (u.pn - 12) * 4 + wc] = ssq;
                }
            }
    }
    DI void operator()(const f32x4 (&acc)[2][2][4][2], const g8::Unit& u, int wr, int wc, int fr, int fq) const {
        const int pn = u.pn;
        if (pn < 4) run<0>(acc, u, wr, wc, fr, fq);
        else if (pn < 6) run<1>(acc, u, wr, wc, fr, fq);
        else if (pn < 8) run<2>(acc, u, wr, wc, fr, fq);
        else if (pn < 10) run<3>(acc, u, wr, wc, fr, fq);
        else if (pn < 12) run<1>(acc, u, wr, wc, fr, fq);
        else run<4>(acc, u, wr, wc, fr, fq);
    }
};
DI void phase_inproj(const Params& p, LAS unsigned char* lds, int bid, int G, int l) {
    unsigned char* ws = ows(p);
    g8::StaticSched S; S.init(ws + WS_XB, (bf16_t*)(ws + WS_WIN) + (size_t)l * DIN * DM, NT, DIN_MAIN, DM, DM, G, bid);
    EpiInProj E{(bf16_t*)(ws + WS_HB), (float*)(ws + WS_LOGF), (float*)(ws + WS_SSQ), (const float*)(ws + WS_LB) + l * 512};
    g8::gemm_phase<EpiInProj, g8::StaticSched, false>(lds, DM, DM, DM, S, E);
}

DI void phase_krope(const Params& p, int bid, int G, int l) {
    unsigned char* ws = ows(p);
    const int tid = otid(), lane = tid & 63, wave = tid >> 6, fr = lane & 15, fq = lane >> 4;
    const bf16_t* X = (const bf16_t*)(ws + WS_XB); const bf16_t* W = (const bf16_t*)(ws + WS_WIN) + ((size_t)l * DIN + 4096) * DM;
    const float* cs = (const float*)(ws + WS_COS); bf16_t* KR = (bf16_t*)(ws + WS_KR);
    for (int task = bid * 8 + wave; task < NT / 16; task += G * 8) {
        const int r0 = task * 16;
        f32x4 acc[4];
#pragma unroll
        for (int n = 0; n < 4; ++n) acc[n] = (f32x4){0.f, 0.f, 0.f, 0.f};
        const bf16_t* ap = X + (size_t)(r0 + fr) * DM + 8 * fq;
        const bf16_t* bp = W + (size_t)fr * DM + 8 * fq;
#pragma unroll 4
        for (int s = 0; s < DM / 32; ++s) {
            const bf16x8 a = *(const bf16x8*)(ap + 32 * s);
#pragma unroll
            for (int n = 0; n < 4; ++n) { const bf16x8 b = *(const bf16x8*)(bp + (size_t)(16 * n) * DM + 32 * s); acc[n] = __builtin_amdgcn_mfma_f32_16x16x32_bf16(a, b, acc[n], 0, 0, 0); }
        }
#pragma unroll
        for (int n = 0; n < 4; ++n)
#pragma unroll
            for (int i = 0; i < 4; ++i) {
                const int row = r0 + 4 * fq + i, col = 16 * n + fr, j = col >> 1;
                const float v = acc[n][i], o = __shfl_xor(v, 1);
                const float c = cs[(size_t)row * 32 + j], s = cs[(size_t)NT * 32 + (size_t)row * 32 + j];
                const float y = (col & 1) ? (v * c + o * s) : (v * c - o * s);
                KR[(size_t)row * 64 + col] = f2bf(y);
            }
    }
}

DI void phase_sgu(const Params& p, LAS unsigned char* lds, int bid, int G, int l) {
    unsigned char* ws = ows(p);
    const int tid = otid(), lane = tid & 63, wave = tid >> 6, fr = lane & 15, fq = lane >> 4;
    const bf16_t* HB = (const bf16_t*)(ws + WS_HB); bf16_t* CAT = (bf16_t*)(ws + WS_CAT);
    const bf16_t* SW = (const bf16_t*)(ws + WS_SGUW) + (size_t)l * 4 * 128 * 128;
    const float* lng = p.in[I_SGU_LNG] + l * 512; const float* lnb = p.in[I_SGU_LNB] + l * 512; const float* sb = p.in[I_SGU_B] + l * 512;
    constexpr int TS = 272;
    LAS unsigned char* T = lds;
    for (int unit = bid; unit < 128 * 4; unit += G) {
        const int ci = unit >> 2, g = unit & 3, rbase = ci * 128;
        __syncthreads();
        for (int rr = 0; rr < 16; ++rr) {
            const int s = wave * 16 + rr, row = rbase + s;
            const u32x4 raw = *(const u32x4*)(HB + (size_t)row * 4096 + 512 + 8 * lane);
            float v[8] = {bflo(raw.x), bfhi(raw.x), bflo(raw.y), bfhi(raw.y), bflo(raw.z), bfhi(raw.z), bflo(raw.w), bfhi(raw.w)};
            float sm = 0.f;
#pragma unroll
            for (int i = 0; i < 8; ++i) sm += v[i];
            const float mean = wave_sum(sm) * (1.0f / 512.0f);
            float sq = 0.f;
#pragma unroll
            for (int i = 0; i < 8; ++i) { v[i] -= mean; sq += v[i] * v[i]; }
            const float rstd = 1.0f / sqrtf(wave_sum(sq) * (1.0f / 512.0f) + EPS);
            if ((lane >> 4) == g) {
#pragma unroll
                for (int i = 0; i < 8; ++i) { const int c = 8 * lane + i, d = c & 127; const float y = v[i] * rstd * lng[c] + lnb[c];
                    *(LAS bf16_t*)(T + d * TS + s * 2) = f2bf(y); }
            }
        }
        __syncthreads();
        f32x4 acc[8];
#pragma unroll
        for (int n = 0; n < 8; ++n) acc[n] = (f32x4){0.f, 0.f, 0.f, 0.f};
        const bf16_t* wp = SW + ((size_t)g * 128 + wave * 16 + fr) * 128 + 8 * fq;
        const int ksmax = wave >> 1;
        for (int ks = 0; ks <= ksmax; ++ks) {
            const bf16x8 a = *(const bf16x8*)(wp + 32 * ks);
#pragma unroll
            for (int n = 0; n < 8; ++n) { const bf16x8 b = *(const LAS bf16x8*)(T + (16 * n + fr) * TS + (32 * ks + 8 * fq) * 2); acc[n] = __builtin_amdgcn_mfma_f32_16x16x32_bf16(a, b, acc[n], 0, 0, 0); }
        }
#pragma unroll
        for (int i = 0; i < 4; ++i) {
            const int t = wave * 16 + 4 * fq + i, row = rbase + t; const float bias = sb[g * 128 + t];
#pragma unroll
            for (int n = 0; n < 8; ++n) { const int c = g * 128 + 16 * n + fr; const float uu = bf2f(HB[(size_t)row * 4096 + c]);
                CAT[(size_t)row * DM + c] = f2bf(uu * (acc[n][i] + bias)); }
        }
    }
}

DI void phase_hgrn_simple(const Params& p, LAS unsigned char* lds, int bid, int G, int l) {
    unsigned char* ws = ows(p);
    const int tid = otid(), vi = tid >> 5, kg = tid & 31;
    const bf16_t* HB = (const bf16_t*)(ws + WS_HB); const float* LOGF = (const float*)(ws + WS_LOGF); float* OH = (float*)(ws + WS_OH);
    LAS float* Lf = (LAS float*)lds;
    LAS float* Lk = Lf + 64 * 128;
    LAS float* Lq = Lk + 64 * 128;
    LAS float* Lv = Lq + 64 * 128;
    LAS float* Lo = Lv + 64 * 16;
    for (int unit = bid; unit < 16 * 8; unit += G) {
        const int bh = unit >> 3, vs = unit & 7, b = bh >> 2, h = bh & 3;
        float S[4] = {0.f, 0.f, 0.f, 0.f};
        for (int ch = 0; ch < SEQ / 64; ++ch) {
            const int row0 = b * SEQ + ch * 64;
            __syncthreads();
            for (int e = tid; e < 64 * 32; e += NTHR) {
                const int t = e >> 5, k4 = (e & 31) * 4; const size_t row = (size_t)(row0 + t);
                const f32x4 lf = *(const f32x4*)(LOGF + row * 512 + h * 128 + k4);
                *(LAS f32x4*)(Lf + t * 128 + k4) = (f32x4){__expf(lf.x), __expf(lf.y), __expf(lf.z), __expf(lf.w)};
                const u32x2 kr = *(const u32x2*)(HB + row * 4096 + 1536 + h * 128 + k4);
                *(LAS f32x4*)(Lk + t * 128 + k4) = (f32x4){bflo(kr.x), bfhi(kr.x), bflo(kr.y), bfhi(kr.y)};
                const u32x2 qr = *(const u32x2*)(HB + row * 4096 + 1024 + h * 128 + k4);
                *(LAS f32x4*)(Lq + t * 128 + k4) = (f32x4){bflo(qr.x), bfhi(qr.x), bflo(qr.y), bfhi(qr.y)};
            }
            for (int e = tid; e < 64 * 16; e += NTHR) { const int t = e >> 4, j = e & 15; Lv[e] = bf2f(HB[(size_t)(row0 + t) * 4096 + 2048 + h * 128 + vs * 16 + j]); }
            __syncthreads();
#pragma unroll 4
            for (int t = 0; t < 64; ++t) {
                const f32x4 f = *(const LAS f32x4*)(Lf + t * 128 + 4 * kg), kk = *(const LAS f32x4*)(Lk + t * 128 + 4 * kg), q = *(const LAS f32x4*)(Lq + t * 128 + 4 * kg);
                const float v = Lv[t * 16 + vi];
                S[0] = f.x * S[0] + kk.x * v; S[1] = f.y * S[1] + kk.y * v; S[2] = f.z * S[2] + kk.z * v; S[3] = f.w * S[3] + kk.w * v;
                float o = q.x * S[0] + q.y * S[1] + q.z * S[2] + q.w * S[3];
                o += __shfl_xor(o, 1); o += __shfl_xor(o, 2); o += __shfl_xor(o, 4); o += __shfl_xor(o, 8); o += __shfl_xor(o, 16);
                if (kg == 0) Lo[t * 16 + vi] = o;
            }
            __syncthreads();
            for (int e = tid; e < 64 * 16; e += NTHR) { const int t = e >> 4, j = e & 15; OH[(size_t)(row0 + t) * 512 + h * 128 + vs * 16 + j] = Lo[e]; }
        }
    }
}
DI void phase_hgrn_finish(const Params& p, int bid, int G, int l) {
    unsigned char* ws = ows(p);
    const int tid = otid(), lane = tid & 63, wave = tid >> 6;
    const float* OH = (const float*)(ws + WS_OH); const bf16_t* HB = (const bf16_t*)(ws + WS_HB); bf16_t* CAT = (bf16_t*)(ws + WS_CAT);
    const float* ng = p.in[I_HNORM] + l * 512;
    for (int row = bid * 8 + wave; row < NT; row += G * 8) {
        const f32x4 a = *(const f32x4*)(OH + (size_t)row * 512 + 8 * lane), b = *(const f32x4*)(OH + (size_t)row * 512 + 8 * lane + 4);
        float v[8] = {a.x, a.y, a.z, a.w, b.x, b.y, b.z, b.w};
        float sq = 0.f;
#pragma unroll
        for (int i = 0; i < 8; ++i) sq += v[i] * v[i];
        sq += __shfl_xor(sq, 1); sq += __shfl_xor(sq, 2); sq += __shfl_xor(sq, 4); sq += __shfl_xor(sq, 8);
        const float rstd = 1.0f / sqrtf(sq * (1.0f / 128.0f) + EPS);
        const u32x4 gr = *(const u32x4*)(HB + (size_t)row * 4096 + 2560 + 8 * lane);
        const float gs[8] = {bflo(gr.x), bfhi(gr.x), bflo(gr.y), bfhi(gr.y), bflo(gr.z), bfhi(gr.z), bflo(gr.w), bfhi(gr.w)};
        float y[8];
#pragma unroll
        for (int i = 0; i < 8; ++i) y[i] = v[i] * rstd * ng[8 * lane + i] * gs[i];
        u32x4 w; w.x = pk2(y[0], y[1]); w.y = pk2(y[2], y[3]); w.z = pk2(y[4], y[5]); w.w = pk2(y[6], y[7]);
        *(u32x4*)(CAT + (size_t)row * DM + 512 + 8 * lane) = w;
    }
}

DI float rstd_from_ssq(const float* SSQ, int row, int which) {
    const f32x4 a = *(const f32x4*)(SSQ + (size_t)row * 16 + which * 8), b = *(const f32x4*)(SSQ + (size_t)row * 16 + which * 8 + 4);
    const float s = (a.x + a.y) + (a.z + a.w) + (b.x + b.y) + (b.z + b.w);
    return 1.0f / sqrtf(s * (1.0f / 512.0f) + EPS);
}
struct EpiQ {
    static constexpr bool PERM = true;
    bf16_t* Q; const float* SSQ; const float* cs;
    DI void operator()(const f32x4 (&acc)[2][2][4][2], const g8::Unit& u, int wr, int wc, int fr, int fq) const {
        const int row0 = u.pm * 256 + wr * 64 + fr, col0 = u.pn * 256 + wc * 32 + 8 * fq;
#pragma unroll
        for (int ai = 0; ai < 2; ++ai)
#pragma unroll
            for (int m = 0; m < 4; ++m) {
                const int row = row0 + ai * 128 + m * 16; const float sc = rstd_from_ssq(SSQ, row, 0) * QSCALE;
#pragma unroll
                for (int bj = 0; bj < 2; ++bj) {
                    const int col = col0 + bj * 128, cc = col % 192;
                    float v[8];
#pragma unroll
                    for (int i = 0; i < 4; ++i) { v[i] = acc[ai][bj][m][0][i] * sc; v[4 + i] = acc[ai][bj][m][1][i] * sc; }
                    if (cc >= 128) {
                        const int j0 = (cc - 128) >> 1;
                        const f32x4 c = *(const f32x4*)(cs + (size_t)row * 32 + j0), s = *(const f32x4*)(cs + (size_t)NT * 32 + (size_t)row * 32 + j0);
#pragma unroll
                        for (int i = 0; i < 4; ++i) { const float x1 = v[2 * i], x2 = v[2 * i + 1]; v[2 * i] = x1 * c[i] - x2 * s[i]; v[2 * i + 1] = x2 * c[i] + x1 * s[i]; }
                    }
                    u32x4 w; w.x = pk2(v[0], v[1]); w.y = pk2(v[2], v[3]); w.z = pk2(v[4], v[5]); w.w = pk2(v[6], v[7]);
                    *(u32x4*)(Q + (size_t)row * 1536 + col) = w;
                }
            }
    }
};
struct EpiK {
    static constexpr bool PERM = true;
    bf16_t* KN; const float* SSQ;
    DI void operator()(const f32x4 (&acc)[2][2][4][2], const g8::Unit& u, int wr, int wc, int fr, int fq) const {
        const int row0 = u.pm * 256 + wr * 64 + fr, col0 = u.pn * 256 + wc * 32 + 8 * fq;
#pragma unroll
        for (int ai = 0; ai < 2; ++ai)
#pragma unroll
            for (int m = 0; m < 4; ++m) {
                const int row = row0 + ai * 128 + m * 16; const float sc = rstd_from_ssq(SSQ, row, 1);
#pragma unroll
                for (int bj = 0; bj < 2; ++bj) {
                    const f32x4 v0 = acc[ai][bj][m][0] * sc, v1 = acc[ai][bj][m][1] * sc;
                    u32x4 w; w.x = pk2(v0[0], v0[1]); w.y = pk2(v0[2], v0[3]); w.z = pk2(v1[0], v1[1]); w.w = pk2(v1[2], v1[3]);
                    *(u32x4*)(KN + (size_t)row * 1024 + col0 + bj * 128) = w;
                }
            }
    }
};
struct EpiVT {
    static constexpr bool PERM = true;
    bf16_t* VT; const float* SSQ;
    DI void operator()(const f32x4 (&acc)[2][2][4][2], const g8::Unit& u, int wr, int wc, int fr, int fq) const {
        const int row0 = u.pm * 256 + wr * 64 + fr, col0 = u.pn * 256 + wc * 32 + 8 * fq;
        float sc[2][8];
#pragma unroll
        for (int bj = 0; bj < 2; ++bj)
#pragma unroll
            for (int i = 0; i < 8; ++i) sc[bj][i] = rstd_from_ssq(SSQ, col0 + bj * 128 + i, 1);
#pragma unroll
        for (int ai = 0; ai < 2; ++ai)
#pragma unroll
            for (int m = 0; m < 4; ++m) {
                const int row = row0 + ai * 128 + m * 16, h = row >> 7, d = row & 127;
#pragma unroll
                for (int bj = 0; bj < 2; ++bj) {
                    const int tok = col0 + bj * 128, b = tok >> 12, s = tok & 4095;
                    const f32x4 a0 = acc[ai][bj][m][0], a1 = acc[ai][bj][m][1];
                    u32x4 w; w.x = pk2(a0[0] * sc[bj][0], a0[1] * sc[bj][1]); w.y = pk2(a0[2] * sc[bj][2], a0[3] * sc[bj][3]);
                    w.z = pk2(a1[0] * sc[bj][4], a1[1] * sc[bj][5]); w.w = pk2(a1[2] * sc[bj][6], a1[3] * sc[bj][7]);
                    *(u32x4*)(VT + ((size_t)((b * 8 + h) * 128 + d)) * SEQ + s) = w;
                }
            }
    }
};
DI void phase_mla_proj(const Params& p, LAS unsigned char* lds, int bid, int G, int l) {
    unsigned char* ws = ows(p);
    const float* SSQ = (const float*)(ws + WS_SSQ); const bf16_t* HB = (const bf16_t*)(ws + WS_HB);
    {
        g8::StaticSched S; S.init(HB + 3072, (const bf16_t*)(ws + WS_WUQ) + (size_t)l * 1536 * 512, NT, 1536, 4096, 512, G, bid);
        EpiQ E{(bf16_t*)(ws + WS_Q), SSQ, (const float*)(ws + WS_COS)};
        g8::gemm_phase<EpiQ, g8::StaticSched, false>(lds, 512, 4096, 512, S, E);
    }
    {
        g8::StaticSched S; S.init(HB + 3584, (const bf16_t*)(ws + WS_WUK) + (size_t)l * 1024 * 512, NT, 1024, 4096, 512, G, bid);
        EpiK E{(bf16_t*)(ws + WS_KN), SSQ};
        g8::gemm_phase<EpiK, g8::StaticSched, false>(lds, 512, 4096, 512, S, E);
    }
    {
        g8::StaticSched S; S.init((const bf16_t*)(ws + WS_WUV) + (size_t)l * 1024 * 512, HB + 3584, 1024, NT, 512, 4096, G, bid);
        EpiVT E{(bf16_t*)(ws + WS_VT), SSQ};
        g8::gemm_phase<EpiVT, g8::StaticSched, false>(lds, 512, 512, 4096, S, E);
    }
}

constexpr int AT_KS = 400, AT_VS = 144;
constexpr int AT_KBUF = 64 * AT_KS, AT_VBUF = 128 * AT_VS;
DI void attn_unit(const bf16_t* Qg, const bf16_t* KNg, const bf16_t* KRg, const bf16_t* VTg, bf16_t* CAT, LAS unsigned char* lds, int b, int h, int qb) {
    const int tid = otid(), lane = tid & 63, wave = __builtin_amdgcn_readfirstlane(tid >> 6), c = lane & 31, hi = lane >> 5;
    const int q0 = qb * 256, qmin = q0 + 32 * wave, qrow = qmin + c, ntile = 4 * (qb + 1), jmax = (qmin + 31) >> 6;
    LAS unsigned char* Kb = lds; LAS unsigned char* Vb = lds + 2 * AT_KBUF;
    bf16x8 qf[12];
    { const bf16_t* qp = Qg + (size_t)(b * SEQ + qrow) * 1536 + h * 192 + 8 * hi;
#pragma unroll
      for (int ks = 0; ks < 12; ++ks) qf[ks] = *(const bf16x8*)(qp + 16 * ks); }
    f32x16 o[4];
#pragma unroll
    for (int d = 0; d < 4; ++d)
#pragma unroll
        for (int r = 0; r < 16; ++r) o[d][r] = 0.f;
    float m_run = -1.0e30f, l_run = 0.f;
    int ksrc_off[3], kdst[3]; bool kfromR[3];
#pragma unroll
    for (int i = 0; i < 3; ++i) { const int id = tid + 512 * i, key = id / 24, cc = id % 24; kdst[i] = key * AT_KS + cc * 16; kfromR[i] = cc >= 16;
        ksrc_off[i] = kfromR[i] ? (key * 64 + 8 * (cc - 16)) : (key * 1024 + h * 128 + 8 * cc); }
    int vsrc_off[2], vdst[2];
#pragma unroll
    for (int i = 0; i < 2; ++i) { const int id = tid + 512 * i, d = id >> 3, cc = id & 7; vdst[i] = d * AT_VS + cc * 16; vsrc_off[i] = d * SEQ + 8 * cc; }
    const bf16_t* KNb = KNg + (size_t)b * SEQ * 1024; const bf16_t* KRb = KRg + (size_t)b * SEQ * 64; const bf16_t* VTb = VTg + (size_t)(b * 8 + h) * 128 * SEQ;
    u32x4 kreg[3], vreg[2];
#define AT_LOAD(j) do { _Pragma("unroll") for (int i = 0; i < 3; ++i) kreg[i] = kfromR[i] ? *(const u32x4*)(KRb + (size_t)(j) * 64 * 64 + ksrc_off[i]) : *(const u32x4*)(KNb + (size_t)(j) * 64 * 1024 + ksrc_off[i]); \
                        _Pragma("unroll") for (int i = 0; i < 2; ++i) vreg[i] = *(const u32x4*)(VTb + (size_t)(j) * 64 + vsrc_off[i]); } while (0)
#define AT_STORE(buf) do { _Pragma("unroll") for (int i = 0; i < 3; ++i) *(LAS u32x4*)(Kb + (buf) * AT_KBUF + kdst[i]) = kreg[i]; \
                           _Pragma("unroll") for (int i = 0; i < 2; ++i) *(LAS u32x4*)(Vb + (buf) * AT_VBUF + vdst[i]) = vreg[i]; } while (0)
    __syncthreads();
    AT_LOAD(0); AT_STORE(0);
    __syncthreads();
    for (int j = 0; j < ntile; ++j) {
        const int buf = j & 1;
        if (j + 1 < ntile) AT_LOAD(j + 1);
        if (j <= jmax) {
            const LAS unsigned char* kb_ = Kb + buf * AT_KBUF + c * AT_KS + 16 * hi;
            f32x16 s0, s1;
#pragma unroll
            for (int r = 0; r < 16; ++r) { s0[r] = 0.f; s1[r] = 0.f; }
#pragma unroll
            for (int ks = 0; ks < 12; ++ks) {
                const bf16x8 a0 = *(const LAS bf16x8*)(kb_ + 32 * ks), a1 = *(const LAS bf16x8*)(kb_ + 32 * AT_KS + 32 * ks);
                s0 = __builtin_amdgcn_mfma_f32_32x32x16_bf16(a0, qf[ks], s0, 0, 0, 0);
                s1 = __builtin_amdgcn_mfma_f32_32x32x16_bf16(a1, qf[ks], s1, 0, 0, 0);
            }
            if (64 * j + 63 > qmin) {
                const int dq = qrow - 64 * j - 4 * hi;
#pragma unroll
                for (int r = 0; r < 16; ++r) { const int kk = (r & 3) + 8 * (r >> 2);
                    if (kk > dq) s0[r] = -__builtin_inff();
                    if (kk + 32 > dq) s1[r] = -__builtin_inff(); }
            }
            float mx = s0[0];
#pragma unroll
            for (int r = 1; r < 16; ++r) mx = fmaxf(mx, s0[r]);
#pragma unroll
            for (int r = 0; r < 16; ++r) mx = fmaxf(mx, s1[r]);
            mx = fmaxf(mx, __shfl_xor(mx, 32));
            const float m_new = fmaxf(m_run, mx), alpha = __builtin_amdgcn_exp2f(m_run - m_new);
            m_run = m_new;
            float ps = 0.f;
#pragma unroll
            for (int r = 0; r < 16; ++r) { s0[r] = __builtin_amdgcn_exp2f(s0[r] - m_new); s1[r] = __builtin_amdgcn_exp2f(s1[r] - m_new); ps += s0[r] + s1[r]; }
            l_run = l_run * alpha + ps;
#pragma unroll
            for (int d = 0; d < 4; ++d)
#pragma unroll
                for (int r = 0; r < 16; ++r) o[d][r] *= alpha;
            bf16x8 pb[4];
#pragma unroll
            for (int s2 = 0; s2 < 2; ++s2) {
                u32x4 w0, w1;
                w0.x = pk2(s0[8 * s2 + 0], s0[8 * s2 + 1]); w0.y = pk2(s0[8 * s2 + 2], s0[8 * s2 + 3]); w0.z = pk2(s0[8 * s2 + 4], s0[8 * s2 + 5]); w0.w = pk2(s0[8 * s2 + 6], s0[8 * s2 + 7]);
                w1.x = pk2(s1[8 * s2 + 0], s1[8 * s2 + 1]); w1.y = pk2(s1[8 * s2 + 2], s1[8 * s2 + 3]); w1.z = pk2(s1[8 * s2 + 4], s1[8 * s2 + 5]); w1.w = pk2(s1[8 * s2 + 6], s1[8 * s2 + 7]);
                pb[s2] = __builtin_bit_cast(bf16x8, w0); pb[2 + s2] = __builtin_bit_cast(bf16x8, w1);
            }
            const LAS unsigned char* vb_ = Vb + buf * AT_VBUF + c * AT_VS + 8 * hi;
#pragma unroll
            for (int d = 0; d < 4; ++d)
#pragma unroll
                for (int kk = 0; kk < 4; ++kk) {
                    const LAS unsigned char* vp = vb_ + d * 32 * AT_VS + kk * 32;
                    const u32x2 lo = *(const LAS u32x2*)vp, hi2 = *(const LAS u32x2*)(vp + 16);
                    const u32x4 av = {lo.x, lo.y, hi2.x, hi2.y};
                    o[d] = __builtin_amdgcn_mfma_f32_32x32x16_bf16(__builtin_bit_cast(bf16x8, av), pb[kk], o[d], 0, 0, 0);
                }
        }
        if (j + 1 < ntile) AT_STORE(buf ^ 1);
        __syncthreads();
    }
#undef AT_LOAD
#undef AT_STORE
    const float l_tot = l_run + __shfl_xor(l_run, 32), inv = 1.0f / l_tot;
    bf16_t* op = CAT + (size_t)(b * SEQ + qrow) * DM + 1024 + h * 128 + 4 * hi;
#pragma unroll
    for (int d = 0; d < 4; ++d)
#pragma unroll
        for (int g = 0; g < 4; ++g) {
            const u32x2 w = {pk2(o[d][4 * g] * inv, o[d][4 * g + 1] * inv), pk2(o[d][4 * g + 2] * inv, o[d][4 * g + 3] * inv)};
            *(u32x2*)(op + 32 * d + 8 * g) = w;
        }
}
DI void phase_attn(const Params& p, LAS unsigned char* lds, int bid, int G) {
    unsigned char* ws = ows(p);
    const bf16_t* Q = (const bf16_t*)(ws + WS_Q); const bf16_t* KN = (const bf16_t*)(ws + WS_KN); const bf16_t* KR = (const bf16_t*)(ws + WS_KR); const bf16_t* VT = (const bf16_t*)(ws + WS_VT);
    bf16_t* CAT = (bf16_t*)(ws + WS_CAT);
    for (int it = bid; it < 256; it += G) {
        const int x = it & 7, y = it >> 3, bh = (x * 4 + (y >> 3)) & 31, pair = y & 7, b = bh >> 3, h = bh & 7;
        attn_unit(Q, KN, KR, VT, CAT, lds, b, h, 15 - pair);
        attn_unit(Q, KN, KR, VT, CAT, lds, b, h, pair);
    }
}

struct EpiOut {
    static constexpr bool PERM = false;
    const float* xres; float* Y;
    DI void operator()(const f32x4 (&acc)[2][2][4][2], const g8::Unit& u, int wr, int wc, int fr, int fq) const {
        const int row0 = u.pm * 256 + wr * 64 + fr, col0 = u.pn * 256 + wc * 32 + 4 * fq;
#pragma unroll
        for (int ai = 0; ai < 2; ++ai)
#pragma unroll
            for (int m = 0; m < 4; ++m) {
                const size_t rb = (size_t)(row0 + ai * 128 + m * 16) * DM;
#pragma unroll
                for (int bj = 0; bj < 2; ++bj)
#pragma unroll
                    for (int n = 0; n < 2; ++n) { const int col = col0 + bj * 128 + 16 * n; const f32x4 x = *(const f32x4*)(xres + rb + col); *(f32x4*)(Y + rb + col) = x * ALPHA + acc[ai][bj][m][n]; }
            }
    }
};
DI void phase_outproj(const Params& p, LAS unsigned char* lds, int bid, int G, int l) {
    unsigned char* ws = ows(p);
    g8::StaticSched S; S.init(ws + WS_CAT, (const bf16_t*)(ws + WS_WOUT) + (size_t)l * DM * DM, NT, DM, DM, DM, G, bid);
    EpiOut E{l == 0 ? p.in[I_X] : p.out, (float*)(ws + WS_Y)};
    g8::gemm_phase<EpiOut, g8::StaticSched, false>(lds, DM, DM, DM, S, E);
}

DI void phase_ln1_router(const Params& p, LAS unsigned char* lds, int bid, int G, int l) {
    unsigned char* ws = ows(p);
    const int tid = otid(), lane = tid & 63, wave = tid >> 6, fr = lane & 15, fq = lane >> 4;
    float* Y = (float*)(ws + WS_Y); bf16_t* X1B = (bf16_t*)(ws + WS_X1B);
    const float* RW = (const float*)(ws + WS_ROUTW) + (size_t)l * 48 * DM; const float* rc0 = (const float*)(ws + WS_ROUTC) + (l * 2 + 0) * 48; const float* rc1 = rc0 + 48;
    const float* g = p.in[I_LN1G] + l * DM; const float* bt = p.in[I_LN1B] + l * DM;
    unsigned* cnt = (unsigned*)(ws + WS_CTL) + CW_CNT + l * 32 * 16;
    int* TOK = (int*)(ws + WS_TOK); int* ROUTE = (int*)(ws + WS_ROUTE);
    LAS float* lg = (LAS float*)(lds + wave * 4096);
    for (int task = bid * 8 + wave; task < NT / 16; task += G * 8) {
        const int r0 = task * 16;
        float* yp = Y + (size_t)(r0 + fr) * DM + 4 * fq;
        const float* wp = RW + (size_t)fr * DM + 4 * fq;
        f32x4 acc[3]; float sm = 0.f, sq = 0.f;
#pragma unroll
        for (int n = 0; n < 3; ++n) acc[n] = (f32x4){0.f, 0.f, 0.f, 0.f};
#pragma unroll 2
        for (int s = 0; s < DM / 16; ++s) {
            const f32x4 xa = *(const f32x4*)(yp + 16 * s);
            sm += (xa.x + xa.y) + (xa.z + xa.w); sq += (xa.x * xa.x + xa.y * xa.y) + (xa.z * xa.z + xa.w * xa.w);
#pragma unroll
            for (int n = 0; n < 3; ++n) { const f32x4 wb = *(const f32x4*)(wp + (size_t)(16 * n) * DM + 16 * s);
#pragma unroll
                for (int i = 0; i < 4; ++i) acc[n] = __builtin_amdgcn_mfma_f32_16x16x4f32(xa[i], wb[i], acc[n], 0, 0, 0); }
        }
        sm += __shfl_xor(sm, 16); sm += __shfl_xor(sm, 32); sq += __shfl_xor(sq, 16); sq += __shfl_xor(sq, 32);
        const float mean = sm * (1.0f / DM), var = fmaxf(sq * (1.0f / DM) - mean * mean, 0.f), rstd = 1.0f / sqrtf(var + EPS);
#pragma unroll
        for (int i = 0; i < 4; ++i) {
            const float mr = __shfl(mean, 4 * fq + i), rs = __shfl(rstd, 4 * fq + i);
#pragma unroll
            for (int n = 0; n < 3; ++n) { const int col = 16 * n + fr; lg[(4 * fq + i) * 48 + col] = rs * (acc[n][i] - mr * rc1[col]) + rc0[col]; }
        }
        asm volatile("s_waitcnt lgkmcnt(0)" ::: "memory");
        if (lane < 16) {
            const LAS float* L = lg + lane * 48; const int token = r0 + lane;
            float gm = L[0]; int gi = 0;
#pragma unroll
            for (int j = 1; j < 4; ++j) if (L[j] > gm) { gm = L[j]; gi = j; }
            float gs = 0.f;
#pragma unroll
            for (int j = 0; j < 4; ++j) gs += expf(L[j] - gm);
            const float gval = 1.0f / gs;
            const LAS float* E = L + 4 + gi * 8;
            float v1 = E[0]; int i1 = 0;
#pragma unroll
            for (int j = 1; j < 8; ++j) if (E[j] > v1) { v1 = E[j]; i1 = j; }
            float v2 = -3.0e38f; int i2 = 0;
#pragma unroll
            for (int j = 0; j < 8; ++j) if (j != i1 && E[j] > v2) { v2 = E[j]; i2 = j; }
            const float ex = expf(v2 - v1), p1 = 1.0f / (1.0f + ex), p2 = ex / (1.0f + ex);
            const int e0 = gi * 8 + i1, e1 = gi * 8 + i2;
            const int pos0 = (int)atomicAdd(cnt + e0 * 16, 1u), pos1 = (int)atomicAdd(cnt + e1 * 16, 1u);
            TOK[(size_t)e0 * NT + pos0] = token; TOK[(size_t)e1 * NT + pos1] = token;
            int* rp = ROUTE + (size_t)token * 8;
            rp[0] = e0; rp[1] = pos0; rp[2] = e1; rp[3] = pos1; rp[4] = __float_as_int(gval * p1); rp[5] = __float_as_int(gval * p2);
        }
        bf16_t* xb = X1B + (size_t)(r0 + fr) * DM + 4 * fq;
#pragma unroll 4
        for (int s = 0; s < DM / 16; ++s) {
            const f32x4 xa = *(const f32x4*)(yp + 16 * s); const f32x4 gg = *(const f32x4*)(g + 16 * s + 4 * fq), bb = *(const f32x4*)(bt + 16 * s + 4 * fq);
            const f32x4 y = (xa - mean) * rstd * gg + bb;
            *(f32x4*)(yp + 16 * s) = y; *(u32x2*)(xb + 16 * s) = (u32x2){pk2(y.x, y.y), pk2(y.z, y.w)};
        }
        asm volatile("s_waitcnt lgkmcnt(0)" ::: "memory");
    }
}

constexpr int MOE_LDS_OFF = 131072;
DI void moe_tables(const Params& p, LAS unsigned char* lds, int l) {
    LAS int* mc = (LAS int*)(lds + MOE_LDS_OFF); LAS int* mp = mc + 32;
    __syncthreads();
    if (threadIdx.x == 0) {
        const unsigned* cnt = (const unsigned*)(ows(p) + WS_CTL) + CW_CNT + l * 32 * 16; int acc = 0;
        for (int e = 0; e < 32; ++e) { int c = (int)__hip_atomic_load(cnt + e * 16, __ATOMIC_RELAXED, __HIP_MEMORY_SCOPE_AGENT); if (c > NT) c = NT; mc[e] = c; mp[e] = acc; acc += (c + 255) >> 8; }
        mp[32] = acc;
    }
    __syncthreads();
}
template <int NCT_SHIFT> struct MoeSched {
    const char* A; const char* Bt; const int* TOK; LAS const int* mc; LAS const int* mp; size_t bexp, btile, atile; int G, c;
    DI bool next(int i, g8::Unit& u) const {
        const int L = i * G + c, T = mp[32]; if (L >= (T << NCT_SHIFT)) return false;
        const int rt = L >> NCT_SHIFT, ct = L & ((1 << NCT_SHIFT) - 1); int e = 0;
        for (int j = 1; j < 32; ++j) if (mp[j] <= rt) e = j;
        u.pm = rt; u.pn = ct; u.x0 = e; u.x1 = rt - mp[e];
        u.a = A + (size_t)rt * atile; u.b = Bt + (size_t)e * bexp + (size_t)ct * btile; return true;
    }
    DI int tok(const g8::Unit& u, int R) const { const int idx = u.x1 * 256 + R; return idx < mc[u.x0] ? TOK[(size_t)u.x0 * NT + idx] : 0; }
};
struct EpiMoe1 {
    static constexpr bool PERM = true;
    bf16_t* HM;
    DI void operator()(const f32x4 (&acc)[2][2][4][2], const g8::Unit& u, int wr, int wc, int fr, int fq) const {
        const int row0 = u.pm * 256 + wr * 64 + fr, col0 = u.pn * 128 + wc * 32 + 8 * fq;
#pragma unroll
        for (int ai = 0; ai < 2; ++ai)
#pragma unroll
            for (int m = 0; m < 4; ++m) {
                float v[8];
#pragma unroll
                for (int i = 0; i < 4; ++i) { v[i] = siluf_(acc[ai][0][m][0][i]) * acc[ai][1][m][0][i]; v[4 + i] = siluf_(acc[ai][0][m][1][i]) * acc[ai][1][m][1][i]; }
                u32x4 w; w.x = pk2(v[0], v[1]); w.y = pk2(v[2], v[3]); w.z = pk2(v[4], v[5]); w.w = pk2(v[6], v[7]);
                *(u32x4*)(HM + (size_t)(row0 + ai * 128 + m * 16) * DEXP + col0) = w;
            }
    }
};
struct EpiMoe2 {
    static constexpr bool PERM = true;
    bf16_t* YB;
    DI void operator()(const f32x4 (&acc)[2][2][4][2], const g8::Unit& u, int wr, int wc, int fr, int fq) const {
        const int row0 = u.pm * 256 + wr * 64 + fr, col0 = u.pn * 256 + wc * 32 + 8 * fq;
#pragma unroll
        for (int ai = 0; ai < 2; ++ai)
#pragma unroll
            for (int m = 0; m < 4; ++m)
#pragma unroll
                for (int bj = 0; bj < 2; ++bj) {
                    const f32x4 v0 = acc[ai][bj][m][0], v1 = acc[ai][bj][m][1];
                    u32x4 w; w.x = pk2(v0[0], v0[1]); w.y = pk2(v0[2], v0[3]); w.z = pk2(v1[0], v1[1]); w.w = pk2(v1[2], v1[3]);
                    *(u32x4*)(YB + (size_t)(row0 + ai * 128 + m * 16) * DM + col0 + bj * 128) = w;
                }
    }
};
DI void phase_moe1(const Params& p, LAS unsigned char* lds, int bid, int G, int l) {
    unsigned char* ws = ows(p);
    moe_tables(p, lds, l);
    MoeSched<2> S{(const char*)(ws + WS_X1B), (const char*)(ws + WS_WGU) + (size_t)l * NEXP * 1024 * DM * 2, (const int*)(ws + WS_TOK), (LAS const int*)(lds + MOE_LDS_OFF), (LAS const int*)(lds + MOE_LDS_OFF) + 32,
                  (size_t)1024 * DM * 2, (size_t)256 * DM * 2, 0, G, bid};
    EpiMoe1 E{(bf16_t*)(ws + WS_HM)};
    g8::gemm_phase<EpiMoe1, MoeSched<2>, true>(lds, DM, DM, DM, S, E);
}
DI void phase_moe2(const Params& p, LAS unsigned char* lds, int bid, int G, int l) {
    unsigned char* ws = ows(p);
    moe_tables(p, lds, l);
    MoeSched<3> S{(const char*)(ws + WS_HM), (const char*)(ws + WS_WD) + (size_t)l * NEXP * DM * DEXP * 2, nullptr, (LAS const int*)(lds + MOE_LDS_OFF), (LAS const int*)(lds + MOE_LDS_OFF) + 32,
                  (size_t)DM * DEXP * 2, (size_t)256 * DEXP * 2, (size_t)256 * DEXP * 2, G, bid};
    EpiMoe2 E{(bf16_t*)(ws + WS_YB)};
    g8::gemm_phase<EpiMoe2, MoeSched<3>, false>(lds, DEXP, DEXP, DEXP, S, E);
}

DI void phase_ln2(const Params& p, LAS unsigned char* lds, int bid, int G, int l) {
    unsigned char* ws = ows(p);
    moe_tables(p, lds, l);
    LAS const int* mp = (LAS const int*)(lds + MOE_LDS_OFF) + 32;
    const int tid = otid(), lane = tid & 63, wave = tid >> 6;
    const float* X1 = (const float*)(ws + WS_Y); const bf16_t* YB = (const bf16_t*)(ws + WS_YB); const int* ROUTE = (const int*)(ws + WS_ROUTE);
    const float* g = p.in[I_LN2G] + l * DM; const float* bt = p.in[I_LN2B] + l * DM;
    float* out = p.out; bf16_t* XB = (bf16_t*)(ws + WS_XB);
    for (int row = bid * 8 + wave; row < NT; row += G * 8) {
        const int* rp = ROUTE + (size_t)row * 8;
        const int e0 = rp[0], pos0 = rp[1], e1 = rp[2], pos1 = rp[3]; const float g0 = __int_as_float(rp[4]), g1 = __int_as_float(rp[5]);
        const size_t s0 = (size_t)(256 * mp[e0] + pos0), s1 = (size_t)(256 * mp[e1] + pos1);
        f32x4 v[8]; float sm = 0.f;
#pragma unroll
        for (int j = 0; j < 8; ++j) {
            const int col = 4 * lane + 256 * j;
            const f32x4 x = *(const f32x4*)(X1 + (size_t)row * DM + col);
            const u32x2 a = *(const u32x2*)(YB + s0 * DM + col), b = *(const u32x2*)(YB + s1 * DM + col);
            const f32x4 ya = {bflo(a.x), bfhi(a.x), bflo(a.y), bfhi(a.y)}, yb = {bflo(b.x), bfhi(b.x), bflo(b.y), bfhi(b.y)};
            v[j] = x * ALPHA + (ya * g0 + yb * g1);
            sm += (v[j].x + v[j].y) + (v[j].z + v[j].w);
        }
        const float mean = wave_sum(sm) * (1.0f / DM); float sq = 0.f;
#pragma unroll
        for (int j = 0; j < 8; ++j) { v[j] = v[j] - mean; sq += (v[j].x * v[j].x + v[j].y * v[j].y) + (v[j].z * v[j].z + v[j].w * v[j].w); }
        const float rstd = 1.0f / sqrtf(wave_sum(sq) * (1.0f / DM) + EPS);
#pragma unroll
        for (int j = 0; j < 8; ++j) {
            const int col = 4 * lane + 256 * j;
            const f32x4 y = v[j] * rstd * *(const f32x4*)(g + col) + *(const f32x4*)(bt + col);
            *(f32x4*)(out + (size_t)row * DM + col) = y;
            *(u32x2*)(XB + (size_t)row * DM + col) = (u32x2){pk2(y.x, y.y), pk2(y.z, y.w)};
        }
    }
}


#define GAS __attribute__((address_space(1)))
typedef GAS unsigned gu32;
#define XB_TMO      128
#define XB_XCNT(j)  (256  + 64 * (j))
#define XB_XSUB(j)  (1280 + 64 * (j))
#define XB_XGEN(j)  (2304 + 64 * (j))
#define XB_TOP      3328
#define XB_TOPGEN   3392
#define XCD_BAR_WORDS 3456
#define XB_SPIN_CAP (1u << 18)

__device__ __forceinline__ unsigned xb_ld(unsigned* p)              { return __hip_atomic_load(p, __ATOMIC_RELAXED, __HIP_MEMORY_SCOPE_AGENT); }
__device__ __forceinline__ unsigned xb_add(unsigned* p, unsigned v) { return __hip_atomic_fetch_add(p, v, __ATOMIC_RELAXED, __HIP_MEMORY_SCOPE_AGENT); }
__device__ __forceinline__ unsigned xb_xcc_id() { return (unsigned)__builtin_amdgcn_s_getreg((3 << 11) | 20) & 0xFu; }
#define XB_SPIN(cond, bar) do { unsigned _sp = 0; while (cond) { __builtin_amdgcn_s_sleep(1); \
    if ((++_sp & 255u) == 0u) { if (xb_ld(&(bar)[XB_TMO])) break; if (_sp > XB_SPIN_CAP) { atomicAdd(&(bar)[XB_TMO], 1u); break; } } } } while (0)

struct XcdBarrier {
    unsigned* bar; unsigned x;
    volatile LAS unsigned* st;
};

__device__ __forceinline__ XcdBarrier xcd_barrier_post(unsigned* bar, volatile LAS unsigned* st) {
    XcdBarrier b; b.bar = bar; b.x = xb_xcc_id(); b.st = st;
    if (threadIdx.x == 0) (void)xb_add(&bar[XB_XCNT(b.x)], 1u);
    return b;
}
__device__ __forceinline__ void xcd_barrier_complete(unsigned* bar, unsigned x, unsigned& nloc, unsigned& nx) {
    const unsigned G = gridDim.x * gridDim.y * gridDim.z;
    unsigned sum, cnt, mine, sp = 0u;
    for (;;) {
        sum = 0u; cnt = 0u; mine = 0u;
#pragma unroll
        for (unsigned j = 0; j < 16; ++j) { const unsigned c = xb_ld(&bar[XB_XCNT(j)]); sum += c; cnt += (c > 0u) ? 1u : 0u; mine = (j == x) ? c : mine; }
        if (sum == G) break;
        __builtin_amdgcn_s_sleep(1);
        if ((++sp & 255u) == 0u) { if (xb_ld(&bar[XB_TMO])) break; if (sp > XB_SPIN_CAP) { atomicAdd(&bar[XB_TMO], 1u); break; } }
    }
    nloc = mine > 0u ? mine : 1u; nx = cnt > 0u ? cnt : 1u;
}

__device__ __forceinline__ void xcd_barrier(const XcdBarrier& b) {
    asm volatile("s_waitcnt vmcnt(0)" ::: "memory");
    __syncthreads();
    if (threadIdx.x == 0) {
        unsigned* bar = b.bar;
        __builtin_amdgcn_s_waitcnt(0);
        unsigned nloc = b.st[0], nx = b.st[1];
        if (nloc == 0u) { xcd_barrier_complete(bar, xb_xcc_id(), nloc, nx); b.st[0] = nloc; b.st[1] = nx; }
        const unsigned bx = xb_xcc_id();
        const unsigned old = xb_add(&bar[XB_XSUB(bx)], 1u);
        const unsigned gen = old / nloc;
        if (old + 1u == (gen + 1u) * nloc) {
            __builtin_amdgcn_fence(__ATOMIC_RELEASE, "agent");
            asm volatile("s_waitcnt vmcnt(0)" ::: "memory");
            const unsigned og = xb_add(&bar[XB_TOP], 1u);
            const unsigned tg = og / nx;
            if (og + 1u == (tg + 1u) * nx) xb_add(&bar[XB_TOPGEN], 1u);
            else XB_SPIN(xb_ld(&bar[XB_TOPGEN]) == tg, bar);
            __builtin_amdgcn_fence(__ATOMIC_ACQUIRE, "agent");
            xb_add(&bar[XB_XGEN(bx)], 1u);
            asm volatile("s_waitcnt vmcnt(0)" ::: "memory");
        } else {
            XB_SPIN(xb_ld(&bar[XB_XGEN(bx)]) == gen, bar);
            __builtin_amdgcn_fence(__ATOMIC_ACQUIRE, "agent");
            asm volatile("s_waitcnt vmcnt(0)" ::: "memory");
        }
    }
    __syncthreads();
}


constexpr int BARST_OFF = MOE_LDS_OFF + 1024;
__global__ void __launch_bounds__(NTHR, 2) mega_fwd(Params p) {
    extern __shared__ __attribute__((aligned(16))) unsigned char lds_[];
    LAS unsigned char* lds = (LAS unsigned char*)lds_;
    const int bid0 = blockIdx.x, G0 = gridDim.x;
    if (threadIdx.x == 0) *(LAS u32x4*)(lds + BARST_OFF) = (u32x4){0u, 0u, 0u, 0u};
    __syncthreads();
    XcdBarrier bar = xcd_barrier_post((unsigned*)(p.ws + WS_CTL) + CW_BAR, (volatile LAS unsigned*)(lds + BARST_OFF));
#define OPQ() do { bid = bid0; G = G0; asm volatile("" : "+s"(bid), "+s"(G)); } while (0)
    int bid, G; OPQ();
    phase_prologue(p, lds, bid, G);
    xcd_barrier(bar);
    for (int l = 0; l < DEPTH; ++l) {
        OPQ(); phase_inproj(p, lds, bid, G, l);
        xcd_barrier(bar);
        OPQ(); phase_krope(p, bid, G, l);
        OPQ(); phase_sgu(p, lds, bid, G, l);
        OPQ(); phase_hgrn_simple(p, lds, bid, G, l);
        __syncthreads();
        OPQ(); phase_mla_proj(p, lds, bid, G, l);
        xcd_barrier(bar);
        OPQ(); phase_hgrn_finish(p, bid, G, l);
        OPQ(); phase_attn(p, lds, bid, G);
        xcd_barrier(bar);
        OPQ(); phase_outproj(p, lds, bid, G, l);
        xcd_barrier(bar);
        OPQ(); phase_ln1_router(p, lds, bid, G, l);
        xcd_barrier(bar);
        OPQ(); phase_moe1(p, lds, bid, G, l);
        xcd_barrier(bar);
        OPQ(); phase_moe2(p, lds, bid, G, l);
        xcd_barrier(bar);
        OPQ(); phase_ln2(p, lds, bid, G, l);
        xcd_barrier(bar);
    }
#undef OPQ
}

extern "C" void kernel_launch(void* const* d_in, const int* in_sizes, int n_in, void* d_out, int out_size, void* d_ws, size_t ws_size, hipStream_t stream) {
    static int grid = 0;
    if (grid == 0) {
        if (n_in != 25 || out_size != NT * DM || ws_size < WS_END) { fprintf(stderr, "kernel_launch: unexpected sizes n_in %d out %d ws %zu (need %zu)\n", n_in, out_size, ws_size, (size_t)WS_END); grid = -1; return; }
        int dev = 0, cus = 0, per_cu = 0;
        if (hipGetDevice(&dev) != hipSuccess || hipDeviceGetAttribute(&cus, hipDeviceAttributeMultiprocessorCount, dev) != hipSuccess) { grid = -1; return; }
        if (hipFuncSetAttribute((const void*)mega_fwd, hipFuncAttributeMaxDynamicSharedMemorySize, LDS_BYTES) != hipSuccess) { fprintf(stderr, "kernel_launch: hipFuncSetAttribute failed\n"); grid = -1; return; }
        if (hipOccupancyMaxActiveBlocksPerMultiprocessor(&per_cu, (const void*)mega_fwd, NTHR, LDS_BYTES) != hipSuccess || per_cu < 1) { fprintf(stderr, "kernel_launch: occupancy query says %d blocks per CU\n", per_cu); (void)hipGetLastError(); grid = -1; return; }
        grid = cus;
    }
    if (grid < 0) return;
    (void)hipMemsetAsync((char*)d_ws + WS_CTL, 0, CTL_BYTES, stream);
    Params p{};
    for (int i = 0; i < 25; ++i) p.in[i] = (const float*)d_in[i];
    p.out = (float*)d_out; p.ws = (unsigned char*)d_ws; p.layer = 0; p.pad = 0;
    hipLaunchKernelGGL(mega_fwd, dim3(grid), dim3(NTHR), LDS_BYTES, stream, p);
}
```

```cpp
#include <hip/hip_runtime.h>
#include <cstdio>
#include <cstdint>

#define DI __device__ __forceinline__
#define LAS __attribute__((address_space(3)))
typedef unsigned short bf16_t;
typedef short bf16x8 __attribute__((ext_vector_type(8)));
typedef short s16x4 __attribute__((ext_vector_type(4)));
typedef float f32x2 __attribute__((ext_vector_type(2)));
typedef float f32x4 __attribute__((ext_vector_type(4)));
typedef float f32x16 __attribute__((ext_vector_type(16)));
typedef unsigned u32x2 __attribute__((ext_vector_type(2)));
typedef unsigned u32x4 __attribute__((ext_vector_type(4)));
typedef __bf16 bf2_t __attribute__((ext_vector_type(2)));

constexpr int DM = 2048, BATCH = 4, SEQ = 4096, NT = BATCH * SEQ, DEPTH = 4;
constexpr int DIN = 4160, DIN_MAIN = 4096;
constexpr int NEXP = 32, DEXP = 512;
constexpr int MAXSLOT = 40960;
constexpr float ALPHA = 1.681792830507429f;
constexpr float EPS = 1e-5f;
constexpr float QSCALE = 0.07216878364870323f * 1.4426950408889634f;

constexpr size_t MiB = 1u << 20;
constexpr size_t al(size_t x) { return (x + MiB - 1) / MiB * MiB; }
constexpr size_t WS_CTL = 0, CTL_BYTES = 1 * MiB;
constexpr size_t WS_WIN = WS_CTL + CTL_BYTES;
constexpr size_t WS_WUQ = WS_WIN + al((size_t)DEPTH * DIN * DM * 2);
constexpr size_t WS_WUK = WS_WUQ + al((size_t)DEPTH * 1536 * 512 * 2);
constexpr size_t WS_WUV = WS_WUK + al((size_t)DEPTH * 1024 * 512 * 2);
constexpr size_t WS_WOUT = WS_WUV + al((size_t)DEPTH * 1024 * 512 * 2);
constexpr size_t WS_WGU = WS_WOUT + al((size_t)DEPTH * DM * DM * 2);
constexpr size_t WS_WD = WS_WGU + al((size_t)DEPTH * NEXP * 1024 * DM * 2);
constexpr size_t WS_SGUW = WS_WD + al((size_t)DEPTH * NEXP * DM * DEXP * 2);
constexpr size_t WS_ROUTW = WS_SGUW + al((size_t)DEPTH * 4 * 128 * 128 * 2);
constexpr size_t WS_ROUTC = WS_ROUTW + al((size_t)DEPTH * 48 * DM * 4);
constexpr size_t WS_LB = WS_ROUTC + MiB;
constexpr size_t WS_COS = WS_LB + MiB;
constexpr size_t WS_XB = WS_COS + al((size_t)NT * 64 * 4);
constexpr size_t WS_Y = WS_XB + al((size_t)NT * DM * 2);
constexpr size_t WS_X1B = WS_Y + al((size_t)NT * DM * 4);
constexpr size_t WS_HB = WS_X1B + al((size_t)NT * DM * 2);
constexpr size_t WS_LOGF = WS_HB + al((size_t)NT * 4096 * 2);
constexpr size_t WS_KR = WS_LOGF + al((size_t)NT * 512 * 4);
constexpr size_t WS_SSQ = WS_KR + al((size_t)NT * 64 * 2);
constexpr size_t WS_Q = WS_SSQ + al((size_t)NT * 16 * 4);
constexpr size_t WS_KN = WS_Q + al((size_t)NT * 1536 * 2);
constexpr size_t WS_VT = WS_KN + al((size_t)NT * 1024 * 2);
constexpr size_t WS_OH = WS_VT + al((size_t)NT * 1024 * 2);
constexpr size_t WS_CAT = WS_OH + al((size_t)NT * 512 * 4);
constexpr size_t WS_ROUTE = WS_CAT + al((size_t)NT * DM * 2);
constexpr size_t WS_TOK = WS_ROUTE + al((size_t)NT * 8 * 4);
constexpr size_t WS_HM = WS_TOK + al((size_t)NEXP * NT * 4);
constexpr size_t WS_YB = WS_HM + al((size_t)MAXSLOT * DEXP * 2);
constexpr size_t WS_END = WS_YB + al((size_t)MAXSLOT * DM * 2);

constexpr int CW_TMO = 0;
constexpr int CW_CNT = 1024;
constexpr int CW_BAR = 8192;

constexpr int MOE_LDS_OFF = 159744;
constexpr int LDS_BYTES = 163840;
constexpr int NTHR = 512;

DI unsigned pk2(float lo, float hi) { bf2_t b = __builtin_convertvector((f32x2){lo, hi}, bf2_t); return __builtin_bit_cast(unsigned, b); }
DI bf16_t f2bf(float f) { return (bf16_t)(pk2(f, 0.f) & 0xffffu); }
DI float bflo(unsigned u) { return __uint_as_float(u << 16); }
DI float bfhi(unsigned u) { return __uint_as_float(u & 0xffff0000u); }
DI float bf2f(bf16_t h) { return __uint_as_float((unsigned)h << 16); }
DI float wave_sum(float v) {
#pragma unroll
    for (int o = 1; o < 64; o <<= 1) v += __shfl_xor(v, o);
    return v;
}
DI int otid() { int t = (int)threadIdx.x; asm volatile("" : "+v"(t)); return t; }
DI float rcp_(float x) { return __builtin_amdgcn_rcpf(x); }
DI float rsq_(float x) { return __builtin_amdgcn_rsqf(x); }
DI float sigmoidf_(float x) { return rcp_(1.0f + __expf(-x)); }
DI float siluf_(float x) { return x * rcp_(1.0f + __expf(-x)); }
DI float geluf_(float x) { const float u = 1.5957691216057308f * (x + 0.044715f * x * x * x); return x * rcp_(1.0f + __expf(-u)); }

struct Params {
    const float* in[25];
    float* out;
    unsigned char* ws;
    int layer;
    int pad;
};
DI unsigned char* ows(const Params& p) { __attribute__((address_space(1))) unsigned char* w = (__attribute__((address_space(1))) unsigned char*)p.ws; asm volatile("" : "+s"(w)); return (unsigned char*)w; }

namespace g8 {
constexpr int BM = 256, BK = 64, HALF = 128, HTB = HALF * BK * 2, STAGE_BYTES = 8 * HTB, NXCD = 8, WGM = 8;
DI int lds_byte(int r, int c) { const int st = (r >> 4) * 2 + (c >> 5), rr = r & 15, cc = c & 31, ob = rr * 64 + cc * 2; return st * 1024 + (ob ^ (((ob >> 9) & 1) << 5)); }
DI void stage_rc(int b, int& R, int& C) { const int st = b / 1024, sb = b % 1024, swz = sb ^ (((sb >> 9) & 1) << 5); R = (st >> 1) * 16 + swz / 64; C = (st & 1) * 32 + (swz % 64) / 2; }
DI int perm32(int rho) { const int n = rho >> 4, i = rho & 15; return 8 * (i >> 2) + 4 * n + (i & 3); }

struct Unit { const char* a; const char* b; int pm, pn, x0, x1; };

struct StaticSched {
    const char* A; const char* Bt; int lda, ldb, nM, nN, nwg, G, c;
    DI void init(const void* A_, const void* Bt_, int M, int N, int lda_, int ldb_, int G_, int c_) { A = (const char*)A_; Bt = (const char*)Bt_; lda = lda_; ldb = ldb_; nM = M / BM; nN = N / BM; nwg = nM * nN; G = G_; c = c_; }
    DI bool next(int i, Unit& u) const {
        const long L = (long)i * G + c; if (L >= nwg) return false;
        int wgid = (int)L; { const int q = nwg / NXCD, r = nwg % NXCD, xcd = wgid % NXCD, off = wgid / NXCD; wgid = (xcd < r ? xcd * (q + 1) : r * (q + 1) + (xcd - r) * q) + off; }
        const int nig = WGM * nN, gid = wgid / nig, fm = gid * WGM, gsz = (nM - fm) < WGM ? (nM - fm) : WGM;
        u.pm = fm + ((wgid % nig) % gsz); u.pn = (wgid % nig) / gsz; u.x0 = 0; u.x1 = 0;
        u.a = A + (size_t)u.pm * BM * lda * 2; u.b = Bt + (size_t)u.pn * BM * ldb * 2; return true;
    }
    DI int tok(const Unit&, int) const { return 0; }
};

template <class Epi, class Sched, bool GATHER>
DI void gemm_phase(LAS unsigned char* lds, const int K, const int lda, const int ldb, const Sched& S, const Epi& E) {
    const int tid = otid(), wid = __builtin_amdgcn_readfirstlane(tid >> 6), lane = tid & 63, wr = wid >> 2, wc = wid & 3, fr = lane & 15, fq = lane >> 4;
    const int nt = K / BK;
    unsigned voffA[2], voffB[2]; int RA[2], CA[2];
#pragma unroll
    for (int i = 0; i < 2; ++i) { int R, C; stage_rc(tid * 16 + i * 8192, R, C); const int Rb = Epi::PERM ? ((R & ~31) + perm32(R & 31)) : R;
        voffA[i] = (unsigned)(R * lda + C) * 2u; voffB[i] = (unsigned)(Rb * ldb + C) * 2u; RA[i] = R; CA[i] = C; }
    const size_t kstep = (size_t)(BK * 2);
    const size_t hstepA = (size_t)HALF * lda * 2, hstep = (size_t)HALF * ldb * 2;
    const unsigned ldsw = (unsigned)wid * 1024u;
    const int aoff = lds_byte(wr * 64 + fr, fq * 8), boff = lds_byte(wc * 32 + fr, fq * 8);
    unsigned gC[2][2], gN[2][2], g2[2][2];
#define G8_SA(b, h) (((b) * 2 + (h)) * HTB)
#define G8_SB(b, h) ((4 + (b) * 2 + (h)) * HTB)
#define G8_DMA(bufoff, ptr, _i) __builtin_amdgcn_global_load_lds((const unsigned*)(ptr), (LAS unsigned*)(lds + (bufoff) + ldsw + (_i) * 8192), 16, 0, 0)
#define G8_STAGE_B(bufoff, gbase) do { _Pragma("unroll") for (int _i = 0; _i < 2; ++_i) G8_DMA(bufoff, (const char*)(gbase) + voffB[_i], _i); } while (0)
#define G8_STAGE_A(bufoff, gbase, h, GO) do { _Pragma("unroll") for (int _i = 0; _i < 2; ++_i) { \
        if constexpr (GATHER) G8_DMA(bufoff, (const char*)(gbase) + GO[h][_i], _i); else G8_DMA(bufoff, (const char*)(gbase) + (h) * hstepA + voffA[_i], _i); } } while (0)
#define G8_LDA(dst, b, h) do { _Pragma("unroll") for (int m = 0; m < 4; ++m) _Pragma("unroll") for (int k = 0; k < 2; ++k) dst[m][k] = *(const LAS bf16x8*)(lds + G8_SA(b, h) + aoff + m * 2048 + k * 1024); } while (0)
#define G8_LDB(dst, b, h) do { _Pragma("unroll") for (int n = 0; n < 2; ++n) _Pragma("unroll") for (int k = 0; k < 2; ++k) dst[n][k] = *(const LAS bf16x8*)(lds + G8_SB(b, h) + boff + n * 2048 + k * 1024); } while (0)
#define G8_MMA(ai, bj, At, Bt) do { __builtin_amdgcn_s_setprio(1); _Pragma("unroll") for (int m = 0; m < 4; ++m) _Pragma("unroll") for (int n = 0; n < 2; ++n) _Pragma("unroll") for (int k = 0; k < 2; ++k) \
        acc[ai][bj][m][n] = __builtin_amdgcn_mfma_f32_16x16x32_bf16(Bt[n][k], At[m][k], acc[ai][bj][m][n], 0, 0, 0); __builtin_amdgcn_s_setprio(0); } while (0)
#define G8_WAIT_V(n) asm volatile("s_waitcnt vmcnt(" #n ")" ::: "memory")
#define G8_WAIT_L(n) asm volatile("s_waitcnt lgkmcnt(" #n ")" ::: "memory")
#define G8_BAR __builtin_amdgcn_s_barrier()
#define G8_SCHED __builtin_amdgcn_sched_barrier(0)
#define G8_GOFF(dst, u) do { if constexpr (GATHER) { _Pragma("unroll") for (int _h = 0; _h < 2; ++_h) _Pragma("unroll") for (int _i = 0; _i < 2; ++_i) \
        dst[_h][_i] = (unsigned)(S.tok(u, _h * HALF + RA[_i]) * lda + CA[_i]) * 2u; } } while (0)
    Unit cur, nxt; int ui = 0;
    if (!S.next(0, cur)) return;
    f32x4 acc[2][2][4][2];
#pragma unroll
    for (int a = 0; a < 2; ++a)
#pragma unroll
        for (int b = 0; b < 2; ++b)
#pragma unroll
            for (int m = 0; m < 4; ++m)
#pragma unroll
                for (int n = 0; n < 2; ++n) acc[a][b][m][n] = (f32x4){0.f, 0.f, 0.f, 0.f};
    bf16x8 At[4][2], B0[2][2], B1[2][2];
    const char* cA = cur.a; const char* cB = cur.b;
#pragma unroll
    for (int h = 0; h < 2; ++h)
#pragma unroll
        for (int i = 0; i < 2; ++i) { gC[h][i] = 0u; gN[h][i] = 0u; g2[h][i] = 0u; }
    G8_GOFF(gC, cur);
    G8_STAGE_B(G8_SB(0, 0), cB); G8_STAGE_B(G8_SB(0, 1), cB + hstep); G8_STAGE_A(G8_SA(0, 0), cA, 0, gC); G8_STAGE_A(G8_SA(0, 1), cA, 1, gC);
    if (wr == 1) G8_BAR;
    G8_WAIT_V(2); G8_BAR;
    G8_STAGE_B(G8_SB(1, 0), cB + kstep); G8_STAGE_A(G8_SA(1, 0), cA + kstep, 0, gC); G8_STAGE_B(G8_SB(1, 1), cB + hstep + kstep);
    G8_WAIT_V(6); G8_BAR;
    for (;;) {
        const bool has_next = S.next(ui + 1, nxt);
        const char* nA = has_next ? nxt.a : cA; const char* nB = has_next ? nxt.b : cB;
        if constexpr (GATHER) { if (has_next) { G8_GOFF(gN, nxt); } else {
#pragma unroll
            for (int h = 0; h < 2; ++h)
#pragma unroll
                for (int i = 0; i < 2; ++i) gN[h][i] = gC[h][i]; } }
        for (int t = 0; t < nt; t += 2) {
            const bool last = (t == nt - 2);
            const char* a1 = cA + (size_t)(t + 1) * kstep;
            const char* a2 = last ? nA : cA + (size_t)(t + 2) * kstep; const char* b2 = last ? nB : cB + (size_t)(t + 2) * kstep;
            const char* a3 = a2 + kstep; const char* b3 = b2 + kstep;
            if constexpr (GATHER) {
#pragma unroll
                for (int h = 0; h < 2; ++h)
#pragma unroll
                    for (int i = 0; i < 2; ++i) g2[h][i] = last ? gN[h][i] : gC[h][i]; }
            G8_LDB(B0, 0, 0); G8_LDB(B1, 0, 1); G8_SCHED; G8_LDA(At, 0, 0); G8_STAGE_A(G8_SA(1, 1), a1, 1, gC);
            G8_WAIT_V(8); G8_WAIT_L(0); G8_BAR; G8_MMA(0, 0, At, B0); G8_MMA(0, 1, At, B1); G8_BAR; G8_SCHED;
            G8_LDA(At, 0, 1); G8_STAGE_B(G8_SB(0, 0), b2); G8_STAGE_B(G8_SB(0, 1), b2 + hstep); G8_STAGE_A(G8_SA(0, 0), a2, 0, g2);
            G8_WAIT_V(8); G8_WAIT_L(0); G8_BAR; G8_MMA(1, 0, At, B0); G8_MMA(1, 1, At, B1); G8_BAR; G8_SCHED;
            G8_LDB(B0, 1, 0); G8_LDB(B1, 1, 1); G8_SCHED; G8_LDA(At, 1, 0); G8_STAGE_A(G8_SA(0, 1), a2, 1, g2);
            G8_WAIT_V(8); G8_WAIT_L(0); G8_BAR; G8_MMA(0, 0, At, B0); G8_MMA(0, 1, At, B1); G8_BAR; G8_SCHED;
            G8_LDA(At, 1, 1); G8_STAGE_B(G8_SB(1, 0), b3); G8_STAGE_B(G8_SB(1, 1), b3 + hstep); G8_STAGE_A(G8_SA(1, 0), a3, 0, g2);
            G8_WAIT_V(8); G8_WAIT_L(0); G8_BAR; G8_MMA(1, 0, At, B0); G8_MMA(1, 1, At, B1); G8_BAR; G8_SCHED;
        }
        if (wr == 0) G8_BAR;
        E(acc, cur, wr, wc, fr, fq);
        if (!has_next) break;
#pragma unroll
        for (int a = 0; a < 2; ++a)
#pragma unroll
            for (int b = 0; b < 2; ++b)
#pragma unroll
                for (int m = 0; m < 4; ++m)
#pragma unroll
                    for (int n = 0; n < 2; ++n) acc[a][b][m][n] = (f32x4){0.f, 0.f, 0.f, 0.f};
        cur = nxt; cA = nA; cB = nB; ++ui;
        if constexpr (GATHER) {
#pragma unroll
            for (int h = 0; h < 2; ++h)
#pragma unroll
                for (int i = 0; i < 2; ++i) gC[h][i] = gN[h][i]; }
        if (wr == 1) G8_BAR;
    }
    G8_WAIT_V(0);
    G8_BAR;
#undef G8_SA
#undef G8_SB
#undef G8_DMA
#undef G8_STAGE_A
#undef G8_STAGE_B
#undef G8_LDA
#undef G8_LDB
#undef G8_MMA
#undef G8_WAIT_V
#undef G8_WAIT_L
#undef G8_BAR
#undef G8_SCHED
#undef G8_GOFF
}
}

enum { I_X = 0, I_POS, I_WIN, I_SGU_LNG, I_SGU_LNB, I_SGU_WS, I_SGU_B, I_LBLOG, I_HNORM, I_QNG, I_WUQ, I_KVNG, I_WUKV, I_WOUT, I_LN1G, I_LN1B,
       I_RGW, I_RGB, I_REW, I_REB, I_EWG, I_EWU, I_EWD, I_LN2G, I_LN2B };

enum { TK_WIN = 0, TK_WUQ, TK_WUKV, TK_WOUT, TK_GATE, TK_UP, TK_DOWN };
DI void transpose_item(const float* W, int K, int N, int kind, bf16_t* dst0, bf16_t* dst1, const float* sc, LAS float* scr, int item, int lane) {
    const int nblk = N / 32, kb = item / nblk, nb = item % nblk, k0 = 64 * kb, n0 = 32 * nb;
#pragma unroll 8
    for (int i = 0; i < 32; ++i) { const int kk = 2 * i + (lane >> 5); scr[kk * 33 + (lane & 31)] = W[(size_t)(k0 + kk) * N + n0 + (lane & 31)]; }
    asm volatile("s_waitcnt lgkmcnt(0)" ::: "memory");
    const int c = lane & 7;
    float s8[8];
#pragma unroll
    for (int i = 0; i < 8; ++i) s8[i] = sc ? sc[k0 + 8 * c + i] : 1.0f;
#pragma unroll
    for (int j = 0; j < 4; ++j) {
        const int nl = (lane >> 3) + 8 * j, n = n0 + nl; const LAS float* s = scr + (8 * c) * 33 + nl;
        u32x4 o; o.x = pk2(s[0 * 33] * s8[0], s[1 * 33] * s8[1]); o.y = pk2(s[2 * 33] * s8[2], s[3 * 33] * s8[3]); o.z = pk2(s[4 * 33] * s8[4], s[5 * 33] * s8[5]); o.w = pk2(s[6 * 33] * s8[6], s[7 * 33] * s8[7]);
        bf16_t* d = dst0; int row = n;
        if (kind == TK_WIN) { if (n >= 4096) { const int jj = n - 4096; row = 4096 + 2 * (jj & 31) + (jj >> 5); } }
        else if (kind == TK_WUQ) { const int h = n / 192, cc = n % 192; if (cc >= 128) { const int jj = cc - 128; row = h * 192 + 128 + 2 * (jj & 31) + (jj >> 5); } }
        else if (kind == TK_WUKV) { const int h = n >> 8, cc = n & 255; if (cc < 128) row = h * 128 + cc; else { d = dst1; row = h * 128 + cc - 128; } }
        else if (kind == TK_GATE) row = (n >> 7) * 256 + (n & 127);
        else if (kind == TK_UP) row = (n >> 7) * 256 + 128 + (n & 127);
        *(u32x4*)(d + (size_t)row * K + k0 + 8 * c) = o;
    }
    asm volatile("s_waitcnt lgkmcnt(0)" ::: "memory");
}

DI void phase_prologue(const Params& p, LAS unsigned char* lds, int bid, int G) {
    const int tid = otid(), lane = tid & 63, wave = tid >> 6;
    unsigned char* ws = ows(p);
    LAS float* scr = (LAS float*)(lds + wave * 16384);
    const int gw = bid * 8 + wave, NGW = G * 8;
    constexpr int IT_WIN = 32 * 130, IT_WUQ = 8 * 48, IT_WUKV = 8 * 64, IT_WOUT = 32 * 64, IT_E = 512, IT_LAYER = IT_WIN + IT_WUQ + IT_WUKV + IT_WOUT + NEXP * 3 * IT_E;
    for (int it = gw; it < DEPTH * IT_LAYER; it += NGW) {
        const int l = it / IT_LAYER; int r = it % IT_LAYER;
        if (r < IT_WIN) { transpose_item(p.in[I_WIN] + (size_t)l * DM * DIN, DM, DIN, TK_WIN, (bf16_t*)(ws + WS_WIN) + (size_t)l * DIN * DM, nullptr, nullptr, scr, r, lane); continue; } r -= IT_WIN;
        if (r < IT_WUQ) { transpose_item(p.in[I_WUQ] + (size_t)l * 512 * 1536, 512, 1536, TK_WUQ, (bf16_t*)(ws + WS_WUQ) + (size_t)l * 1536 * 512, nullptr, p.in[I_QNG] + l * 512, scr, r, lane); continue; } r -= IT_WUQ;
        if (r < IT_WUKV) { transpose_item(p.in[I_WUKV] + (size_t)l * 512 * 2048, 512, 2048, TK_WUKV, (bf16_t*)(ws + WS_WUK) + (size_t)l * 1024 * 512, (bf16_t*)(ws + WS_WUV) + (size_t)l * 1024 * 512, p.in[I_KVNG] + l * 512, scr, r, lane); continue; } r -= IT_WUKV;
        if (r < IT_WOUT) { transpose_item(p.in[I_WOUT] + (size_t)l * DM * DM, DM, DM, TK_WOUT, (bf16_t*)(ws + WS_WOUT) + (size_t)l * DM * DM, nullptr, nullptr, scr, r, lane); continue; } r -= IT_WOUT;
        const int e = r / (3 * IT_E), r2 = r % (3 * IT_E), ty = r2 / IT_E, r3 = r2 % IT_E; const size_t le = (size_t)l * NEXP + e;
        if (ty == 0) transpose_item(p.in[I_EWG] + le * DM * DEXP, DM, DEXP, TK_GATE, (bf16_t*)(ws + WS_WGU) + le * 1024 * DM, nullptr, nullptr, scr, r3, lane);
        else if (ty == 1) transpose_item(p.in[I_EWU] + le * DM * DEXP, DM, DEXP, TK_UP, (bf16_t*)(ws + WS_WGU) + le * 1024 * DM, nullptr, nullptr, scr, r3, lane);
        else transpose_item(p.in[I_EWD] + le * DEXP * DM, DEXP, DM, TK_DOWN, (bf16_t*)(ws + WS_WD) + le * DM * DEXP, nullptr, nullptr, scr, r3, lane);
    }
    const int gt = bid * NTHR + tid, NG = G * NTHR;
    {
        const f32x4* x4 = (const f32x4*)p.in[I_X]; u32x2* xb = (u32x2*)(ws + WS_XB);
        for (int i = gt; i < NT * DM / 4; i += NG) { const f32x4 v = x4[i]; xb[i] = (u32x2){pk2(v.x, v.y), pk2(v.z, v.w)}; }
    }
    {
        float* cs = (float*)(ws + WS_COS); const int* pos = (const int*)p.in[I_POS];
        for (int i = gt; i < NT * 32; i += NG) {
            const int tok = i >> 5, j = i & 31;
            const float inv = 1.0f / powf(10000.0f, (float)(2 * j) / 64.0f);
            const float ang = (float)pos[tok] * inv;
            const double a = (double)ang; const double k = rint(a * 0.15915494309189535); const double rr = a - k * 6.283185307179586476925;
            const float rf = (float)rr;
            cs[i] = cosf(rf); cs[NT * 32 + i] = sinf(rf);
        }
    }
    {
        float* lb = (float*)(ws + WS_LB); const float* lg = p.in[I_LBLOG];
        for (int c = gt; c < 512; c += NG) {
            float v[DEPTH], mx = -3.0e38f;
            for (int l = 0; l < DEPTH; ++l) { v[l] = lg[l * 512 + c]; mx = fmaxf(mx, v[l]); }
            float s = 0.f; for (int l = 0; l < DEPTH; ++l) { v[l] = expf(v[l] - mx); s += v[l]; }
            float cum = 0.f, first = 0.f;
            for (int l = 0; l < DEPTH; ++l) { cum += v[l] / s; if (l == 0) first = cum; lb[l * 512 + c] = cum - first; }
        }
    }
    {
        bf16_t* o = (bf16_t*)(ws + WS_SGUW); const float* w = p.in[I_SGU_WS];
        for (int i = gt; i < DEPTH * 4 * 128 * 128; i += NG) { const int s = i & 127, t = (i >> 7) & 127; o[i] = f2bf(s <= t ? w[i] : 0.f); }
    }
    {
        float* rw = (float*)(ws + WS_ROUTW);
        for (int i = gt; i < DEPTH * 48 * DM; i += NG) {
            const int k = i % DM, n = (i / DM) % 48, l = i / (DM * 48);
            float w = 0.f;
            if (n < 4) w = p.in[I_RGW][((size_t)l * DM + k) * 4 + n]; else if (n < 36) w = p.in[I_REW][((size_t)l * DM + k) * 32 + (n - 4)];
            rw[i] = w * p.in[I_LN1G][l * DM + k];
        }
        float* rc = (float*)(ws + WS_ROUTC);
        for (int it = gw; it < DEPTH * 48; it += NGW) {
            const int l = it / 48, n = it % 48; float s1 = 0.f, s0 = 0.f;
            if (n < 36) for (int k = lane; k < DM; k += 64) {
                const float w = (n < 4) ? p.in[I_RGW][((size_t)l * DM + k) * 4 + n] : p.in[I_REW][((size_t)l * DM + k) * 32 + (n - 4)];
                s1 += w * p.in[I_LN1G][l * DM + k]; s0 += w * p.in[I_LN1B][l * DM + k]; }
            s1 = wave_sum(s1); s0 = wave_sum(s0);
            if (lane == 0) { const float bias = (n < 4) ? p.in[I_RGB][l * 4 + n] : (n < 36 ? p.in[I_REB][l * 32 + n - 4] : 0.f); rc[(l * 2 + 0) * 48 + n] = s0 + bias; rc[(l * 2 + 1) * 48 + n] = s1; }
        }
    }
}

struct EpiInProj {
    static constexpr bool PERM = true;
    bf16_t* HB; float* LOGF; float* SSQ; const float* lb;
    template <int KIND> DI void run(const f32x4 (&acc)[2][2][4][2], const g8::Unit& u, int wr, int wc, int fr, int fq) const {
        const int row0 = u.pm * 256 + wr * 64 + fr, col0 = u.pn * 256 + wc * 32 + 8 * fq;
        float lbv[2][8];
        if constexpr (KIND == 2) {
#pragma unroll
            for (int bj = 0; bj < 2; ++bj)
#pragma unroll
                for (int i = 0; i < 8; ++i) lbv[bj][i] = lb[col0 - 1536 + bj * 128 + i];
        }
#pragma unroll
        for (int ai = 0; ai < 2; ++ai)
#pragma unroll
            for (int m = 0; m < 4; ++m) {
                const int row = row0 + ai * 128 + m * 16; float ssq = 0.f;
#pragma unroll
                for (int bj = 0; bj < 2; ++bj) {
                    float v[8];
#pragma unroll
                    for (int i = 0; i < 4; ++i) { v[i] = acc[ai][bj][m][0][i]; v[4 + i] = acc[ai][bj][m][1][i]; }
                    const int col = col0 + bj * 128;
                    if constexpr (KIND == 0) {
#pragma unroll
                        for (int i = 0; i < 8; ++i) v[i] = geluf_(v[i]);
                    } else if constexpr (KIND == 1) {
#pragma unroll
                        for (int i = 0; i < 8; ++i) v[i] = siluf_(v[i]);
                    } else if constexpr (KIND == 2) {
                        float lf[8];
#pragma unroll
                        for (int i = 0; i < 8; ++i) { const float e = __expf(v[i]), l_ = lbv[bj][i];
                            const float f = l_ + (1.0f - l_) * rcp_(1.0f + __expf(-v[i]));
                            lf[i] = logf(f); v[i] = (1.0f - l_) * rcp_(1.0f + e); }
                        float* lp = LOGF + (size_t)row * 512 + (col - 1536);
                        *(f32x4*)lp = (f32x4){lf[0], lf[1], lf[2], lf[3]}; *(f32x4*)(lp + 4) = (f32x4){lf[4], lf[5], lf[6], lf[7]};
                    } else if constexpr (KIND == 4) {
#pragma unroll
                        for (int i = 0; i < 8; ++i) ssq += v[i] * v[i];
                    }
                    u32x4 w; w.x = pk2(v[0], v[1]); w.y = pk2(v[2], v[3]); w.z = pk2(v[4], v[5]); w.w = pk2(v[6], v[7]);
                    *(u32x4*)(HB + (size_t)row * 4096 + col) = w;
                }
                if constexpr (KIND == 4) {
                    ssq += __shfl_xor(ssq, 16); ssq += __shfl_xor(ssq, 32);
                    if (fq == 0) SSQ[(size_t)row * 16 + (u.pn - 12) * 4 + wc] = ssq;
                }
            }
    }
    DI void operator()(const f32x4 (&acc)[2][2][4][2], const g8::Unit& u, int wr, int wc, int fr, int fq) const {
        const int pn = u.pn;
        if (pn < 4) run<0>(acc, u, wr, wc, fr, fq);
        else if (pn < 6) run<1>(acc, u, wr, wc, fr, fq);
        else if (pn < 8) run<2>(acc, u, wr, wc, fr, fq);
        else if (pn < 10) run<3>(acc, u, wr, wc, fr, fq);
        else if (pn < 12) run<1>(acc, u, wr, wc, fr, fq);
        else run<4>(acc, u, wr, wc, fr, fq);
    }
};
DI void phase_inproj(const Params& p, LAS unsigned char* lds, int bid, int G, int l) {
    unsigned char* ws = ows(p);
    g8::StaticSched S; S.init(ws + WS_XB, (bf16_t*)(ws + WS_WIN) + (size_t)l * DIN * DM, NT, DIN_MAIN, DM, DM, G, bid);
    EpiInProj E{(bf16_t*)(ws + WS_HB), (float*)(ws + WS_LOGF), (float*)(ws + WS_SSQ), (const float*)(ws + WS_LB) + l * 512};
    g8::gemm_phase<EpiInProj, g8::StaticSched, false>(lds, DM, DM, DM, S, E);
}

DI void phase_krope(const Params& p, int bid, int G, int l) {
    unsigned char* ws = ows(p);
    const int tid = otid(), lane = tid & 63, wave = tid >> 6, fr = lane & 15, fq = lane >> 4;
    const bf16_t* X = (const bf16_t*)(ws + WS_XB); const bf16_t* W = (const bf16_t*)(ws + WS_WIN) + ((size_t)l * DIN + 4096) * DM;
    const float* cs = (const float*)(ws + WS_COS); bf16_t* KR = (bf16_t*)(ws + WS_KR);
    for (int task = bid * 8 + wave; task < NT / 16; task += G * 8) {
        const int r0 = task * 16;
        f32x4 acc[4];
#pragma unroll
        for (int n = 0; n < 4; ++n) acc[n] = (f32x4){0.f, 0.f, 0.f, 0.f};
        const bf16_t* ap = X + (size_t)(r0 + fr) * DM + 8 * fq;
        const bf16_t* bp = W + (size_t)fr * DM + 8 * fq;
#pragma unroll 4
        for (int s = 0; s < DM / 32; ++s) {
            const bf16x8 a = *(const bf16x8*)(ap + 32 * s);
#pragma unroll
            for (int n = 0; n < 4; ++n) { const bf16x8 b = *(const bf16x8*)(bp + (size_t)(16 * n) * DM + 32 * s); acc[n] = __builtin_amdgcn_mfma_f32_16x16x32_bf16(a, b, acc[n], 0, 0, 0); }
        }
#pragma unroll
        for (int n = 0; n < 4; ++n)
#pragma unroll
            for (int i = 0; i < 4; ++i) {
                const int row = r0 + 4 * fq + i, col = 16 * n + fr, j = col >> 1;
                const float v = acc[n][i], o = __shfl_xor(v, 1);
                const float c = cs[(size_t)row * 32 + j], s = cs[(size_t)NT * 32 + (size_t)row * 32 + j];
                const float y = (col & 1) ? (v * c + o * s) : (v * c - o * s);
                KR[(size_t)row * 64 + col] = f2bf(y);
            }
    }
}

DI void phase_sgu(const Params& p, LAS unsigned char* lds, int bid, int G, int l) {
    unsigned char* ws = ows(p);
    const int tid = otid(), lane = tid & 63, wave = tid >> 6, fr = lane & 15, fq = lane >> 4;
    const bf16_t* HB = (const bf16_t*)(ws + WS_HB); bf16_t* CAT = (bf16_t*)(ws + WS_CAT);
    const bf16_t* SW = (const bf16_t*)(ws + WS_SGUW) + (size_t)l * 4 * 128 * 128;
    const float* lng = p.in[I_SGU_LNG] + l * 512; const float* lnb = p.in[I_SGU_LNB] + l * 512; const float* sb = p.in[I_SGU_B] + l * 512;
    constexpr int TS = 272;
    LAS unsigned char* T = lds;
    for (int unit = bid; unit < 128 * 4; unit += G) {
        const int ci = unit >> 2, g = unit & 3, rbase = ci * 128;
        __syncthreads();
        for (int rr = 0; rr < 16; ++rr) {
            const int s = wave * 16 + rr, row = rbase + s;
            const u32x4 raw = *(const u32x4*)(HB + (size_t)row * 4096 + 512 + 8 * lane);
            float v[8] = {bflo(raw.x), bfhi(raw.x), bflo(raw.y), bfhi(raw.y), bflo(raw.z), bfhi(raw.z), bflo(raw.w), bfhi(raw.w)};
            float sm = 0.f;
#pragma unroll
            for (int i = 0; i < 8; ++i) sm += v[i];
            const float mean = wave_sum(sm) * (1.0f / 512.0f);
            float sq = 0.f;
#pragma unroll
            for (int i = 0; i < 8; ++i) { v[i] -= mean; sq += v[i] * v[i]; }
            const float rstd = rsq_(wave_sum(sq) * (1.0f / 512.0f) + EPS);
            if ((lane >> 4) == g) {
#pragma unroll
                for (int i = 0; i < 8; ++i) { const int c = 8 * lane + i, d = c & 127; const float y = v[i] * rstd * lng[c] + lnb[c];
                    *(LAS bf16_t*)(T + d * TS + s * 2) = f2bf(y); }
            }
        }
        __syncthreads();
        f32x4 acc[8];
#pragma unroll
        for (int n = 0; n < 8; ++n) acc[n] = (f32x4){0.f, 0.f, 0.f, 0.f};
        const bf16_t* wp = SW + ((size_t)g * 128 + wave * 16 + fr) * 128 + 8 * fq;
        const int ksmax = wave >> 1;
        for (int ks = 0; ks <= ksmax; ++ks) {
            const bf16x8 a = *(const bf16x8*)(wp + 32 * ks);
#pragma unroll
            for (int n = 0; n < 8; ++n) { const bf16x8 b = *(const LAS bf16x8*)(T + (16 * n + fr) * TS + (32 * ks + 8 * fq) * 2); acc[n] = __builtin_amdgcn_mfma_f32_16x16x32_bf16(a, b, acc[n], 0, 0, 0); }
        }
#pragma unroll
        for (int i = 0; i < 4; ++i) {
            const int t = wave * 16 + 4 * fq + i, row = rbase + t; const float bias = sb[g * 128 + t];
#pragma unroll
            for (int n = 0; n < 8; ++n) { const int c = g * 128 + 16 * n + fr; const float uu = bf2f(HB[(size_t)row * 4096 + c]);
                CAT[(size_t)row * DM + c] = f2bf(uu * (acc[n][i] + bias)); }
        }
    }
}

constexpr int HQ_OFF = 0, HK_OFF = 17408, HG_OFF = 34816, HKD_OFF = 52224, HV_OFF = 70656, HP_OFF = 89088, HSEG_OFF = 98304, HDL_OFF = 102400, HSS_OFF = 102912;
constexpr int HS_T = 272, HS_S = 144;
DI void hgrn_stream_unit(const bf16_t* HB, const float* LOGF, const float* ng, bf16_t* CAT, LAS unsigned char* lds, int b, int h, int cfull, int cend) {
    const int tid = otid(), lane = tid & 63, wave = __builtin_amdgcn_readfirstlane(tid >> 6), fr = lane & 15, fq = lane >> 4;
    const int kp = lane, seg = wave;
    f32x4 S[8];
#pragma unroll
    for (int a = 0; a < 8; ++a) S[a] = (f32x4){0.f, 0.f, 0.f, 0.f};
    __syncthreads();
    if (tid < 128) { const int t = (tid < 64) ? (tid >> 2) : 32 + ((tid - 64) >> 2), s0 = ((tid < 64) ? 16 : 48) + 4 * (tid & 3);
        *(LAS u32x2*)(lds + HP_OFF + t * HS_S + s0 * 2) = (u32x2){0u, 0u}; }
#define HG_BAR() do { asm volatile("s_waitcnt lgkmcnt(0)" ::: "memory"); __builtin_amdgcn_s_barrier(); asm volatile("" ::: "memory"); } while (0)
    f32x2 lf[8]; unsigned qr[8], kr[8], vr[8];
    const size_t rowb = (size_t)b * SEQ;
#define HG_LOAD(c) do { _Pragma("unroll") for (int i = 0; i < 8; ++i) { const size_t row = rowb + (c) * 64 + 8 * seg + i; \
        lf[i] = *(const f32x2*)(LOGF + row * 512 + h * 128 + 2 * kp); const bf16_t* hp = HB + row * 4096 + h * 128 + 2 * kp; \
        qr[i] = *(const unsigned*)(hp + 1024); kr[i] = *(const unsigned*)(hp + 1536); vr[i] = *(const unsigned*)(hp + 2048); } } while (0)
    HG_LOAD(0);
    for (int c = 0; c < cend; ++c) {
        const bool full = c >= cfull;
        { float c0 = 0.f, c1 = 0.f;
#pragma unroll
          for (int i = 0; i < 8; ++i) { c0 += lf[i].x; c1 += lf[i].y; lf[i].x = c0; lf[i].y = c1; }
          *(LAS f32x2*)(lds + HSEG_OFF + (seg * 128 + 2 * kp) * 4) = (f32x2){c0, c1}; }
        HG_BAR();
        { f32x2 off = {0.f, 0.f}, R = {0.f, 0.f}, GL = {0.f, 0.f};
#pragma unroll
          for (int j = 0; j < 8; ++j) { const f32x2 tj = *(const LAS f32x2*)(lds + HSEG_OFF + (j * 128 + 2 * kp) * 4); if (j < seg) off += tj; if (j < 4) R += tj; GL += tj; }
          const f32x2 eR = {__expf(R.x), __expf(R.y)}, eGR = {__expf(GL.x - R.x), __expf(GL.y - R.y)};
          float kd0[8], kd1[8];
#pragma unroll
          for (int i = 0; i < 8; ++i) {
              const int t = 8 * seg + i; const float g0 = off.x + lf[i].x, g1 = off.y + lf[i].y;
              const float e10 = __expf(g0 - R.x), e11 = __expf(g1 - R.y), e20 = __expf(R.x - g0), e21 = __expf(R.y - g1), e30 = e10 * eR.x, e31 = e11 * eR.y, e40 = e20 * eGR.x, e41 = e21 * eGR.y;
              const float q0 = bflo(qr[i]), q1 = bfhi(qr[i]), k0 = bflo(kr[i]), k1 = bfhi(kr[i]);
              if (full) {
              *(LAS unsigned*)(lds + HQ_OFF + t * HS_T + kp * 4) = pk2(q0 * e10, q1 * e11);
              *(LAS unsigned*)(lds + HK_OFF + t * HS_T + kp * 4) = pk2(k0 * e20, k1 * e21);
              *(LAS unsigned*)(lds + HG_OFF + t * HS_T + kp * 4) = pk2(q0 * e30, q1 * e31); }
              kd0[i] = k0 * e40; kd1[i] = k1 * e41;
          }
          *(LAS u32x4*)(lds + HKD_OFF + (2 * kp) * HS_S + 16 * seg) = (u32x4){pk2(kd0[0], kd0[1]), pk2(kd0[2], kd0[3]), pk2(kd0[4], kd0[5]), pk2(kd0[6], kd0[7])};
          *(LAS u32x4*)(lds + HKD_OFF + (2 * kp + 1) * HS_S + 16 * seg) = (u32x4){pk2(kd1[0], kd1[1]), pk2(kd1[2], kd1[3]), pk2(kd1[4], kd1[5]), pk2(kd1[6], kd1[7])};
          u32x4 v0, v1;
          v0.x = (vr[0] & 0xffffu) | (vr[1] << 16); v0.y = (vr[2] & 0xffffu) | (vr[3] << 16); v0.z = (vr[4] & 0xffffu) | (vr[5] << 16); v0.w = (vr[6] & 0xffffu) | (vr[7] << 16);
          v1.x = (vr[0] >> 16) | (vr[1] & 0xffff0000u); v1.y = (vr[2] >> 16) | (vr[3] & 0xffff0000u); v1.z = (vr[4] >> 16) | (vr[5] & 0xffff0000u); v1.w = (vr[6] >> 16) | (vr[7] & 0xffff0000u);
          *(LAS u32x4*)(lds + HV_OFF + (2 * kp) * HS_S + 16 * seg) = v0;
          *(LAS u32x4*)(lds + HV_OFF + (2 * kp + 1) * HS_S + 16 * seg) = v1;
          if (seg == 0) *(LAS f32x2*)(lds + HDL_OFF + 2 * kp * 4) = (f32x2){__expf(GL.x), __expf(GL.y)};
        }
        if (c + 1 < cend) HG_LOAD(c + 1);
        u32x4 gsr[2] = {(u32x4){0u, 0u, 0u, 0u}, (u32x4){0u, 0u, 0u, 0u}};
        if (full) {
#pragma unroll
        for (int jj = 0; jj < 2; ++jj) gsr[jj] = *(const u32x4*)(HB + (rowb + c * 64 + (lane >> 1) + 32 * jj) * 4096 + 2560 + h * 128 + 16 * wave + 8 * (lane & 1));
        }
        HG_BAR();
        if (full) {
        for (int rep = 0; rep < 2; ++rep) {
            const int idx = wave + 8 * rep; if (idx >= 10) break;
            const int a = (int)((0x3221110000ULL >> (4 * idx)) & 0xf), bt = (int)((0x3323213210ULL >> (4 * idx)) & 0xf);
            f32x4 pacc = {0.f, 0.f, 0.f, 0.f};
#pragma unroll
            for (int ks = 0; ks < 4; ++ks) {
                const bf16x8 af = *(const LAS bf16x8*)(lds + HK_OFF + (16 * a + fr) * HS_T + (32 * ks + 8 * fq) * 2);
                const bf16x8 bf = *(const LAS bf16x8*)(lds + HQ_OFF + (16 * bt + fr) * HS_T + (32 * ks + 8 * fq) * 2);
                pacc = __builtin_amdgcn_mfma_f32_16x16x32_bf16(af, bf, pacc, 0, 0, 0);
            }
            const int t = 16 * bt + fr, s0 = 16 * a + 4 * fq;
#pragma unroll
            for (int i = 0; i < 4; ++i) if (s0 + i > t) pacc[i] = 0.f;
            *(LAS u32x2*)(lds + HP_OFF + t * HS_S + s0 * 2) = (u32x2){pk2(pacc[0], pacc[1]), pk2(pacc[2], pacc[3])};
        }
        HG_BAR();
        }
        f32x4 o[4];
#pragma unroll
        for (int bt = 0; bt < 4; ++bt) o[bt] = (f32x4){0.f, 0.f, 0.f, 0.f};
        {
            bf16x8 sf[4];
#pragma unroll
            for (int a2 = 0; a2 < 4; ++a2) { const u32x4 w = {pk2(S[2 * a2][0], S[2 * a2][1]), pk2(S[2 * a2][2], S[2 * a2][3]), pk2(S[2 * a2 + 1][0], S[2 * a2 + 1][1]), pk2(S[2 * a2 + 1][2], S[2 * a2 + 1][3])}; sf[a2] = __builtin_bit_cast(bf16x8, w); }
            bf16x8 vf[2];
#pragma unroll
            for (int ss = 0; ss < 2; ++ss) vf[ss] = *(const LAS bf16x8*)(lds + HV_OFF + (16 * wave + fr) * HS_S + (32 * ss + 8 * fq) * 2);
            if (full) {
#pragma unroll
            for (int bt = 0; bt < 4; ++bt) {
                f32x4 acc = {0.f, 0.f, 0.f, 0.f};
#pragma unroll
                for (int ss = 0; ss < 2; ++ss) if (32 * ss <= 16 * bt + 15) {
                    const bf16x8 pf = *(const LAS bf16x8*)(lds + HP_OFF + (16 * bt + fr) * HS_S + (32 * ss + 8 * fq) * 2);
                    acc = __builtin_amdgcn_mfma_f32_16x16x32_bf16(pf, vf[ss], acc, 0, 0, 0);
                }
#pragma unroll
                for (int a2 = 0; a2 < 4; ++a2) {
                    const LAS unsigned char* gp = lds + HG_OFF + (16 * bt + fr) * HS_T + (32 * a2 + 4 * fq) * 2;
                    const u32x2 lo = *(const LAS u32x2*)gp, hi = *(const LAS u32x2*)(gp + 32);
                    const u32x4 w = {lo.x, lo.y, hi.x, hi.y};
                    acc = __builtin_amdgcn_mfma_f32_16x16x32_bf16(__builtin_bit_cast(bf16x8, w), sf[a2], acc, 0, 0, 0);
                }
                o[bt] = acc;
            }
            }
#pragma unroll
            for (int a = 0; a < 8; ++a) {
                const f32x4 dl = *(const LAS f32x4*)(lds + HDL_OFF + (16 * a + 4 * fq) * 4);
                f32x4 acc = S[a] * dl;
#pragma unroll
                for (int ss = 0; ss < 2; ++ss) {
                    const bf16x8 kf = *(const LAS bf16x8*)(lds + HKD_OFF + (16 * a + fr) * HS_S + (32 * ss + 8 * fq) * 2);
                    acc = __builtin_amdgcn_mfma_f32_16x16x32_bf16(kf, vf[ss], acc, 0, 0, 0);
                }
                S[a] = acc;
            }
        }
        if (!full) continue;
        LAS unsigned char* ot = lds + HQ_OFF + wave * 4096;
#pragma unroll
        for (int bt = 0; bt < 4; ++bt)
#pragma unroll
            for (int i = 0; i < 4; ++i) *(LAS float*)(ot + (16 * bt + 4 * fq + i) * 64 + fr * 4) = o[bt][i];
        asm volatile("s_waitcnt lgkmcnt(0)" ::: "memory");
        f32x4 orow[2][2];
#pragma unroll
        for (int jj = 0; jj < 2; ++jj) {
            const LAS unsigned char* rp = ot + ((lane >> 1) + 32 * jj) * 64 + (lane & 1) * 32;
            orow[jj][0] = *(const LAS f32x4*)rp; orow[jj][1] = *(const LAS f32x4*)(rp + 16);
            const f32x4 a = orow[jj][0], bb = orow[jj][1];
            float q2 = (a.x * a.x + a.y * a.y) + (a.z * a.z + a.w * a.w) + (bb.x * bb.x + bb.y * bb.y) + (bb.z * bb.z + bb.w * bb.w);
            q2 += __shfl_xor(q2, 1);
            if ((lane & 1) == 0) *(LAS float*)(lds + HSS_OFF + (((lane >> 1) + 32 * jj) * 8 + wave) * 4) = q2;
        }
        HG_BAR();
        {
            const int v0 = h * 128 + 16 * wave + 8 * (lane & 1);
            const f32x4 gn0 = *(const f32x4*)(ng + v0), gn1 = *(const f32x4*)(ng + v0 + 4);
#pragma unroll
            for (int jj = 0; jj < 2; ++jj) {
                const int t = (lane >> 1) + 32 * jj;
                const LAS float* sp = (const LAS float*)(lds + HSS_OFF + t * 32);
                const f32x4 s0 = *(const LAS f32x4*)sp, s1 = *(const LAS f32x4*)(sp + 4);
                const float ssum = (s0.x + s0.y) + (s0.z + s0.w) + (s1.x + s1.y) + (s1.z + s1.w);
                const float rstd = rsq_(ssum * (1.0f / 128.0f) + EPS);
                const u32x4 g = gsr[jj];
                const f32x4 y0 = orow[jj][0] * rstd * gn0 * (f32x4){bflo(g.x), bfhi(g.x), bflo(g.y), bfhi(g.y)};
                const f32x4 y1 = orow[jj][1] * rstd * gn1 * (f32x4){bflo(g.z), bfhi(g.z), bflo(g.w), bfhi(g.w)};
                *(u32x4*)(CAT + (rowb + c * 64 + t) * DM + 512 + v0) = (u32x4){pk2(y0.x, y0.y), pk2(y0.z, y0.w), pk2(y1.x, y1.y), pk2(y1.z, y1.w)};
            }
        }
    }
#undef HG_LOAD
}

DI float rstd_from_ssq(const float* SSQ, int row, int which) {
    const f32x4 a = *(const f32x4*)(SSQ + (size_t)row * 16 + which * 8), b = *(const f32x4*)(SSQ + (size_t)row * 16 + which * 8 + 4);
    const float s = (a.x + a.y) + (a.z + a.w) + (b.x + b.y) + (b.z + b.w);
    return rsq_(s * (1.0f / 512.0f) + EPS);
}
struct EpiQ {
    static constexpr bool PERM = true;
    bf16_t* Q; const float* SSQ; const float* cs;
    DI void operator()(const f32x4 (&acc)[2][2][4][2], const g8::Unit& u, int wr, int wc, int fr, int fq) const {
        const int row0 = u.pm * 256 + wr * 64 + fr, col0 = u.pn * 256 + wc * 32 + 8 * fq;
#pragma unroll
        for (int ai = 0; ai < 2; ++ai)
#pragma unroll
            for (int m = 0; m < 4; ++m) {
                const int row = row0 + ai * 128 + m * 16; const float sc = rstd_from_ssq(SSQ, row, 0) * QSCALE;
#pragma unroll
                for (int bj = 0; bj < 2; ++bj) {
                    const int col = col0 + bj * 128, cc = col % 192;
                    float v[8];
#pragma unroll
                    for (int i = 0; i < 4; ++i) { v[i] = acc[ai][bj][m][0][i] * sc; v[4 + i] = acc[ai][bj][m][1][i] * sc; }
                    if (cc >= 128) {
                        const int j0 = (cc - 128) >> 1;
                        const f32x4 c = *(const f32x4*)(cs + (size_t)row * 32 + j0), s = *(const f32x4*)(cs + (size_t)NT * 32 + (size_t)row * 32 + j0);
#pragma unroll
                        for (int i = 0; i < 4; ++i) { const float x1 = v[2 * i], x2 = v[2 * i + 1]; v[2 * i] = x1 * c[i] - x2 * s[i]; v[2 * i + 1] = x2 * c[i] + x1 * s[i]; }
                    }
                    u32x4 w; w.x = pk2(v[0], v[1]); w.y = pk2(v[2], v[3]); w.z = pk2(v[4], v[5]); w.w = pk2(v[6], v[7]);
                    *(u32x4*)(Q + (size_t)row * 1536 + col) = w;
                }
            }
    }
};
struct EpiK {
    static constexpr bool PERM = true;
    bf16_t* KN; const float* SSQ;
    DI void operator()(const f32x4 (&acc)[2][2][4][2], const g8::Unit& u, int wr, int wc, int fr, int fq) const {
        const int row0 = u.pm * 256 + wr * 64 + fr, col0 = u.pn * 256 + wc * 32 + 8 * fq;
#pragma unroll
        for (int ai = 0; ai < 2; ++ai)
#pragma unroll
            for (int m = 0; m < 4; ++m) {
                const int row = row0 + ai * 128 + m * 16; const float sc = rstd_from_ssq(SSQ, row, 1);
#pragma unroll
                for (int bj = 0; bj < 2; ++bj) {
                    const f32x4 v0 = acc[ai][bj][m][0] * sc, v1 = acc[ai][bj][m][1] * sc;
                    u32x4 w; w.x = pk2(v0[0], v0[1]); w.y = pk2(v0[2], v0[3]); w.z = pk2(v1[0], v1[1]); w.w = pk2(v1[2], v1[3]);
                    *(u32x4*)(KN + (size_t)row * 1024 + col0 + bj * 128) = w;
                }
            }
    }
};
struct EpiVT {
    static constexpr bool PERM = true;
    bf16_t* VT; const float* SSQ;
    DI void operator()(const f32x4 (&acc)[2][2][4][2], const g8::Unit& u, int wr, int wc, int fr, int fq) const {
        const int row0 = u.pm * 256 + wr * 64 + fr, col0 = u.pn * 256 + wc * 32 + 8 * fq;
        float sc[2][8];
#pragma unroll
        for (int bj = 0; bj < 2; ++bj)
#pragma unroll
            for (int i = 0; i < 8; ++i) sc[bj][i] = rstd_from_ssq(SSQ, col0 + bj * 128 + i, 1);
#pragma unroll
        for (int ai = 0; ai < 2; ++ai)
#pragma unroll
            for (int m = 0; m < 4; ++m) {
                const int row = row0 + ai * 128 + m * 16, h = row >> 7, d = row & 127;
#pragma unroll
                for (int bj = 0; bj < 2; ++bj) {
                    const int tok = col0 + bj * 128, b = tok >> 12, s = tok & 4095;
                    const f32x4 a0 = acc[ai][bj][m][0], a1 = acc[ai][bj][m][1];
                    u32x4 w; w.x = pk2(a0[0] * sc[bj][0], a0[1] * sc[bj][1]); w.y = pk2(a0[2] * sc[bj][2], a0[3] * sc[bj][3]);
                    w.z = pk2(a1[0] * sc[bj][4], a1[1] * sc[bj][5]); w.w = pk2(a1[2] * sc[bj][6], a1[3] * sc[bj][7]);
                    *(u32x4*)(VT + ((size_t)((b * 8 + h) * 128 + d)) * SEQ + s) = w;
                }
            }
    }
};
DI void phase_mla_proj(const Params& p, LAS unsigned char* lds, int bid, int G, int l) {
    unsigned char* ws = ows(p);
    const float* SSQ = (const float*)(ws + WS_SSQ); const bf16_t* HB = (const bf16_t*)(ws + WS_HB);
    {
        g8::StaticSched S; S.init(HB + 3072, (const bf16_t*)(ws + WS_WUQ) + (size_t)l * 1536 * 512, NT, 1536, 4096, 512, G, bid);
        EpiQ E{(bf16_t*)(ws + WS_Q), SSQ, (const float*)(ws + WS_COS)};
        g8::gemm_phase<EpiQ, g8::StaticSched, false>(lds, 512, 4096, 512, S, E);
    }
    {
        g8::StaticSched S; S.init(HB + 3584, (const bf16_t*)(ws + WS_WUK) + (size_t)l * 1024 * 512, NT, 1024, 4096, 512, G, bid);
        EpiK E{(bf16_t*)(ws + WS_KN), SSQ};
        g8::gemm_phase<EpiK, g8::StaticSched, false>(lds, 512, 4096, 512, S, E);
    }
    {
        g8::StaticSched S; S.init((const bf16_t*)(ws + WS_WUV) + (size_t)l * 1024 * 512, HB + 3584, 1024, NT, 512, 4096, G, bid);
        EpiVT E{(bf16_t*)(ws + WS_VT), SSQ};
        g8::gemm_phase<EpiVT, g8::StaticSched, false>(lds, 512, 512, 4096, S, E);
    }
}

constexpr int AT_KS = 400, AT_VS = 144;
constexpr int AT_KBUF = 64 * AT_KS, AT_VBUF = 128 * AT_VS;
DI void attn_unit(const bf16_t* Qg, const bf16_t* KNg, const bf16_t* KRg, const bf16_t* VTg, bf16_t* CAT, LAS unsigned char* lds, int b, int h, int qb) {
    const int tid = otid(), lane = tid & 63, wave = __builtin_amdgcn_readfirstlane(tid >> 6), c = lane & 31, hi = lane >> 5;
    const int q0 = qb * 256, qmin = q0 + 32 * wave, qrow = qmin + c, ntile = 4 * (qb + 1), jmax = (qmin + 31) >> 6;
    LAS unsigned char* Kb = lds; LAS unsigned char* Vb = lds + 2 * AT_KBUF;
    bf16x8 qf[12];
    { const bf16_t* qp = Qg + (size_t)(b * SEQ + qrow) * 1536 + h * 192 + 8 * hi;
#pragma unroll
      for (int ks = 0; ks < 12; ++ks) qf[ks] = *(const bf16x8*)(qp + 16 * ks); }
    f32x16 o[4];
#pragma unroll
    for (int d = 0; d < 4; ++d)
#pragma unroll
        for (int r = 0; r < 16; ++r) o[d][r] = 0.f;
    float m_run = -1.0e30f, l_run = 0.f;
    int ksrc_off[3], kdst[3]; bool kfromR[3];
#pragma unroll
    for (int i = 0; i < 3; ++i) { const int id = tid + 512 * i, key = id / 24, cc = id % 24; kdst[i] = key * AT_KS + cc * 16; kfromR[i] = cc >= 16;
        ksrc_off[i] = kfromR[i] ? (key * 64 + 8 * (cc - 16)) : (key * 1024 + h * 128 + 8 * cc); }
    int vsrc_off[2], vdst[2];
#pragma unroll
    for (int i = 0; i < 2; ++i) { const int id = tid + 512 * i, d = id >> 3, cc = id & 7; vdst[i] = d * AT_VS + cc * 16; vsrc_off[i] = d * SEQ + 8 * cc; }
    const bf16_t* KNb = KNg + (size_t)b * SEQ * 1024; const bf16_t* KRb = KRg + (size_t)b * SEQ * 64; const bf16_t* VTb = VTg + (size_t)(b * 8 + h) * 128 * SEQ;
    u32x4 kreg[3], vreg[2];
#define AT_LOAD(j) do { _Pragma("unroll") for (int i = 0; i < 3; ++i) kreg[i] = kfromR[i] ? *(const u32x4*)(KRb + (size_t)(j) * 64 * 64 + ksrc_off[i]) : *(const u32x4*)(KNb + (size_t)(j) * 64 * 1024 + ksrc_off[i]); \
                        _Pragma("unroll") for (int i = 0; i < 2; ++i) vreg[i] = *(const u32x4*)(VTb + (size_t)(j) * 64 + vsrc_off[i]); } while (0)
#define AT_STORE(buf) do { _Pragma("unroll") for (int i = 0; i < 3; ++i) *(LAS u32x4*)(Kb + (buf) * AT_KBUF + kdst[i]) = kreg[i]; \
                           _Pragma("unroll") for (int i = 0; i < 2; ++i) *(LAS u32x4*)(Vb + (buf) * AT_VBUF + vdst[i]) = vreg[i]; } while (0)
    __syncthreads();
    AT_LOAD(0); AT_STORE(0);
    __syncthreads();
    for (int j = 0; j < ntile; ++j) {
        const int buf = j & 1;
        if (j + 1 < ntile) AT_LOAD(j + 1);
        if (j <= jmax) {
            const LAS unsigned char* kb_ = Kb + buf * AT_KBUF + c * AT_KS + 16 * hi;
            f32x16 s0, s1;
#pragma unroll
            for (int r = 0; r < 16; ++r) { s0[r] = 0.f; s1[r] = 0.f; }
#pragma unroll
            for (int ks = 0; ks < 12; ++ks) {
                const bf16x8 a0 = *(const LAS bf16x8*)(kb_ + 32 * ks), a1 = *(const LAS bf16x8*)(kb_ + 32 * AT_KS + 32 * ks);
                s0 = __builtin_amdgcn_mfma_f32_32x32x16_bf16(a0, qf[ks], s0, 0, 0, 0);
                s1 = __builtin_amdgcn_mfma_f32_32x32x16_bf16(a1, qf[ks], s1, 0, 0, 0);
            }
            if (64 * j + 63 > qmin) {
                const int dq = qrow - 64 * j - 4 * hi;
#pragma unroll
                for (int r = 0; r < 16; ++r) { const int kk = (r & 3) + 8 * (r >> 2);
                    if (kk > dq) s0[r] = -__builtin_inff();
                    if (kk + 32 > dq) s1[r] = -__builtin_inff(); }
            }
            float mx = s0[0];
#pragma unroll
            for (int r = 1; r < 16; ++r) mx = fmaxf(mx, s0[r]);
#pragma unroll
            for (int r = 0; r < 16; ++r) mx = fmaxf(mx, s1[r]);
            mx = fmaxf(mx, __shfl_xor(mx, 32));
            const float m_new = fmaxf(m_run, mx), alpha = __builtin_amdgcn_exp2f(m_run - m_new);
            m_run = m_new;
            float ps = 0.f;
#pragma unroll
            for (int r = 0; r < 16; ++r) { s0[r] = __builtin_amdgcn_exp2f(s0[r] - m_new); s1[r] = __builtin_amdgcn_exp2f(s1[r] - m_new); ps += s0[r] + s1[r]; }
            l_run = l_run * alpha + ps;
#pragma unroll
            for (int d = 0; d < 4; ++d)
#pragma unroll
                for (int r = 0; r < 16; ++r) o[d][r] *= alpha;
            bf16x8 pb[4];
#pragma unroll
            for (int s2 = 0; s2 < 2; ++s2) {
                u32x4 w0, w1;
                w0.x = pk2(s0[8 * s2 + 0], s0[8 * s2 + 1]); w0.y = pk2(s0[8 * s2 + 2], s0[8 * s2 + 3]); w0.z = pk2(s0[8 * s2 + 4], s0[8 * s2 + 5]); w0.w = pk2(s0[8 * s2 + 6], s0[8 * s2 + 7]);
                w1.x = pk2(s1[8 * s2 + 0], s1[8 * s2 + 1]); w1.y = pk2(s1[8 * s2 + 2], s1[8 * s2 + 3]); w1.z = pk2(s1[8 * s2 + 4], s1[8 * s2 + 5]); w1.w = pk2(s1[8 * s2 + 6], s1[8 * s2 + 7]);
                pb[s2] = __builtin_bit_cast(bf16x8, w0); pb[2 + s2] = __builtin_bit_cast(bf16x8, w1);
            }
            const LAS unsigned char* vb_ = Vb + buf * AT_VBUF + c * AT_VS + 8 * hi;
#pragma unroll
            for (int d = 0; d < 4; ++d)
#pragma unroll
                for (int kk = 0; kk < 4; ++kk) {
                    const LAS unsigned char* vp = vb_ + d * 32 * AT_VS + kk * 32;
                    const u32x2 lo = *(const LAS u32x2*)vp, hi2 = *(const LAS u32x2*)(vp + 16);
                    const u32x4 av = {lo.x, lo.y, hi2.x, hi2.y};
                    o[d] = __builtin_amdgcn_mfma_f32_32x32x16_bf16(__builtin_bit_cast(bf16x8, av), pb[kk], o[d], 0, 0, 0);
                }
        }
        if (j + 1 < ntile) AT_STORE(buf ^ 1);
        __syncthreads();
    }
#undef AT_LOAD
#undef AT_STORE
    const float l_tot = l_run + __shfl_xor(l_run, 32), inv = 1.0f / l_tot;
    bf16_t* op = CAT + (size_t)(b * SEQ + qrow) * DM + 1024 + h * 128 + 4 * hi;
#pragma unroll
    for (int d = 0; d < 4; ++d)
#pragma unroll
        for (int g = 0; g < 4; ++g) {
            const u32x2 w = {pk2(o[d][4 * g] * inv, o[d][4 * g + 1] * inv), pk2(o[d][4 * g + 2] * inv, o[d][4 * g + 3] * inv)};
            *(u32x2*)(op + 32 * d + 8 * g) = w;
        }
}
constexpr int CW_QUEUE = 4096;
constexpr int QWORD_OFF = MOE_LDS_OFF + 2048;
DI void phase_attn_hgrn(const Params& p, LAS unsigned char* lds, int l) {
    unsigned char* ws = ows(p);
    const bf16_t* Q = (const bf16_t*)(ws + WS_Q); const bf16_t* KN = (const bf16_t*)(ws + WS_KN); const bf16_t* KR = (const bf16_t*)(ws + WS_KR); const bf16_t* VT = (const bf16_t*)(ws + WS_VT);
    const bf16_t* HB = (const bf16_t*)(ws + WS_HB); const float* LOGF = (const float*)(ws + WS_LOGF);
    bf16_t* CAT = (bf16_t*)(ws + WS_CAT);
    unsigned* qh = (unsigned*)(ws + WS_CTL) + CW_QUEUE + l * 8 * 16;
    const int x0 = (int)(__builtin_amdgcn_s_getreg((3 << 11) | 20) & 7u);
    for (int dx = 0; dx < 8; ++dx) {
        const int x = (x0 + dx) & 7;
        for (;;) {
            __syncthreads();
            if (threadIdx.x == 0) *(LAS unsigned*)(lds + QWORD_OFF) = atomicAdd(qh + x * 16, 1u);
            __syncthreads();
            const int idx = (int)*(LAS unsigned*)(lds + QWORD_OFF);
            if (idx >= 68) break;
            if (idx < 4) { const int bh = 2 * x + (idx & 1); if (idx < 2) hgrn_stream_unit(HB, LOGF, p.in[I_HNORM] + l * 512, CAT, lds, bh >> 2, bh & 3, 32, 64);
                           else hgrn_stream_unit(HB, LOGF, p.in[I_HNORM] + l * 512, CAT, lds, bh >> 2, bh & 3, 0, 32); }
            else { const int j = idx - 4, bh = 4 * x + (j & 3), qb = 15 - (j >> 2); attn_unit(Q, KN, KR, VT, CAT, lds, bh >> 3, bh & 7, qb); }
        }
    }
}

struct EpiOut {
    static constexpr bool PERM = false;
    const float* xres; float* Y;
    DI void operator()(const f32x4 (&acc)[2][2][4][2], const g8::Unit& u, int wr, int wc, int fr, int fq) const {
        const int row0 = u.pm * 256 + wr * 64 + fr, col0 = u.pn * 256 + wc * 32 + 4 * fq;
#pragma unroll
        for (int ai = 0; ai < 2; ++ai)
#pragma unroll
            for (int m = 0; m < 4; ++m) {
                const size_t rb = (size_t)(row0 + ai * 128 + m * 16) * DM;
#pragma unroll
                for (int bj = 0; bj < 2; ++bj)
#pragma unroll
                    for (int n = 0; n < 2; ++n) { const int col = col0 + bj * 128 + 16 * n; const f32x4 x = *(const f32x4*)(xres + rb + col); *(f32x4*)(Y + rb + col) = x * ALPHA + acc[ai][bj][m][n]; }
            }
    }
};
DI void phase_outproj(const Params& p, LAS unsigned char* lds, int bid, int G, int l) {
    unsigned char* ws = ows(p);
    g8::StaticSched S; S.init(ws + WS_CAT, (const bf16_t*)(ws + WS_WOUT) + (size_t)l * DM * DM, NT, DM, DM, DM, G, bid);
    EpiOut E{l == 0 ? p.in[I_X] : p.out, (float*)(ws + WS_Y)};
    g8::gemm_phase<EpiOut, g8::StaticSched, false>(lds, DM, DM, DM, S, E);
}

constexpr int L1_RS = 8208;
constexpr int L1_PART = 16 * L1_RS, L1_STAT = L1_PART + 8 * 16 * 48 * 4, L1_LG = L1_STAT + 128;
static_assert(L1_LG + 16 * 48 * 4 <= MOE_LDS_OFF, "ln1 LDS map");
DI void phase_ln1_router(const Params& p, LAS unsigned char* lds, int bid, int G, int l) {
    unsigned char* ws = ows(p);
    const int tid = otid(), lane = tid & 63, wave = __builtin_amdgcn_readfirstlane(tid >> 6), fr = lane & 15, fq = lane >> 4;
    float* Y = (float*)(ws + WS_Y); bf16_t* X1B = (bf16_t*)(ws + WS_X1B);
    const float* RW = (const float*)(ws + WS_ROUTW) + (size_t)l * 48 * DM; const float* rc0 = (const float*)(ws + WS_ROUTC) + (l * 2 + 0) * 48; const float* rc1 = rc0 + 48;
    unsigned* cnt = (unsigned*)(ws + WS_CTL) + CW_CNT + l * 32 * 16;
    int* TOK = (int*)(ws + WS_TOK); int* ROUTE = (int*)(ws + WS_ROUTE);
    const f32x4 gg = *(const f32x4*)(p.in[I_LN1G] + l * DM + 4 * tid), bb = *(const f32x4*)(p.in[I_LN1B] + l * DM + 4 * tid);
    LAS float* PART = (LAS float*)(lds + L1_PART); LAS float* STAT = (LAS float*)(lds + L1_STAT); LAS float* LG = (LAS float*)(lds + L1_LG);
    for (int task = bid; task < NT / 16; task += G) {
        const int r0 = task * 16;
        f32x4 xr[16];
#pragma unroll
        for (int i = 0; i < 16; ++i) xr[i] = *(const f32x4*)(Y + (size_t)(r0 + i) * DM + 4 * tid);
        __syncthreads();
#pragma unroll
        for (int i = 0; i < 16; ++i) *(LAS f32x4*)(lds + i * L1_RS + tid * 16) = xr[i];
        __syncthreads();
#pragma unroll
        for (int rr = 0; rr < 2; ++rr) {
            const int row = 2 * wave + rr; float sm = 0.f, sq = 0.f;
#pragma unroll
            for (int j = 0; j < 8; ++j) { const f32x4 v = *(const LAS f32x4*)(lds + row * L1_RS + (4 * lane + 256 * j) * 4); sm += (v.x + v.y) + (v.z + v.w); sq += (v.x * v.x + v.y * v.y) + (v.z * v.z + v.w * v.w); }
            sm = wave_sum(sm); sq = wave_sum(sq);
            const float mean = sm * (1.0f / DM), var = fmaxf(sq * (1.0f / DM) - mean * mean, 0.f);
            if (lane == 0) { STAT[2 * row] = mean; STAT[2 * row + 1] = rsq_(var + EPS); }
        }
        f32x4 acc[3];
#pragma unroll
        for (int n = 0; n < 3; ++n) acc[n] = (f32x4){0.f, 0.f, 0.f, 0.f};
        const LAS unsigned char* ap = lds + fr * L1_RS + (256 * wave + 4 * fq) * 4;
        const float* wp = RW + (size_t)fr * DM + 256 * wave + 4 * fq;
#pragma unroll 4
        for (int s2 = 0; s2 < 16; ++s2) {
            const f32x4 xa = *(const LAS f32x4*)(ap + 64 * s2);
#pragma unroll
            for (int n = 0; n < 3; ++n) { const f32x4 wb = *(const f32x4*)(wp + (size_t)(16 * n) * DM + 16 * s2);
#pragma unroll
                for (int i = 0; i < 4; ++i) acc[n] = __builtin_amdgcn_mfma_f32_16x16x4f32(xa[i], wb[i], acc[n], 0, 0, 0); }
        }
#pragma unroll
        for (int n = 0; n < 3; ++n)
#pragma unroll
            for (int i = 0; i < 4; ++i) PART[(wave * 16 + 4 * fq + i) * 48 + 16 * n + fr] = acc[n][i];
        __syncthreads();
#pragma unroll
        for (int rep = 0; rep < 2; ++rep) {
            const int pp = tid + 512 * rep;
            if (pp < 768) { const int row = pp / 48, col = pp % 48; float sacc = 0.f;
#pragma unroll
                for (int w = 0; w < 8; ++w) sacc += PART[(w * 16 + row) * 48 + col];
                LG[pp] = STAT[2 * row + 1] * (sacc - STAT[2 * row] * rc1[col]) + rc0[col]; }
        }
        __syncthreads();
        if (tid < 16) {
            const LAS float* L = LG + tid * 48; const int token = r0 + tid;
            float gm = L[0]; int gi = 0;
#pragma unroll
            for (int j = 1; j < 4; ++j) if (L[j] > gm) { gm = L[j]; gi = j; }
            float gs = 0.f;
#pragma unroll
            for (int j = 0; j < 4; ++j) gs += expf(L[j] - gm);
            const float gval = 1.0f / gs;
            const LAS float* E = L + 4 + gi * 8;
            float v1 = E[0]; int i1 = 0;
#pragma unroll
            for (int j = 1; j < 8; ++j) if (E[j] > v1) { v1 = E[j]; i1 = j; }
            float v2 = -3.0e38f; int i2 = 0;
#pragma unroll
            for (int j = 0; j < 8; ++j) if (j != i1 && E[j] > v2) { v2 = E[j]; i2 = j; }
            const float ex = expf(v2 - v1), p1 = 1.0f / (1.0f + ex), p2 = ex / (1.0f + ex);
            const int e0 = gi * 8 + i1, e1 = gi * 8 + i2;
            const int pos0 = (int)atomicAdd(cnt + e0 * 16, 1u), pos1 = (int)atomicAdd(cnt + e1 * 16, 1u);
            TOK[(size_t)e0 * NT + pos0] = token; TOK[(size_t)e1 * NT + pos1] = token;
            int* rp = ROUTE + (size_t)token * 8;
            rp[0] = e0; rp[1] = pos0; rp[2] = e1; rp[3] = pos1; rp[4] = __float_as_int(gval * p1); rp[5] = __float_as_int(gval * p2);
        }
#pragma unroll
        for (int i = 0; i < 16; ++i) {
            const float mean = STAT[2 * i], rstd = STAT[2 * i + 1];
            const f32x4 y = (xr[i] - mean) * rstd * gg + bb;
            *(f32x4*)(Y + (size_t)(r0 + i) * DM + 4 * tid) = y;
            *(u32x2*)(X1B + (size_t)(r0 + i) * DM + 4 * tid) = (u32x2){pk2(y.x, y.y), pk2(y.z, y.w)};
        }
    }
}

DI void moe_tables(const Params& p, LAS unsigned char* lds, int l) {
    LAS int* mc = (LAS int*)(lds + MOE_LDS_OFF); LAS int* mp = mc + 32;
    __syncthreads();
    if (threadIdx.x == 0) {
        const unsigned* cnt = (const unsigned*)(ows(p) + WS_CTL) + CW_CNT + l * 32 * 16; int acc = 0;
        for (int e = 0; e < 32; ++e) { int c = (int)__hip_atomic_load(cnt + e * 16, __ATOMIC_RELAXED, __HIP_MEMORY_SCOPE_AGENT); if (c > NT) c = NT; mc[e] = c; mp[e] = acc; acc += (c + 255) >> 8; }
        mp[32] = acc;
    }
    __syncthreads();
}
template <int NCT_SHIFT> struct MoeSched {
    const char* A; const char* Bt; const int* TOK; LAS const int* mc; LAS const int* mp; size_t bexp, btile, atile; int G, c;
    DI bool next(int i, g8::Unit& u) const {
        const int L = i * G + c, T = mp[32]; if (L >= (T << NCT_SHIFT)) return false;
        const int rt = L >> NCT_SHIFT, ct = L & ((1 << NCT_SHIFT) - 1); int e = 0;
        for (int j = 1; j < 32; ++j) if (mp[j] <= rt) e = j;
        u.pm = rt; u.pn = ct; u.x0 = e; u.x1 = rt - mp[e];
        u.a = A + (size_t)rt * atile; u.b = Bt + (size_t)e * bexp + (size_t)ct * btile; return true;
    }
    DI int tok(const g8::Unit& u, int R) const { const int idx = u.x1 * 256 + R; return idx < mc[u.x0] ? TOK[(size_t)u.x0 * NT + idx] : 0; }
};
struct EpiMoe1 {
    static constexpr bool PERM = true;
    bf16_t* HM;
    DI void operator()(const f32x4 (&acc)[2][2][4][2], const g8::Unit& u, int wr, int wc, int fr, int fq) const {
        const int row0 = u.pm * 256 + wr * 64 + fr, col0 = u.pn * 128 + wc * 32 + 8 * fq;
#pragma unroll
        for (int ai = 0; ai < 2; ++ai)
#pragma unroll
            for (int m = 0; m < 4; ++m) {
                float v[8];
#pragma unroll
                for (int i = 0; i < 4; ++i) { v[i] = siluf_(acc[ai][0][m][0][i]) * acc[ai][1][m][0][i]; v[4 + i] = siluf_(acc[ai][0][m][1][i]) * acc[ai][1][m][1][i]; }
                u32x4 w; w.x = pk2(v[0], v[1]); w.y = pk2(v[2], v[3]); w.z = pk2(v[4], v[5]); w.w = pk2(v[6], v[7]);
                *(u32x4*)(HM + (size_t)(row0 + ai * 128 + m * 16) * DEXP + col0) = w;
            }
    }
};
struct EpiMoe2 {
    static constexpr bool PERM = true;
    bf16_t* YB;
    DI void operator()(const f32x4 (&acc)[2][2][4][2], const g8::Unit& u, int wr, int wc, int fr, int fq) const {
        const int row0 = u.pm * 256 + wr * 64 + fr, col0 = u.pn * 256 + wc * 32 + 8 * fq;
#pragma unroll
        for (int ai = 0; ai < 2; ++ai)
#pragma unroll
            for (int m = 0; m < 4; ++m)
#pragma unroll
                for (int bj = 0; bj < 2; ++bj) {
                    const f32x4 v0 = acc[ai][bj][m][0], v1 = acc[ai][bj][m][1];
                    u32x4 w; w.x = pk2(v0[0], v0[1]); w.y = pk2(v0[2], v0[3]); w.z = pk2(v1[0], v1[1]); w.w = pk2(v1[2], v1[3]);
                    *(u32x4*)(YB + (size_t)(row0 + ai * 128 + m * 16) * DM + col0 + bj * 128) = w;
                }
    }
};
DI void phase_moe1(const Params& p, LAS unsigned char* lds, int bid, int G, int l) {
    unsigned char* ws = ows(p);
    moe_tables(p, lds, l);
    MoeSched<2> S{(const char*)(ws + WS_X1B), (const char*)(ws + WS_WGU) + (size_t)l * NEXP * 1024 * DM * 2, (const int*)(ws + WS_TOK), (LAS const int*)(lds + MOE_LDS_OFF), (LAS const int*)(lds + MOE_LDS_OFF) + 32,
                  (size_t)1024 * DM * 2, (size_t)256 * DM * 2, 0, G, bid};
    EpiMoe1 E{(bf16_t*)(ws + WS_HM)};
    g8::gemm_phase<EpiMoe1, MoeSched<2>, true>(lds, DM, DM, DM, S, E);
}
DI void phase_moe2(const Params& p, LAS unsigned char* lds, int bid, int G, int l) {
    unsigned char* ws = ows(p);
    moe_tables(p, lds, l);
    MoeSched<3> S{(const char*)(ws + WS_HM), (const char*)(ws + WS_WD) + (size_t)l * NEXP * DM * DEXP * 2, nullptr, (LAS const int*)(lds + MOE_LDS_OFF), (LAS const int*)(lds + MOE_LDS_OFF) + 32,
                  (size_t)DM * DEXP * 2, (size_t)256 * DEXP * 2, (size_t)256 * DEXP * 2, G, bid};
    EpiMoe2 E{(bf16_t*)(ws + WS_YB)};
    g8::gemm_phase<EpiMoe2, MoeSched<3>, false>(lds, DEXP, DEXP, DEXP, S, E);
}

DI void phase_ln2(const Params& p, LAS unsigned char* lds, int bid, int G, int l) {
    unsigned char* ws = ows(p);
    moe_tables(p, lds, l);
    LAS const int* mp = (LAS const int*)(lds + MOE_LDS_OFF) + 32;
    const int tid = otid(), lane = tid & 63, wave = tid >> 6;
    const float* X1 = (const float*)(ws + WS_Y); const bf16_t* YB = (const bf16_t*)(ws + WS_YB); const int* ROUTE = (const int*)(ws + WS_ROUTE);
    const float* g = p.in[I_LN2G] + l * DM; const float* bt = p.in[I_LN2B] + l * DM;
    float* out = p.out; bf16_t* XB = (bf16_t*)(ws + WS_XB);
    for (int row = bid * 8 + wave; row < NT; row += G * 8) {
        const int* rp = ROUTE + (size_t)row * 8;
        const int e0 = rp[0], pos0 = rp[1], e1 = rp[2], pos1 = rp[3]; const float g0 = __int_as_float(rp[4]), g1 = __int_as_float(rp[5]);
        const size_t s0 = (size_t)(256 * mp[e0] + pos0), s1 = (size_t)(256 * mp[e1] + pos1);
        f32x4 v[8]; float sm = 0.f;
#pragma unroll
        for (int j = 0; j < 8; ++j) {
            const int col = 4 * lane + 256 * j;
            const f32x4 x = *(const f32x4*)(X1 + (size_t)row * DM + col);
            const u32x2 a = *(const u32x2*)(YB + s0 * DM + col), b = *(const u32x2*)(YB + s1 * DM + col);
            const f32x4 ya = {bflo(a.x), bfhi(a.x), bflo(a.y), bfhi(a.y)}, yb = {bflo(b.x), bfhi(b.x), bflo(b.y), bfhi(b.y)};
            v[j] = x * ALPHA + (ya * g0 + yb * g1);
            sm += (v[j].x + v[j].y) + (v[j].z + v[j].w);
        }
        const float mean = wave_sum(sm) * (1.0f / DM); float sq = 0.f;
#pragma unroll
        for (int j = 0; j < 8; ++j) { v[j] = v[j] - mean; sq += (v[j].x * v[j].x + v[j].y * v[j].y) + (v[j].z * v[j].z + v[j].w * v[j].w); }
        const float rstd = rsq_(wave_sum(sq) * (1.0f / DM) + EPS);
#pragma unroll
        for (int j = 0; j < 8; ++j) {
            const int col = 4 * lane + 256 * j;
            const f32x4 y = v[j] * rstd * *(const f32x4*)(g + col) + *(const f32x4*)(bt + col);
            *(f32x4*)(out + (size_t)row * DM + col) = y;
            *(u32x2*)(XB + (size_t)row * DM + col) = (u32x2){pk2(y.x, y.y), pk2(y.z, y.w)};
        }
    }
}


#define GAS __attribute__((address_space(1)))
typedef GAS unsigned gu32;
#define XB_TMO      128
#define XB_XCNT(j)  (256  + 64 * (j))
#define XB_XSUB(j)  (1280 + 64 * (j))
#define XB_XGEN(j)  (2304 + 64 * (j))
#define XB_TOP      3328
#define XB_TOPGEN   3392
#define XCD_BAR_WORDS 3456
#define XB_SPIN_CAP (1u << 18)

__device__ __forceinline__ unsigned xb_ld(unsigned* p)              { return __hip_atomic_load(p, __ATOMIC_RELAXED, __HIP_MEMORY_SCOPE_AGENT); }
__device__ __forceinline__ unsigned xb_add(unsigned* p, unsigned v) { return __hip_atomic_fetch_add(p, v, __ATOMIC_RELAXED, __HIP_MEMORY_SCOPE_AGENT); }
__device__ __forceinline__ unsigned xb_xcc_id() { return (unsigned)__builtin_amdgcn_s_getreg((3 << 11) | 20) & 0xFu; }
#define XB_SPIN(cond, bar) do { unsigned _sp = 0; while (cond) { __builtin_amdgcn_s_sleep(1); \
    if ((++_sp & 255u) == 0u) { if (xb_ld(&(bar)[XB_TMO])) break; if (_sp > XB_SPIN_CAP) { atomicAdd(&(bar)[XB_TMO], 1u); break; } } } } while (0)

struct XcdBarrier {
    unsigned* bar; unsigned x;
    volatile LAS unsigned* st;
};

__device__ __forceinline__ XcdBarrier xcd_barrier_post(unsigned* bar, volatile LAS unsigned* st) {
    XcdBarrier b; b.bar = bar; b.x = xb_xcc_id(); b.st = st;
    if (threadIdx.x == 0) (void)xb_add(&bar[XB_XCNT(b.x)], 1u);
    return b;
}
__device__ __forceinline__ void xcd_barrier_complete(unsigned* bar, unsigned x, unsigned& nloc, unsigned& nx) {
    const unsigned G = gridDim.x * gridDim.y * gridDim.z;
    unsigned sum, cnt, mine, sp = 0u;
    for (;;) {
        sum = 0u; cnt = 0u; mine = 0u;
#pragma unroll
        for (unsigned j = 0; j < 16; ++j) { const unsigned c = xb_ld(&bar[XB_XCNT(j)]); sum += c; cnt += (c > 0u) ? 1u : 0u; mine = (j == x) ? c : mine; }
        if (sum == G) break;
        __builtin_amdgcn_s_sleep(1);
        if ((++sp & 255u) == 0u) { if (xb_ld(&bar[XB_TMO])) break; if (sp > XB_SPIN_CAP) { atomicAdd(&bar[XB_TMO], 1u); break; } }
    }
    nloc = mine > 0u ? mine : 1u; nx = cnt > 0u ? cnt : 1u;
}

__device__ __forceinline__ void xcd_barrier(const XcdBarrier& b) {
    asm volatile("s_waitcnt vmcnt(0)" ::: "memory");
    __syncthreads();
    if (threadIdx.x == 0) {
        unsigned* bar = b.bar;
        __builtin_amdgcn_s_waitcnt(0);
        unsigned nloc = b.st[0], nx = b.st[1];
        if (nloc == 0u) { xcd_barrier_complete(bar, xb_xcc_id(), nloc, nx); b.st[0] = nloc; b.st[1] = nx; }
        const unsigned bx = xb_xcc_id();
        const unsigned old = xb_add(&bar[XB_XSUB(bx)], 1u);
        const unsigned gen = old / nloc;
        if (old + 1u == (gen + 1u) * nloc) {
            __builtin_amdgcn_fence(__ATOMIC_RELEASE, "agent");
            asm volatile("s_waitcnt vmcnt(0)" ::: "memory");
            const unsigned og = xb_add(&bar[XB_TOP], 1u);
            const unsigned tg = og / nx;
            if (og + 1u == (tg + 1u) * nx) xb_add(&bar[XB_TOPGEN], 1u);
            else XB_SPIN(xb_ld(&bar[XB_TOPGEN]) == tg, bar);
            __builtin_amdgcn_fence(__ATOMIC_ACQUIRE, "agent");
            xb_add(&bar[XB_XGEN(bx)], 1u);
            asm volatile("s_waitcnt vmcnt(0)" ::: "memory");
        } else {
            XB_SPIN(xb_ld(&bar[XB_XGEN(bx)]) == gen, bar);
            __builtin_amdgcn_fence(__ATOMIC_ACQUIRE, "agent");
            asm volatile("s_waitcnt vmcnt(0)" ::: "memory");
        }
    }
    __syncthreads();
}


constexpr int BARST_OFF = MOE_LDS_OFF + 1024;
#ifndef REP_KS
#define REP_KS 1
#endif
#ifndef REP_LN2
#define REP_LN2 1
#endif
#ifndef REP_INP
#define REP_INP 1
#endif
#ifndef REP_MOE1
#define REP_MOE1 1
#endif
__global__ void __launch_bounds__(NTHR, 2) mega_fwd(Params p) {
    extern __shared__ __attribute__((aligned(16))) unsigned char lds_[];
    LAS unsigned char* lds = (LAS unsigned char*)lds_;
    const int bid0 = blockIdx.x, G0 = gridDim.x;
    if (threadIdx.x == 0) *(LAS u32x4*)(lds + BARST_OFF) = (u32x4){0u, 0u, 0u, 0u};
    __syncthreads();
    XcdBarrier bar = xcd_barrier_post((unsigned*)(p.ws + WS_CTL) + CW_BAR, (volatile LAS unsigned*)(lds + BARST_OFF));
#define OPQ() do { bid = bid0; G = G0; asm volatile("" : "+s"(bid), "+s"(G)); } while (0)
    int bid, G; OPQ();
    phase_prologue(p, lds, bid, G);
    xcd_barrier(bar);
    for (int l = 0; l < DEPTH; ++l) {
        for (int r_ = 0; r_ < REP_INP; ++r_) { OPQ(); phase_inproj(p, lds, bid, G, l); }
        xcd_barrier(bar);
        for (int r_ = 0; r_ < REP_KS; ++r_) { OPQ(); phase_krope(p, bid, G, l);
        OPQ(); phase_sgu(p, lds, bid, G, l); }
        __syncthreads();
        OPQ(); phase_mla_proj(p, lds, bid, G, l);
        xcd_barrier(bar);
        OPQ(); phase_attn_hgrn(p, lds, l);
        xcd_barrier(bar);
        OPQ(); phase_outproj(p, lds, bid, G, l);
        xcd_barrier(bar);
        OPQ(); phase_ln1_router(p, lds, bid, G, l);
        xcd_barrier(bar);
        for (int r_ = 0; r_ < REP_MOE1; ++r_) { OPQ(); phase_moe1(p, lds, bid, G, l); }
        xcd_barrier(bar);
        OPQ(); phase_moe2(p, lds, bid, G, l);
        xcd_barrier(bar);
        for (int r_ = 0; r_ < REP_LN2; ++r_) { OPQ(); phase_ln2(p, lds, bid, G, l); }
        xcd_barrier(bar);
    }
#undef OPQ
}

extern "C" void kernel_launch(void* const* d_in, const int* in_sizes, int n_in, void* d_out, int out_size, void* d_ws, size_t ws_size, hipStream_t stream) {
    static int grid = 0;
    if (grid == 0) {
        if (n_in != 25 || out_size != NT * DM || ws_size < WS_END) { fprintf(stderr, "kernel_launch: unexpected sizes n_in %d out %d ws %zu (need %zu)\n", n_in, out_size, ws_size, (size_t)WS_END); grid = -1; return; }
        int dev = 0, cus = 0, per_cu = 0;
        if (hipGetDevice(&dev) != hipSuccess || hipDeviceGetAttribute(&cus, hipDeviceAttributeMultiprocessorCount, dev) != hipSuccess) { grid = -1; return; }
        if (hipFuncSetAttribute((const void*)mega_fwd, hipFuncAttributeMaxDynamicSharedMemorySize, LDS_BYTES) != hipSuccess) { fprintf(stderr, "kernel_launch: hipFuncSetAttribute failed\n"); grid = -1; return; }
        if (hipOccupancyMaxActiveBlocksPerMultiprocessor(&per_cu, (const void*)mega_fwd, NTHR, LDS_BYTES) != hipSuccess || per_cu < 1) { fprintf(stderr, "kernel_launch: occupancy query says %d blocks per CU\n", per_cu); (void)hipGetLastError(); grid = -1; return; }
        grid = cus;
    }
    if (grid < 0) return;
    (void)hipMemsetAsync((char*)d_ws + WS_CTL, 0, CTL_BYTES, stream);
    Params p{};
    for (int i = 0; i < 25; ++i) p.in[i] = (const float*)d_in[i];
    p.out = (float*)d_out; p.ws = (unsigned char*)d_ws; p.layer = 0; p.pad = 0;
    hipLaunchKernelGGL(mega_fwd, dim3(grid), dim3(NTHR), LDS_BYTES, stream, p);
}
```

```cpp
#include <hip/hip_runtime.h>
#include <cstdio>
#include <cstdint>

#define DI __device__ __forceinline__
#define LAS __attribute__((address_space(3)))
typedef unsigned short bf16_t;
typedef short bf16x8 __attribute__((ext_vector_type(8)));
typedef short s16x4 __attribute__((ext_vector_type(4)));
typedef float f32x2 __attribute__((ext_vector_type(2)));
typedef float f32x4 __attribute__((ext_vector_type(4)));
typedef float f32x16 __attribute__((ext_vector_type(16)));
typedef unsigned u32x2 __attribute__((ext_vector_type(2)));
typedef unsigned u32x4 __attribute__((ext_vector_type(4)));
typedef __bf16 bf2_t __attribute__((ext_vector_type(2)));

constexpr int DM = 2048, BATCH = 4, SEQ = 4096, NT = BATCH * SEQ, DEPTH = 4;
constexpr int DIN = 4160, DIN_MAIN = 4096;
constexpr int NEXP = 32, DEXP = 512;
constexpr int MAXSLOT = 40960;
constexpr float ALPHA = 1.681792830507429f;
constexpr float EPS = 1e-5f;
constexpr float QSCALE = 0.07216878364870323f * 1.4426950408889634f;

constexpr size_t MiB = 1u << 20;
constexpr size_t al(size_t x) { return (x + MiB - 1) / MiB * MiB; }
constexpr size_t WS_CTL = 0, CTL_BYTES = 1 * MiB;
constexpr size_t WS_WIN = WS_CTL + CTL_BYTES;
constexpr size_t WS_WUQ = WS_WIN + al((size_t)DEPTH * DIN * DM * 2);
constexpr size_t WS_WUK = WS_WUQ + al((size_t)DEPTH * 1536 * 512 * 2);
constexpr size_t WS_WUV = WS_WUK + al((size_t)DEPTH * 1024 * 512 * 2);
constexpr size_t WS_WOUT = WS_WUV + al((size_t)DEPTH * 1024 * 512 * 2);
constexpr size_t WS_WGU = WS_WOUT + al((size_t)DEPTH * DM * DM * 2);
constexpr size_t WS_WD = WS_WGU + al((size_t)DEPTH * NEXP * 1024 * DM * 2);
constexpr size_t WS_SGUW = WS_WD + al((size_t)DEPTH * NEXP * DM * DEXP * 2);
constexpr size_t WS_ROUTW = WS_SGUW + al((size_t)DEPTH * 4 * 128 * 128 * 2);
constexpr size_t WS_ROUTC = WS_ROUTW + al((size_t)DEPTH * 48 * DM * 4);
constexpr size_t WS_LB = WS_ROUTC + MiB;
constexpr size_t WS_COS = WS_LB + MiB;
constexpr size_t WS_XB = WS_COS + al((size_t)NT * 64 * 4);
constexpr size_t WS_Y = WS_XB + al((size_t)NT * DM * 2);
constexpr size_t WS_X1B = WS_Y + al((size_t)NT * DM * 4);
constexpr size_t WS_HB = WS_X1B + al((size_t)NT * DM * 2);
constexpr size_t WS_LOGF = WS_HB + al((size_t)NT * 4096 * 2);
constexpr size_t WS_KR = WS_LOGF + al((size_t)NT * 512 * 4);
constexpr size_t WS_SSQ = WS_KR + al((size_t)NT * 64 * 2);
constexpr size_t WS_Q = WS_SSQ + al((size_t)NT * 16 * 4);
constexpr size_t WS_KN = WS_Q + al((size_t)NT * 1536 * 2);
constexpr size_t WS_VT = WS_KN + al((size_t)NT * 1024 * 2);
constexpr size_t WS_OH = WS_VT + al((size_t)NT * 1024 * 2);
constexpr size_t WS_CAT = WS_OH + al((size_t)NT * 512 * 4);
constexpr size_t WS_ROUTE = WS_CAT + al((size_t)NT * DM * 2);
constexpr size_t WS_TOK = WS_ROUTE + al((size_t)NT * 8 * 4);
constexpr size_t WS_HM = WS_TOK + al((size_t)NEXP * NT * 4);
constexpr size_t WS_YB = WS_HM + al((size_t)MAXSLOT * DEXP * 2);
constexpr size_t WS_HU = WS_YB + al((size_t)MAXSLOT * DM * 2);
constexpr size_t WS_HQG = WS_HU + al((size_t)1024 * 65536);
constexpr size_t WS_HDL = WS_HQG + al((size_t)1024 * 16384);
constexpr size_t WS_END = WS_HDL + al((size_t)1024 * 512);

constexpr int CW_TMO = 0;
constexpr int CW_CNT = 1024;
constexpr int CW_BAR = 8192;

constexpr int MOE_LDS_OFF = 159744;
constexpr int LDS_BYTES = 163840;
constexpr int NTHR = 512;

DI unsigned pk2(float lo, float hi) { bf2_t b = __builtin_convertvector((f32x2){lo, hi}, bf2_t); return __builtin_bit_cast(unsigned, b); }
DI bf16_t f2bf(float f) { return (bf16_t)(pk2(f, 0.f) & 0xffffu); }
DI float bflo(unsigned u) { return __uint_as_float(u << 16); }
DI float bfhi(unsigned u) { return __uint_as_float(u & 0xffff0000u); }
DI float bf2f(bf16_t h) { return __uint_as_float((unsigned)h << 16); }
DI float wave_sum(float v) {
#pragma unroll
    for (int o = 1; o < 64; o <<= 1) v += __shfl_xor(v, o);
    return v;
}
DI int otid() { int t = (int)threadIdx.x; asm volatile("" : "+v"(t)); return t; }
DI float rcp_(float x) { return __builtin_amdgcn_rcpf(x); }
DI float rsq_(float x) { return __builtin_amdgcn_rsqf(x); }
DI float sigmoidf_(float x) { return rcp_(1.0f + __expf(-x)); }
DI float siluf_(float x) { return x * rcp_(1.0f + __expf(-x)); }
DI float geluf_(float x) { const float u = 1.5957691216057308f * (x + 0.044715f * x * x * x); return x * rcp_(1.0f + __expf(-u)); }

struct Params {
    const float* in[25];
    float* out;
    unsigned char* ws;
    int layer;
    int pad;
};
constexpr size_t PTR_TAB_BYTES = 65536;
template <bool DIRECT> DI const float* pinT(const Params& p, unsigned char* ws, int i) {
    if constexpr (DIRECT) return p.in[i];
    else return (const float*)(const __attribute__((address_space(1))) float*)(((const unsigned long long*)(ws + WS_CTL + PTR_TAB_BYTES))[i]);
}
DI unsigned char* ows(const Params& p) { __attribute__((address_space(1))) unsigned char* w = (__attribute__((address_space(1))) unsigned char*)p.ws; asm volatile("" : "+s"(w)); return (unsigned char*)w; }

namespace g8 {
constexpr int BM = 256, BK = 64, HALF = 128, HTB = HALF * BK * 2, STAGE_BYTES = 8 * HTB, NXCD = 8, WGM = 8;
DI int lds_byte(int r, int c) { const int st = (r >> 4) * 2 + (c >> 5), rr = r & 15, cc = c & 31, ob = rr * 64 + cc * 2; return st * 1024 + (ob ^ (((ob >> 9) & 1) << 5)); }
DI void stage_rc(int b, int& R, int& C) { const int st = b / 1024, sb = b % 1024, swz = sb ^ (((sb >> 9) & 1) << 5); R = (st >> 1) * 16 + swz / 64; C = (st & 1) * 32 + (swz % 64) / 2; }
DI int perm32(int rho) { const int n = rho >> 4, i = rho & 15; return 8 * (i >> 2) + 4 * n + (i & 3); }

struct Unit { const char* a; const char* b; int pm, pn, x0, x1; };

struct StaticSched {
    const char* A; const char* Bt; int lda, ldb, nM, nN, nwg, G, c;
    DI void init(const void* A_, const void* Bt_, int M, int N, int lda_, int ldb_, int G_, int c_) { A = (const char*)A_; Bt = (const char*)Bt_; lda = lda_; ldb = ldb_; nM = M / BM; nN = N / BM; nwg = nM * nN; G = G_; c = c_; }
    DI bool next(int i, Unit& u) const {
        const long L = (long)i * G + c; if (L >= nwg) return false;
        int wgid = (int)L; { const int q = nwg / NXCD, r = nwg % NXCD, xcd = wgid % NXCD, off = wgid / NXCD; wgid = (xcd < r ? xcd * (q + 1) : r * (q + 1) + (xcd - r) * q) + off; }
        const int nig = WGM * nN, gid = wgid / nig, fm = gid * WGM, gsz = (nM - fm) < WGM ? (nM - fm) : WGM;
        u.pm = fm + ((wgid % nig) % gsz); u.pn = (wgid % nig) / gsz; u.x0 = 0; u.x1 = 0;
        u.a = A + (size_t)u.pm * BM * lda * 2; u.b = Bt + (size_t)u.pn * BM * ldb * 2; return true;
    }
    DI int tok(const Unit&, int) const { return 0; }
};

template <class Epi, class Sched, bool GATHER>
DI void gemm_phase(LAS unsigned char* lds, const int K, const int lda, const int ldb, const Sched& S, const Epi& E) {
    const int tid = otid(), wid = __builtin_amdgcn_readfirstlane(tid >> 6), lane = tid & 63, wr = wid >> 2, wc = wid & 3, fr = lane & 15, fq = lane >> 4;
    const int nt = K / BK;
    unsigned voffA[2], voffB[2]; int RA[2], CA[2];
#pragma unroll
    for (int i = 0; i < 2; ++i) { int R, C; stage_rc(tid * 16 + i * 8192, R, C); const int Rb = Epi::PERM ? ((R & ~31) + perm32(R & 31)) : R;
        voffA[i] = (unsigned)(R * lda + C) * 2u; voffB[i] = (unsigned)(Rb * ldb + C) * 2u; RA[i] = R; CA[i] = C; }
    const size_t kstep = (size_t)(BK * 2);
    const size_t hstepA = (size_t)HALF * lda * 2, hstep = (size_t)HALF * ldb * 2;
    const unsigned ldsw = (unsigned)wid * 1024u;
    const int aoff = lds_byte(wr * 64 + fr, fq * 8), boff = lds_byte(wc * 32 + fr, fq * 8);
    unsigned gC[2][2], gN[2][2], g2[2][2];
#define G8_SA(b, h) (((b) * 2 + (h)) * HTB)
#define G8_SB(b, h) ((4 + (b) * 2 + (h)) * HTB)
#define G8_DMA(bufoff, ptr, _i) __builtin_amdgcn_global_load_lds((const unsigned*)(ptr), (LAS unsigned*)(lds + (bufoff) + ldsw + (_i) * 8192), 16, 0, 0)
#define G8_STAGE_B(bufoff, gbase) do { _Pragma("unroll") for (int _i = 0; _i < 2; ++_i) G8_DMA(bufoff, (const char*)(gbase) + voffB[_i], _i); } while (0)
#define G8_STAGE_A(bufoff, gbase, h, GO) do { _Pragma("unroll") for (int _i = 0; _i < 2; ++_i) { \
        if constexpr (GATHER) G8_DMA(bufoff, (const char*)(gbase) + GO[h][_i], _i); else G8_DMA(bufoff, (const char*)(gbase) + (h) * hstepA + voffA[_i], _i); } } while (0)
#define G8_LDA(dst, b, h) do { _Pragma("unroll") for (int m = 0; m < 4; ++m) _Pragma("unroll") for (int k = 0; k < 2; ++k) dst[m][k] = *(const LAS bf16x8*)(lds + G8_SA(b, h) + aoff + m * 2048 + k * 1024); } while (0)
#define G8_LDB(dst, b, h) do { _Pragma("unroll") for (int n = 0; n < 2; ++n) _Pragma("unroll") for (int k = 0; k < 2; ++k) dst[n][k] = *(const LAS bf16x8*)(lds + G8_SB(b, h) + boff + n * 2048 + k * 1024); } while (0)
#define G8_MMA(ai, bj, At, Bt) do { __builtin_amdgcn_s_setprio(1); _Pragma("unroll") for (int m = 0; m < 4; ++m) _Pragma("unroll") for (int n = 0; n < 2; ++n) _Pragma("unroll") for (int k = 0; k < 2; ++k) \
        acc[ai][bj][m][n] = __builtin_amdgcn_mfma_f32_16x16x32_bf16(Bt[n][k], At[m][k], acc[ai][bj][m][n], 0, 0, 0); __builtin_amdgcn_s_setprio(0); } while (0)
#define G8_WAIT_V(n) asm volatile("s_waitcnt vmcnt(" #n ")" ::: "memory")
#define G8_WAIT_L(n) asm volatile("s_waitcnt lgkmcnt(" #n ")" ::: "memory")
#define G8_BAR __builtin_amdgcn_s_barrier()
#define G8_SCHED __builtin_amdgcn_sched_barrier(0)
#define G8_GOFF(dst, u) do { if constexpr (GATHER) { _Pragma("unroll") for (int _h = 0; _h < 2; ++_h) _Pragma("unroll") for (int _i = 0; _i < 2; ++_i) \
        dst[_h][_i] = (unsigned)(S.tok(u, _h * HALF + RA[_i]) * lda + CA[_i]) * 2u; } } while (0)
    Unit cur, nxt; int ui = 0;
    if (!S.next(0, cur)) return;
    f32x4 acc[2][2][4][2];
#pragma unroll
    for (int a = 0; a < 2; ++a)
#pragma unroll
        for (int b = 0; b < 2; ++b)
#pragma unroll
            for (int m = 0; m < 4; ++m)
#pragma unroll
                for (int n = 0; n < 2; ++n) acc[a][b][m][n] = (f32x4){0.f, 0.f, 0.f, 0.f};
    bf16x8 At[4][2], B0[2][2], B1[2][2];
    const char* cA = cur.a; const char* cB = cur.b;
#pragma unroll
    for (int h = 0; h < 2; ++h)
#pragma unroll
        for (int i = 0; i < 2; ++i) { gC[h][i] = 0u; gN[h][i] = 0u; g2[h][i] = 0u; }
    G8_GOFF(gC, cur);
    G8_STAGE_B(G8_SB(0, 0), cB); G8_STAGE_B(G8_SB(0, 1), cB + hstep); G8_STAGE_A(G8_SA(0, 0), cA, 0, gC); G8_STAGE_A(G8_SA(0, 1), cA, 1, gC);
    if (wr == 1) G8_BAR;
    G8_WAIT_V(2); G8_BAR;
    G8_STAGE_B(G8_SB(1, 0), cB + kstep); G8_STAGE_A(G8_SA(1, 0), cA + kstep, 0, gC); G8_STAGE_B(G8_SB(1, 1), cB + hstep + kstep);
    G8_WAIT_V(6); G8_BAR;
    for (;;) {
        const bool has_next = S.next(ui + 1, nxt);
        const char* nA = has_next ? nxt.a : cA; const char* nB = has_next ? nxt.b : cB;
        if constexpr (GATHER) { if (has_next) { G8_GOFF(gN, nxt); } else {
#pragma unroll
            for (int h = 0; h < 2; ++h)
#pragma unroll
                for (int i = 0; i < 2; ++i) gN[h][i] = gC[h][i]; } }
        for (int t = 0; t < nt; t += 2) {
            const bool last = (t == nt - 2);
            const char* a1 = cA + (size_t)(t + 1) * kstep;
            const char* a2 = last ? nA : cA + (size_t)(t + 2) * kstep; const char* b2 = last ? nB : cB + (size_t)(t + 2) * kstep;
            const char* a3 = a2 + kstep; const char* b3 = b2 + kstep;
            if constexpr (GATHER) {
#pragma unroll
                for (int h = 0; h < 2; ++h)
#pragma unroll
                    for (int i = 0; i < 2; ++i) g2[h][i] = last ? gN[h][i] : gC[h][i]; }
            G8_LDB(B0, 0, 0); G8_LDB(B1, 0, 1); G8_SCHED; G8_LDA(At, 0, 0); G8_STAGE_A(G8_SA(1, 1), a1, 1, gC);
            G8_WAIT_V(8); G8_WAIT_L(0); G8_BAR; G8_MMA(0, 0, At, B0); G8_MMA(0, 1, At, B1); G8_BAR; G8_SCHED;
            G8_LDA(At, 0, 1); G8_STAGE_B(G8_SB(0, 0), b2); G8_STAGE_B(G8_SB(0, 1), b2 + hstep); G8_STAGE_A(G8_SA(0, 0), a2, 0, g2);
            G8_WAIT_V(8); G8_WAIT_L(0); G8_BAR; G8_MMA(1, 0, At, B0); G8_MMA(1, 1, At, B1); G8_BAR; G8_SCHED;
            G8_LDB(B0, 1, 0); G8_LDB(B1, 1, 1); G8_SCHED; G8_LDA(At, 1, 0); G8_STAGE_A(G8_SA(0, 1), a2, 1, g2);
            G8_WAIT_V(8); G8_WAIT_L(0); G8_BAR; G8_MMA(0, 0, At, B0); G8_MMA(0, 1, At, B1); G8_BAR; G8_SCHED;
            G8_LDA(At, 1, 1); G8_STAGE_B(G8_SB(1, 0), b3); G8_STAGE_B(G8_SB(1, 1), b3 + hstep); G8_STAGE_A(G8_SA(1, 0), a3, 0, g2);
            G8_WAIT_V(8); G8_WAIT_L(0); G8_BAR; G8_MMA(1, 0, At, B0); G8_MMA(1, 1, At, B1); G8_BAR; G8_SCHED;
        }
        if (wr == 0) G8_BAR;
        E(acc, cur, wr, wc, fr, fq);
        if (!has_next) break;
#pragma unroll
        for (int a = 0; a < 2; ++a)
#pragma unroll
            for (int b = 0; b < 2; ++b)
#pragma unroll
                for (int m = 0; m < 4; ++m)
#pragma unroll
                    for (int n = 0; n < 2; ++n) acc[a][b][m][n] = (f32x4){0.f, 0.f, 0.f, 0.f};
        cur = nxt; cA = nA; cB = nB; ++ui;
        if constexpr (GATHER) {
#pragma unroll
            for (int h = 0; h < 2; ++h)
#pragma unroll
                for (int i = 0; i < 2; ++i) gC[h][i] = gN[h][i]; }
        if (wr == 1) G8_BAR;
    }
    G8_WAIT_V(0);
    G8_BAR;
#undef G8_SA
#undef G8_SB
#undef G8_DMA
#undef G8_STAGE_A
#undef G8_STAGE_B
#undef G8_LDA
#undef G8_LDB
#undef G8_MMA
#undef G8_WAIT_V
#undef G8_WAIT_L
#undef G8_BAR
#undef G8_SCHED
#undef G8_GOFF
}
}

enum { I_X = 0, I_POS, I_WIN, I_SGU_LNG, I_SGU_LNB, I_SGU_WS, I_SGU_B, I_LBLOG, I_HNORM, I_QNG, I_WUQ, I_KVNG, I_WUKV, I_WOUT, I_LN1G, I_LN1B,
       I_RGW, I_RGB, I_REW, I_REB, I_EWG, I_EWU, I_EWD, I_LN2G, I_LN2B };

enum { TK_WIN = 0, TK_WUQ, TK_WUKV, TK_WOUT, TK_GATE, TK_UP, TK_DOWN };
struct ConvItem { const float* src; bf16_t* dst0; bf16_t* dst1; const float* sc; int K, N, kind, k0, n0; };
DI void conv_load(const ConvItem& c, f32x4 (&v)[16], int lane) {
    const int c16 = lane & 15, r4 = lane >> 4;
#pragma unroll
    for (int i = 0; i < 16; ++i) v[i] = __builtin_nontemporal_load((const f32x4*)(c.src + (size_t)(c.k0 + 4 * i + r4) * c.N + c.n0 + 4 * c16));
}
DI void conv_store(const ConvItem& ci, const f32x4 (&v)[16], LAS float* scr, int lane) {
    const int c16 = lane & 15, r4 = lane >> 4, K = ci.K, kind = ci.kind;
#pragma unroll
    for (int i = 0; i < 16; ++i) { LAS float* d = scr + (4 * i + r4) * 65 + 4 * c16; d[0] = v[i].x; d[1] = v[i].y; d[2] = v[i].z; d[3] = v[i].w; }
    asm volatile("s_waitcnt lgkmcnt(0)" ::: "memory");
    const int c = lane & 7;
    float s8[8];
#pragma unroll
    for (int i = 0; i < 8; ++i) s8[i] = ci.sc ? ci.sc[ci.k0 + 8 * c + i] : 1.0f;
#pragma unroll
    for (int j = 0; j < 8; ++j) {
        const int nl = (lane >> 3) + 8 * j, n = ci.n0 + nl; const LAS float* s = scr + (8 * c) * 65 + nl;
        u32x4 o; o.x = pk2(s[0 * 65] * s8[0], s[1 * 65] * s8[1]); o.y = pk2(s[2 * 65] * s8[2], s[3 * 65] * s8[3]); o.z = pk2(s[4 * 65] * s8[4], s[5 * 65] * s8[5]); o.w = pk2(s[6 * 65] * s8[6], s[7 * 65] * s8[7]);
        bf16_t* d = ci.dst0; int row = n;
        if (kind == TK_WIN) { if (n >= 4096) { const int jj = n - 4096; row = 4096 + 2 * (jj & 31) + (jj >> 5); } }
        else if (kind == TK_WUQ) { const int h = n / 192, cc = n % 192; if (cc >= 128) { const int jj = cc - 128; row = h * 192 + 128 + 2 * (jj & 31) + (jj >> 5); } }
        else if (kind == TK_WUKV) { const int h = n >> 8, cc = n & 255; if (cc < 128) row = h * 128 + cc; else { d = ci.dst1; row = h * 128 + cc - 128; } }
        else if (kind == TK_GATE) row = (n >> 7) * 256 + (n & 127);
        else if (kind == TK_UP) row = (n >> 7) * 256 + 128 + (n & 127);
        *(u32x4*)(d + (size_t)row * K + ci.k0 + 8 * c) = o;
    }
    asm volatile("s_waitcnt lgkmcnt(0)" ::: "memory");
}

constexpr int IT_WIN = 32 * 65, IT_WUQ = 8 * 24, IT_WUKV = 8 * 32, IT_WOUT = 32 * 32, IT_E = 256, IT_LAYER = IT_WIN + IT_WUQ + IT_WUKV + IT_WOUT + NEXP * 3 * IT_E;
template <bool DIRECT> DI ConvItem conv_desc(const Params& p, unsigned char* ws, int l, int r) {
    ConvItem c; c.dst1 = nullptr; c.sc = nullptr; int item;
    if (r < IT_WIN) { c.src = pinT<DIRECT>(p, ws, I_WIN) + (size_t)l * DM * DIN; c.K = DM; c.N = DIN; c.kind = TK_WIN; c.dst0 = (bf16_t*)(ws + WS_WIN) + (size_t)l * DIN * DM; item = r; }
    else if ((r -= IT_WIN) < IT_WUQ) { c.src = pinT<DIRECT>(p, ws, I_WUQ) + (size_t)l * 512 * 1536; c.K = 512; c.N = 1536; c.kind = TK_WUQ; c.dst0 = (bf16_t*)(ws + WS_WUQ) + (size_t)l * 1536 * 512; c.sc = pinT<DIRECT>(p, ws, I_QNG) + l * 512; item = r; }
    else if ((r -= IT_WUQ) < IT_WUKV) { c.src = pinT<DIRECT>(p, ws, I_WUKV) + (size_t)l * 512 * 2048; c.K = 512; c.N = 2048; c.kind = TK_WUKV; c.dst0 = (bf16_t*)(ws + WS_WUK) + (size_t)l * 1024 * 512; c.dst1 = (bf16_t*)(ws + WS_WUV) + (size_t)l * 1024 * 512; c.sc = pinT<DIRECT>(p, ws, I_KVNG) + l * 512; item = r; }
    else if ((r -= IT_WUKV) < IT_WOUT) { c.src = pinT<DIRECT>(p, ws, I_WOUT) + (size_t)l * DM * DM; c.K = DM; c.N = DM; c.kind = TK_WOUT; c.dst0 = (bf16_t*)(ws + WS_WOUT) + (size_t)l * DM * DM; item = r; }
    else { r -= IT_WOUT; const int e = r / (3 * IT_E), r2 = r % (3 * IT_E), ty = r2 / IT_E; item = r2 % IT_E; const size_t le = (size_t)l * NEXP + e;
        if (ty == 0) { c.src = pinT<DIRECT>(p, ws, I_EWG) + le * DM * DEXP; c.K = DM; c.N = DEXP; c.kind = TK_GATE; c.dst0 = (bf16_t*)(ws + WS_WGU) + le * 1024 * DM; }
        else if (ty == 1) { c.src = pinT<DIRECT>(p, ws, I_EWU) + le * DM * DEXP; c.K = DM; c.N = DEXP; c.kind = TK_UP; c.dst0 = (bf16_t*)(ws + WS_WGU) + le * 1024 * DM; }
        else { c.src = pinT<DIRECT>(p, ws, I_EWD) + le * DEXP * DM; c.K = DEXP; c.N = DM; c.kind = TK_DOWN; c.dst0 = (bf16_t*)(ws + WS_WD) + le * DM * DEXP; } }
    const int nblk = c.N / 64; c.k0 = 64 * (item / nblk); c.n0 = 64 * (item % nblk);
    return c;
}
template <bool DIRECT> DI void conv_range(const Params& p, unsigned char* ws, int l, int first, int step, int end, LAS float* scr, int lane) {
    if (first >= end) return;
    f32x4 va[16], vb[16];
    ConvItem ca = conv_desc<DIRECT>(p, ws, l, first), cb = ca;
    conv_load(ca, va, lane);
    for (int it = first; it < end; it += 2 * step) {
        const bool hb = it + step < end;
        if (hb) { cb = conv_desc<DIRECT>(p, ws, l, it + step); conv_load(cb, vb, lane); }
        conv_store(ca, va, scr, lane);
        if (!hb) break;
        const bool ha = it + 2 * step < end;
        if (ha) { ca = conv_desc<DIRECT>(p, ws, l, it + 2 * step); conv_load(ca, va, lane); }
        conv_store(cb, vb, scr, lane);
        if (!ha) break;
    }
}
constexpr int CONV_UNIT = 64, N_CONV_UNITS = (IT_LAYER + CONV_UNIT - 1) / CONV_UNIT;
DI void conv_unit(const Params& p, LAS unsigned char* lds, int l, int u) {
    unsigned char* ws = ows(p);
    const int tid = otid(), lane = tid & 63, wave = __builtin_amdgcn_readfirstlane(tid >> 6);
    LAS float* scr = (LAS float*)(lds + wave * 16640);
    const int hi = (u + 1) * CONV_UNIT < IT_LAYER ? (u + 1) * CONV_UNIT : IT_LAYER;
    conv_range<false>(p, ws, l, u * CONV_UNIT + wave, 8, hi, scr, lane);
}

DI void phase_prologue(const Params& p, LAS unsigned char* lds, int bid, int G) {
    const int tid = otid(), lane = tid & 63, wave = __builtin_amdgcn_readfirstlane(tid >> 6);
    unsigned char* ws = ows(p);
    LAS float* scr = (LAS float*)(lds + wave * 16640);
    const int gw = bid * 8 + wave, NGW = G * 8;
    if (bid == 0 && tid < 25) ((unsigned long long*)(ws + WS_CTL + PTR_TAB_BYTES))[tid] = (unsigned long long)p.in[tid];
    conv_range<true>(p, ws, 0, gw, NGW, IT_LAYER, scr, lane);
    const int gt = bid * NTHR + tid, NG = G * NTHR;
    {
        const f32x4* x4 = (const f32x4*)p.in[I_X]; u32x2* xb = (u32x2*)(ws + WS_XB);
        for (int i = gt; i < NT * DM / 4; i += NG) { const f32x4 v = x4[i]; xb[i] = (u32x2){pk2(v.x, v.y), pk2(v.z, v.w)}; }
    }
    {
        float* cs = (float*)(ws + WS_COS); const int* pos = (const int*)p.in[I_POS];
        for (int i = gt; i < NT * 32; i += NG) {
            const int tok = i >> 5, j = i & 31;
            const float inv = 1.0f / powf(10000.0f, (float)(2 * j) / 64.0f);
            const float ang = (float)pos[tok] * inv;
            const double a = (double)ang; const double k = rint(a * 0.15915494309189535); const double rr = a - k * 6.283185307179586476925;
            const float rf = (float)rr;
            cs[i] = cosf(rf); cs[NT * 32 + i] = sinf(rf);
        }
    }
    {
        float* lb = (float*)(ws + WS_LB); const float* lg = p.in[I_LBLOG];
        for (int c = gt; c < 512; c += NG) {
            float v[DEPTH], mx = -3.0e38f;
            for (int l = 0; l < DEPTH; ++l) { v[l] = lg[l * 512 + c]; mx = fmaxf(mx, v[l]); }
            float s = 0.f; for (int l = 0; l < DEPTH; ++l) { v[l] = expf(v[l] - mx); s += v[l]; }
            float cum = 0.f, first = 0.f;
            for (int l = 0; l < DEPTH; ++l) { cum += v[l] / s; if (l == 0) first = cum; lb[l * 512 + c] = cum - first; }
        }
    }
    {
        bf16_t* o = (bf16_t*)(ws + WS_SGUW); const float* w = p.in[I_SGU_WS];
        for (int i = gt; i < DEPTH * 4 * 128 * 128; i += NG) { const int s = i & 127, t = (i >> 7) & 127; o[i] = f2bf(s <= t ? w[i] : 0.f); }
    }
    {
        const float* rgw = p.in[I_RGW]; const float* rew = p.in[I_REW]; const float* l1g = p.in[I_LN1G]; const float* l1b = p.in[I_LN1B]; const float* rgb = p.in[I_RGB]; const float* reb = p.in[I_REB];
        float* rw = (float*)(ws + WS_ROUTW);
        for (int i = gt; i < DEPTH * 48 * DM; i += NG) {
            const int k = i % DM, n = (i / DM) % 48, l = i / (DM * 48);
            float w = 0.f;
            if (n < 4) w = rgw[((size_t)l * DM + k) * 4 + n]; else if (n < 36) w = rew[((size_t)l * DM + k) * 32 + (n - 4)];
            rw[i] = w * l1g[l * DM + k];
        }
        float* rc = (float*)(ws + WS_ROUTC);
        for (int it = gw; it < DEPTH * 48; it += NGW) {
            const int l = it / 48, n = it % 48; float s1 = 0.f, s0 = 0.f;
            if (n < 36) for (int k = lane; k < DM; k += 64) {
                const float w = (n < 4) ? rgw[((size_t)l * DM + k) * 4 + n] : rew[((size_t)l * DM + k) * 32 + (n - 4)];
                s1 += w * l1g[l * DM + k]; s0 += w * l1b[l * DM + k]; }
            s1 = wave_sum(s1); s0 = wave_sum(s0);
            if (lane == 0) { const float bias = (n < 4) ? rgb[l * 4 + n] : (n < 36 ? reb[l * 32 + n - 4] : 0.f); rc[(l * 2 + 0) * 48 + n] = s0 + bias; rc[(l * 2 + 1) * 48 + n] = s1; }
        }
    }
}

struct EpiInProj {
    static constexpr bool PERM = true;
    bf16_t* HB; float* LOGF; float* SSQ; const float* lb;
    template <int KIND> DI void run(const f32x4 (&acc)[2][2][4][2], const g8::Unit& u, int wr, int wc, int fr, int fq) const {
        const int row0 = u.pm * 256 + wr * 64 + fr, col0 = u.pn * 256 + wc * 32 + 8 * fq;
        float lbv[2][8];
        if constexpr (KIND == 2) {
#pragma unroll
            for (int bj = 0; bj < 2; ++bj)
#pragma unroll
                for (int i = 0; i < 8; ++i) lbv[bj][i] = lb[col0 - 1536 + bj * 128 + i];
        }
#pragma unroll
        for (int ai = 0; ai < 2; ++ai)
#pragma unroll
            for (int m = 0; m < 4; ++m) {
                const int row = row0 + ai * 128 + m * 16; float ssq = 0.f;
#pragma unroll
                for (int bj = 0; bj < 2; ++bj) {
                    float v[8];
#pragma unroll
                    for (int i = 0; i < 4; ++i) { v[i] = acc[ai][bj][m][0][i]; v[4 + i] = acc[ai][bj][m][1][i]; }
                    const int col = col0 + bj * 128;
                    if constexpr (KIND == 0) {
#pragma unroll
                        for (int i = 0; i < 8; ++i) v[i] = geluf_(v[i]);
                    } else if constexpr (KIND == 1) {
#pragma unroll
                        for (int i = 0; i < 8; ++i) v[i] = siluf_(v[i]);
                    } else if constexpr (KIND == 2) {
                        float lf[8];
#pragma unroll
                        for (int i = 0; i < 8; ++i) { const float e = __expf(v[i]), l_ = lbv[bj][i];
                            const float f = l_ + (1.0f - l_) * rcp_(1.0f + __expf(-v[i]));
                            lf[i] = logf(f); v[i] = (1.0f - l_) * rcp_(1.0f + e); }
                        float* lp = LOGF + (size_t)row * 512 + (col - 1536);
                        *(f32x4*)lp = (f32x4){lf[0], lf[1], lf[2], lf[3]}; *(f32x4*)(lp + 4) = (f32x4){lf[4], lf[5], lf[6], lf[7]};
                    } else if constexpr (KIND == 4) {
#pragma unroll
                        for (int i = 0; i < 8; ++i) ssq += v[i] * v[i];
                    }
                    u32x4 w; w.x = pk2(v[0], v[1]); w.y = pk2(v[2], v[3]); w.z = pk2(v[4], v[5]); w.w = pk2(v[6], v[7]);
                    *(u32x4*)(HB + (size_t)row * 4096 + col) = w;
                }
                if constexpr (KIND == 4) {
                    ssq += __shfl_xor(ssq, 16); ssq += __shfl_xor(ssq, 32);
                    if (fq == 0) SSQ[(size_t)row * 16 + (u.pn - 12) * 4 + wc] = ssq;
                }
            }
    }
    DI void operator()(const f32x4 (&acc)[2][2][4][2], const g8::Unit& u, int wr, int wc, int fr, int fq) const {
        const int pn = u.pn;
        if (pn < 4) run<0>(acc, u, wr, wc, fr, fq);
        else if (pn < 6) run<1>(acc, u, wr, wc, fr, fq);
        else if (pn < 8) run<2>(acc, u, wr, wc, fr, fq);
        else if (pn < 10) run<3>(acc, u, wr, wc, fr, fq);
        else if (pn < 12) run<1>(acc, u, wr, wc, fr, fq);
        else run<4>(acc, u, wr, wc, fr, fq);
    }
};
DI void phase_inproj(const Params& p, LAS unsigned char* lds, int bid, int G, int l) {
    unsigned char* ws = ows(p);
    g8::StaticSched S; S.init(ws + WS_XB, (bf16_t*)(ws + WS_WIN) + (size_t)l * DIN * DM, NT, DIN_MAIN, DM, DM, G, bid);
    EpiInProj E{(bf16_t*)(ws + WS_HB), (float*)(ws + WS_LOGF), (float*)(ws + WS_SSQ), (const float*)(ws + WS_LB) + l * 512};
    g8::gemm_phase<EpiInProj, g8::StaticSched, false>(lds, DM, DM, DM, S, E);
}

DI void phase_krope(const Params& p, LAS unsigned char* lds, int bid, int G, int l) {
    unsigned char* ws = ows(p);
    const int tid = otid(), lane = tid & 63, wave = __builtin_amdgcn_readfirstlane(tid >> 6), fr = lane & 15, fq = lane >> 4;
    const bf16_t* X = (const bf16_t*)(ws + WS_XB); const bf16_t* W = (const bf16_t*)(ws + WS_WIN) + ((size_t)l * DIN + 4096) * DM;
    const float* cs = (const float*)(ws + WS_COS); bf16_t* KR = (bf16_t*)(ws + WS_KR);
    LAS float* PART = (LAS float*)lds;
    for (int task = bid; task < NT / 16; task += G) {
        const int r0 = task * 16;
        f32x4 acc[4];
#pragma unroll
        for (int n = 0; n < 4; ++n) acc[n] = (f32x4){0.f, 0.f, 0.f, 0.f};
        const bf16_t* ap = X + (size_t)(r0 + fr) * DM + 256 * wave + 8 * fq;
        const bf16_t* bp = W + (size_t)fr * DM + 256 * wave + 8 * fq;
#pragma unroll
        for (int s2 = 0; s2 < 8; ++s2) {
            const bf16x8 a = *(const bf16x8*)(ap + 32 * s2);
#pragma unroll
            for (int n = 0; n < 4; ++n) { const bf16x8 b = *(const bf16x8*)(bp + (size_t)(16 * n) * DM + 32 * s2); acc[n] = __builtin_amdgcn_mfma_f32_16x16x32_bf16(a, b, acc[n], 0, 0, 0); }
        }
        __syncthreads();
#pragma unroll
        for (int n = 0; n < 4; ++n)
#pragma unroll
            for (int i = 0; i < 4; ++i) PART[(wave * 16 + 4 * fq + i) * 64 + 16 * n + fr] = acc[n][i];
        __syncthreads();
        {
            const int row = tid >> 5, j = tid & 31; float x1 = 0.f, x2 = 0.f;
#pragma unroll
            for (int w = 0; w < 8; ++w) { const f32x2 v = *(const LAS f32x2*)(PART + (w * 16 + row) * 64 + 2 * j); x1 += v.x; x2 += v.y; }
            const size_t grow = (size_t)(r0 + row);
            const float c = cs[grow * 32 + j], sn = cs[(size_t)NT * 32 + grow * 32 + j];
            *(unsigned*)(KR + grow * 64 + 2 * j) = pk2(x1 * c - x2 * sn, x2 * c + x1 * sn);
        }
    }
}

DI void phase_sgu(const Params& p, LAS unsigned char* lds, int bid, int G, int l) {
    unsigned char* ws = ows(p);
    const int tid = otid(), lane = tid & 63, wave = tid >> 6, fr = lane & 15, fq = lane >> 4;
    const bf16_t* HB = (const bf16_t*)(ws + WS_HB); bf16_t* CAT = (bf16_t*)(ws + WS_CAT);
    const bf16_t* SW = (const bf16_t*)(ws + WS_SGUW) + (size_t)l * 4 * 128 * 128;
    const float* lng = pinT<false>(p, ws, I_SGU_LNG) + l * 512; const float* lnb = pinT<false>(p, ws, I_SGU_LNB) + l * 512; const float* sb = pinT<false>(p, ws, I_SGU_B) + l * 512;
    constexpr int TS = 272;
    LAS unsigned char* T = lds;
    for (int unit = bid; unit < 128 * 4; unit += G) {
        const int ci = unit >> 2, g = unit & 3, rbase = ci * 128;
        __syncthreads();
        for (int rr = 0; rr < 4; ++rr) {
            const int s = wave * 16 + rr * 4 + fq, row = rbase + s;
            float v[4][8]; float sm = 0.f;
#pragma unroll
            for (int j = 0; j < 4; ++j) { const u32x4 raw = *(const u32x4*)(HB + (size_t)row * 4096 + 512 + 128 * j + 8 * fr);
                v[j][0] = bflo(raw.x); v[j][1] = bfhi(raw.x); v[j][2] = bflo(raw.y); v[j][3] = bfhi(raw.y); v[j][4] = bflo(raw.z); v[j][5] = bfhi(raw.z); v[j][6] = bflo(raw.w); v[j][7] = bfhi(raw.w);
#pragma unroll
                for (int i = 0; i < 8; ++i) sm += v[j][i]; }
            sm += __shfl_xor(sm, 1); sm += __shfl_xor(sm, 2); sm += __shfl_xor(sm, 4); sm += __shfl_xor(sm, 8);
            const float mean = sm * (1.0f / 512.0f); float sq = 0.f;
#pragma unroll
            for (int j = 0; j < 4; ++j)
#pragma unroll
                for (int i = 0; i < 8; ++i) { v[j][i] -= mean; sq += v[j][i] * v[j][i]; }
            sq += __shfl_xor(sq, 1); sq += __shfl_xor(sq, 2); sq += __shfl_xor(sq, 4); sq += __shfl_xor(sq, 8);
            const float rstd = rsq_(sq * (1.0f / 512.0f) + EPS);
#pragma unroll
            for (int j = 0; j < 4; ++j) if (j == g) {
#pragma unroll
                for (int i = 0; i < 8; ++i) { const int c = 128 * j + 8 * fr + i, d = 8 * fr + i; const float y = v[j][i] * rstd * lng[c] + lnb[c];
                    *(LAS bf16_t*)(T + d * TS + s * 2) = f2bf(y); }
            }
        }
        __syncthreads();
        f32x4 acc[8];
#pragma unroll
        for (int n = 0; n < 8; ++n) acc[n] = (f32x4){0.f, 0.f, 0.f, 0.f};
        const bf16_t* wp = SW + ((size_t)g * 128 + wave * 16 + fr) * 128 + 8 * fq;
        const int ksmax = wave >> 1;
        for (int ks = 0; ks <= ksmax; ++ks) {
            const bf16x8 a = *(const bf16x8*)(wp + 32 * ks);
#pragma unroll
            for (int n = 0; n < 8; ++n) { const bf16x8 b = *(const LAS bf16x8*)(T + (16 * n + fr) * TS + (32 * ks + 8 * fq) * 2); acc[n] = __builtin_amdgcn_mfma_f32_16x16x32_bf16(a, b, acc[n], 0, 0, 0); }
        }
#pragma unroll
        for (int i = 0; i < 4; ++i) {
            const int t = wave * 16 + 4 * fq + i, row = rbase + t; const float bias = sb[g * 128 + t];
#pragma unroll
            for (int n = 0; n < 8; ++n) { const int c = g * 128 + 16 * n + fr; const float uu = bf2f(HB[(size_t)row * 4096 + c]);
                CAT[(size_t)row * DM + c] = f2bf(uu * (acc[n][i] + bias)); }
        }
    }
}

constexpr int HQ_OFF = 0, HK_OFF = 17408, HG_OFF = 34816, HKD_OFF = 52224, HV_OFF = 70656, HP_OFF = 89088, HSEG_OFF = 98304;
constexpr int HS_T = 272, HS_S = 144;
#define HG_BAR() do { asm volatile("s_waitcnt lgkmcnt(0)" ::: "memory"); __builtin_amdgcn_s_barrier(); asm volatile("" ::: "memory"); } while (0)
DI void hgrn_local_unit(const bf16_t* HB, const float* LOGF, float* OI, float* UU, bf16_t* QGg, float* DLg, LAS unsigned char* lds, int b, int h, int c) {
    const int tid = otid(), lane = tid & 63, wave = __builtin_amdgcn_readfirstlane(tid >> 6), fr = lane & 15, fq = lane >> 4;
    const int kp = lane, seg = wave;
    const size_t unit = (size_t)((b * 4 + h) * 64 + c), rowb = (size_t)b * SEQ;
    f32x2 lf[8]; unsigned qr[8], kr[8], vr[8];
#pragma unroll
    for (int i = 0; i < 8; ++i) { const size_t row = rowb + c * 64 + 8 * seg + i;
        lf[i] = *(const f32x2*)(LOGF + row * 512 + h * 128 + 2 * kp); const bf16_t* hp = HB + row * 4096 + h * 128 + 2 * kp;
        qr[i] = *(const unsigned*)(hp + 1024); kr[i] = *(const unsigned*)(hp + 1536); vr[i] = *(const unsigned*)(hp + 2048); }
    __syncthreads();
    if (tid < 128) { const int t = (tid < 64) ? (tid >> 2) : 32 + ((tid - 64) >> 2), s0 = ((tid < 64) ? 16 : 48) + 4 * (tid & 3);
        unsigned z = 0u; asm volatile("" : "+v"(z));
        *(LAS u32x2*)(lds + HP_OFF + t * HS_S + s0 * 2) = (u32x2){z, z}; }
    { float c0 = 0.f, c1 = 0.f;
#pragma unroll
      for (int i = 0; i < 8; ++i) { c0 += lf[i].x; c1 += lf[i].y; lf[i].x = c0; lf[i].y = c1; }
      *(LAS f32x2*)(lds + HSEG_OFF + (seg * 128 + 2 * kp) * 4) = (f32x2){c0, c1}; }
    HG_BAR();
    { f32x2 off = {0.f, 0.f}, R = {0.f, 0.f}, GL = {0.f, 0.f};
#pragma unroll
      for (int j = 0; j < 8; ++j) { const f32x2 tj = *(const LAS f32x2*)(lds + HSEG_OFF + (j * 128 + 2 * kp) * 4); if (j < seg) off += tj; if (j < 4) R += tj; GL += tj; }
      const f32x2 eR = {__expf(R.x), __expf(R.y)}, eGR = {__expf(GL.x - R.x), __expf(GL.y - R.y)};
      float kd0[8], kd1[8];
#pragma unroll
      for (int i = 0; i < 8; ++i) {
          const int t = 8 * seg + i; const float g0 = off.x + lf[i].x, g1 = off.y + lf[i].y;
          const float e10 = __expf(g0 - R.x), e11 = __expf(g1 - R.y), e20 = __expf(R.x - g0), e21 = __expf(R.y - g1), e30 = e10 * eR.x, e31 = e11 * eR.y, e40 = e20 * eGR.x, e41 = e21 * eGR.y;
          const float q0 = bflo(qr[i]), q1 = bfhi(qr[i]), k0 = bflo(kr[i]), k1 = bfhi(kr[i]);
          *(LAS unsigned*)(lds + HQ_OFF + t * HS_T + kp * 4) = pk2(q0 * e10, q1 * e11);
          *(LAS unsigned*)(lds + HK_OFF + t * HS_T + kp * 4) = pk2(k0 * e20, k1 * e21);
          *(LAS unsigned*)(lds + HG_OFF + t * HS_T + kp * 4) = pk2(q0 * e30, q1 * e31);
          kd0[i] = k0 * e40; kd1[i] = k1 * e41;
      }
      *(LAS u32x4*)(lds + HKD_OFF + (2 * kp) * HS_S + 16 * seg) = (u32x4){pk2(kd0[0], kd0[1]), pk2(kd0[2], kd0[3]), pk2(kd0[4], kd0[5]), pk2(kd0[6], kd0[7])};
      *(LAS u32x4*)(lds + HKD_OFF + (2 * kp + 1) * HS_S + 16 * seg) = (u32x4){pk2(kd1[0], kd1[1]), pk2(kd1[2], kd1[3]), pk2(kd1[4], kd1[5]), pk2(kd1[6], kd1[7])};
      u32x4 v0, v1;
      v0.x = (vr[0] & 0xffffu) | (vr[1] << 16); v0.y = (vr[2] & 0xffffu) | (vr[3] << 16); v0.z = (vr[4] & 0xffffu) | (vr[5] << 16); v0.w = (vr[6] & 0xffffu) | (vr[7] << 16);
      v1.x = (vr[0] >> 16) | (vr[1] & 0xffff0000u); v1.y = (vr[2] >> 16) | (vr[3] & 0xffff0000u); v1.z = (vr[4] >> 16) | (vr[5] & 0xffff0000u); v1.w = (vr[6] >> 16) | (vr[7] & 0xffff0000u);
      *(LAS u32x4*)(lds + HV_OFF + (2 * kp) * HS_S + 16 * seg) = v0;
      *(LAS u32x4*)(lds + HV_OFF + (2 * kp + 1) * HS_S + 16 * seg) = v1;
      if (seg == 0) *(f32x2*)(DLg + unit * 128 + 2 * kp) = (f32x2){__expf(GL.x), __expf(GL.y)};
    }
    HG_BAR();
    for (int rep = 0; rep < 2; ++rep) {
        const int idx = wave + 8 * rep; if (idx >= 10) break;
        const int a = (int)((0x3221110000ULL >> (4 * idx)) & 0xf), bt = (int)((0x3323213210ULL >> (4 * idx)) & 0xf);
        f32x4 pacc = {0.f, 0.f, 0.f, 0.f};
#pragma unroll
        for (int ks = 0; ks < 4; ++ks) {
            const bf16x8 af = *(const LAS bf16x8*)(lds + HK_OFF + (16 * a + fr) * HS_T + (32 * ks + 8 * fq) * 2);
            const bf16x8 bf = *(const LAS bf16x8*)(lds + HQ_OFF + (16 * bt + fr) * HS_T + (32 * ks + 8 * fq) * 2);
            pacc = __builtin_amdgcn_mfma_f32_16x16x32_bf16(af, bf, pacc, 0, 0, 0);
        }
        const int t = 16 * bt + fr, s0 = 16 * a + 4 * fq;
#pragma unroll
        for (int i = 0; i < 4; ++i) if (s0 + i > t) pacc[i] = 0.f;
        *(LAS u32x2*)(lds + HP_OFF + t * HS_S + s0 * 2) = (u32x2){pk2(pacc[0], pacc[1]), pk2(pacc[2], pacc[3])};
    }
#pragma unroll
    for (int jj = 0; jj < 2; ++jj) { const int pp = tid + 512 * jj, t = pp >> 4, c16 = pp & 15;
        *(u32x4*)(QGg + unit * 8192 + t * 128 + c16 * 8) = *(const LAS u32x4*)(lds + HG_OFF + t * HS_T + c16 * 16); }
    HG_BAR();
    {
        bf16x8 vf[2];
#pragma unroll
        for (int ss = 0; ss < 2; ++ss) vf[ss] = *(const LAS bf16x8*)(lds + HV_OFF + (16 * wave + fr) * HS_S + (32 * ss + 8 * fq) * 2);
        u32x4* oi = (u32x4*)OI + (unit * 8 + wave) * 2 * 64 + lane;
        f32x4 oacc[4];
#pragma unroll
        for (int bt = 0; bt < 4; ++bt) {
            f32x4 acc = {0.f, 0.f, 0.f, 0.f};
#pragma unroll
            for (int ss = 0; ss < 2; ++ss) if (32 * ss <= 16 * bt + 15) {
                const bf16x8 pf = *(const LAS bf16x8*)(lds + HP_OFF + (16 * bt + fr) * HS_S + (32 * ss + 8 * fq) * 2);
                acc = __builtin_amdgcn_mfma_f32_16x16x32_bf16(pf, vf[ss], acc, 0, 0, 0);
            }
            oacc[bt] = acc;
        }
#pragma unroll
        for (int pr = 0; pr < 2; ++pr) oi[pr * 64] = (u32x4){pk2(oacc[2 * pr][0], oacc[2 * pr][1]), pk2(oacc[2 * pr][2], oacc[2 * pr][3]), pk2(oacc[2 * pr + 1][0], oacc[2 * pr + 1][1]), pk2(oacc[2 * pr + 1][2], oacc[2 * pr + 1][3])};
        u32x4* uu = (u32x4*)UU + (unit * 8 + wave) * 4 * 64 + lane;
        f32x4 uacc[8];
#pragma unroll
        for (int a = 0; a < 8; ++a) {
            f32x4 acc = {0.f, 0.f, 0.f, 0.f};
#pragma unroll
            for (int ss = 0; ss < 2; ++ss) {
                const bf16x8 kf = *(const LAS bf16x8*)(lds + HKD_OFF + (16 * a + fr) * HS_S + (32 * ss + 8 * fq) * 2);
                acc = __builtin_amdgcn_mfma_f32_16x16x32_bf16(kf, vf[ss], acc, 0, 0, 0);
            }
            uacc[a] = acc;
        }
#pragma unroll
        for (int a2 = 0; a2 < 4; ++a2) uu[a2 * 64] = (u32x4){pk2(uacc[2 * a2][0], uacc[2 * a2][1]), pk2(uacc[2 * a2][2], uacc[2 * a2][3]), pk2(uacc[2 * a2 + 1][0], uacc[2 * a2 + 1][1]), pk2(uacc[2 * a2 + 1][2], uacc[2 * a2 + 1][3])};
    }
}
DI void phase_hgrn_local(const Params& p, LAS unsigned char* lds, int bid, int G, int l) {
    unsigned char* ws = ows(p);
    for (int u = bid; u < 1024; u += G) { const int bh = u >> 6, c = u & 63;
        hgrn_local_unit((const bf16_t*)(ws + WS_HB), (const float*)(ws + WS_LOGF), (float*)(ws + WS_OH), (float*)(ws + WS_HU), (bf16_t*)(ws + WS_HQG), (float*)(ws + WS_HDL), lds, bh >> 2, bh & 3, c); }
}
constexpr int SQ_OFF = 0, SOT_OFF = 34816, SSS_OFF = 67584, SDL_OFF = 71680;
struct HsW { u32x4 oi[2], u[4]; };
struct HsQ { u32x4 q[2]; f32x4 d; };
DI void hgrn_seq_unit(const bf16_t* HB, const float* OI, const float* UU, const bf16_t* QGg, const float* DLg, const float* ng, bf16_t* CAT, LAS unsigned char* lds, int b, int h) {
    const int tid = otid(), lane = tid & 63, wave = __builtin_amdgcn_readfirstlane(tid >> 6), fr = lane & 15, fq = lane >> 4;
    const size_t unit0 = (size_t)((b * 4 + h) * 64), rowb = (size_t)b * SEQ;
    f32x4 S[8];
#pragma unroll
    for (int a = 0; a < 8; ++a) S[a] = (f32x4){0.f, 0.f, 0.f, 0.f};
    HsW w0, w1, w2; HsQ q1, q2; u32x4 g0[2], g1[2];
    w2 = HsW{}; q2 = HsQ{};
#define HS_LOADW(W, c) do { const size_t un = unit0 + (c); const u32x4* oi_ = (const u32x4*)OI + (un * 8 + wave) * 2 * 64 + lane; const u32x4* uu_ = (const u32x4*)UU + (un * 8 + wave) * 4 * 64 + lane; \
        asm volatile("" : "+v"(oi_), "+v"(uu_)); W.oi[0] = oi_[0]; W.oi[1] = oi_[64]; W.u[0] = uu_[0]; W.u[1] = uu_[64]; W.u[2] = uu_[128]; W.u[3] = uu_[192]; } while (0)
#define HS_LOADQ(Qs, c) do { _Pragma("unroll") for (int jj = 0; jj < 2; ++jj) { const int pp = tid + 512 * jj; Qs.q[jj] = *(const u32x4*)(QGg + (unit0 + (c)) * 8192 + (pp >> 4) * 128 + (pp & 15) * 8); } \
        Qs.d = (tid < 32) ? *(const f32x4*)(DLg + (unit0 + (c)) * 128 + 4 * (tid & 31)) : (f32x4){0.f, 0.f, 0.f, 0.f}; } while (0)
#define HS_STOREQ(Qs, buf) do { _Pragma("unroll") for (int jj = 0; jj < 2; ++jj) { const int pp = tid + 512 * jj; *(LAS u32x4*)(lds + SQ_OFF + (buf) * 17408 + (pp >> 4) * HS_T + (pp & 15) * 16) = Qs.q[jj]; } \
        if (tid < 32) *(LAS f32x4*)(lds + SDL_OFF + (buf) * 512 + tid * 16) = Qs.d; } while (0)
#define HS_LOADG(Gs, c) do { _Pragma("unroll") for (int jj = 0; jj < 2; ++jj) Gs[jj] = *(const u32x4*)(HB + (rowb + (c) * 64 + (lane >> 1) + 32 * jj) * 4096 + 2560 + h * 128 + 16 * wave + 8 * (lane & 1)); } while (0)
    const int v0 = h * 128 + 16 * wave + 8 * (lane & 1);
    const f32x4 gn0 = *(const f32x4*)(ng + v0), gn1 = *(const f32x4*)(ng + v0 + 4);
    __syncthreads();
    HS_LOADQ(q1, 0); HS_LOADW(w0, 0); HS_LOADG(g0, 0);
    HS_STOREQ(q1, 0);
    HS_LOADQ(q1, 1); HS_LOADW(w1, 1);
    HG_BAR();
    for (int c = 0; c < SEQ / 64; ++c) {
        const int buf = c & 1;
        if (c + 2 < SEQ / 64) { HS_LOADQ(q2, c + 2); HS_LOADW(w2, c + 2); }
        if (c + 1 < SEQ / 64) HS_LOADG(g1, c + 1);
        f32x4 o[4];
        {
            bf16x8 sf[4];
#pragma unroll
            for (int a2 = 0; a2 < 4; ++a2) { const u32x4 w = {pk2(S[2 * a2][0], S[2 * a2][1]), pk2(S[2 * a2][2], S[2 * a2][3]), pk2(S[2 * a2 + 1][0], S[2 * a2 + 1][1]), pk2(S[2 * a2 + 1][2], S[2 * a2 + 1][3])}; sf[a2] = __builtin_bit_cast(bf16x8, w); }
#pragma unroll
            for (int bt = 0; bt < 4; ++bt) {
                const u32x4 ow = w0.oi[bt >> 1];
                f32x4 acc = (bt & 1) ? (f32x4){bflo(ow.z), bfhi(ow.z), bflo(ow.w), bfhi(ow.w)} : (f32x4){bflo(ow.x), bfhi(ow.x), bflo(ow.y), bfhi(ow.y)};
#pragma unroll
                for (int a2 = 0; a2 < 4; ++a2) {
                    const LAS unsigned char* gp = lds + SQ_OFF + buf * 17408 + (16 * bt + fr) * HS_T + (32 * a2 + 4 * fq) * 2;
                    const u32x2 lo = *(const LAS u32x2*)gp, hi = *(const LAS u32x2*)(gp + 32);
                    const u32x4 w = {lo.x, lo.y, hi.x, hi.y};
                    acc = __builtin_amdgcn_mfma_f32_16x16x32_bf16(__builtin_bit_cast(bf16x8, w), sf[a2], acc, 0, 0, 0);
                }
                o[bt] = acc;
            }
#pragma unroll
            for (int a = 0; a < 8; ++a) { const u32x4 uw = w0.u[a >> 1];
                const f32x4 uv = (a & 1) ? (f32x4){bflo(uw.z), bfhi(uw.z), bflo(uw.w), bfhi(uw.w)} : (f32x4){bflo(uw.x), bfhi(uw.x), bflo(uw.y), bfhi(uw.y)};
                S[a] = S[a] * *(const LAS f32x4*)(lds + SDL_OFF + buf * 512 + (16 * a + 4 * fq) * 4) + uv; }
        }
        LAS unsigned char* ot = lds + SOT_OFF + wave * 4096;
#pragma unroll
        for (int bt = 0; bt < 4; ++bt)
#pragma unroll
            for (int i = 0; i < 4; ++i) *(LAS float*)(ot + (16 * bt + 4 * fq + i) * 64 + fr * 4) = o[bt][i];
        asm volatile("s_waitcnt lgkmcnt(0)" ::: "memory");
        f32x4 orow[2][2];
#pragma unroll
        for (int jj = 0; jj < 2; ++jj) {
            const LAS unsigned char* rp = ot + ((lane >> 1) + 32 * jj) * 64 + (lane & 1) * 32;
            orow[jj][0] = *(const LAS f32x4*)rp; orow[jj][1] = *(const LAS f32x4*)(rp + 16);
            const f32x4 a = orow[jj][0], bb = orow[jj][1];
            float q2s = (a.x * a.x + a.y * a.y) + (a.z * a.z + a.w * a.w) + (bb.x * bb.x + bb.y * bb.y) + (bb.z * bb.z + bb.w * bb.w);
            q2s += __shfl_xor(q2s, 1);
            if ((lane & 1) == 0) *(LAS float*)(lds + SSS_OFF + buf * 2048 + (((lane >> 1) + 32 * jj) * 8 + wave) * 4) = q2s;
        }
        if (c + 1 < SEQ / 64) HS_STOREQ(q1, buf ^ 1);
        HG_BAR();
#pragma unroll
        for (int jj = 0; jj < 2; ++jj) {
            const int t = (lane >> 1) + 32 * jj;
            const LAS float* sp = (const LAS float*)(lds + SSS_OFF + buf * 2048 + t * 32);
            const f32x4 s0 = *(const LAS f32x4*)sp, s1 = *(const LAS f32x4*)(sp + 4);
            const float ssum = (s0.x + s0.y) + (s0.z + s0.w) + (s1.x + s1.y) + (s1.z + s1.w);
            const float rstd = rsq_(ssum * (1.0f / 128.0f) + EPS);
            const u32x4 g = g0[jj];
            const f32x4 y0 = orow[jj][0] * rstd * gn0 * (f32x4){bflo(g.x), bfhi(g.x), bflo(g.y), bfhi(g.y)};
            const f32x4 y1 = orow[jj][1] * rstd * gn1 * (f32x4){bflo(g.z), bfhi(g.z), bflo(g.w), bfhi(g.w)};
            *(u32x4*)(CAT + (rowb + c * 64 + t) * DM + 512 + v0) = (u32x4){pk2(y0.x, y0.y), pk2(y0.z, y0.w), pk2(y1.x, y1.y), pk2(y1.z, y1.w)};
        }
        w0 = w1; w1 = w2; q1 = q2; g0[0] = g1[0]; g0[1] = g1[1];
    }
#undef HS_LOADQ
#undef HS_STOREQ
#undef HS_LOADW
#undef HS_LOADG
}
#undef HG_BAR

DI float rstd_from_ssq(const float* SSQ, int row, int which) {
    const f32x4 a = *(const f32x4*)(SSQ + (size_t)row * 16 + which * 8), b = *(const f32x4*)(SSQ + (size_t)row * 16 + which * 8 + 4);
    const float s = (a.x + a.y) + (a.z + a.w) + (b.x + b.y) + (b.z + b.w);
    return rsq_(s * (1.0f / 512.0f) + EPS);
}
struct EpiQ {
    static constexpr bool PERM = true;
    bf16_t* Q; const float* SSQ; const float* cs;
    DI void operator()(const f32x4 (&acc)[2][2][4][2], const g8::Unit& u, int wr, int wc, int fr, int fq) const {
        const int row0 = u.pm * 256 + wr * 64 + fr, col0 = u.pn * 256 + wc * 32 + 8 * fq;
#pragma unroll
        for (int ai = 0; ai < 2; ++ai)
#pragma unroll
            for (int m = 0; m < 4; ++m) {
                const int row = row0 + ai * 128 + m * 16; const float sc = rstd_from_ssq(SSQ, row, 0) * QSCALE;
#pragma unroll
                for (int bj = 0; bj < 2; ++bj) {
                    const int col = col0 + bj * 128, cc = col % 192;
                    float v[8];
#pragma unroll
                    for (int i = 0; i < 4; ++i) { v[i] = acc[ai][bj][m][0][i] * sc; v[4 + i] = acc[ai][bj][m][1][i] * sc; }
                    if (cc >= 128) {
                        const int j0 = (cc - 128) >> 1;
                        const f32x4 c = *(const f32x4*)(cs + (size_t)row * 32 + j0), s = *(const f32x4*)(cs + (size_t)NT * 32 + (size_t)row * 32 + j0);
#pragma unroll
                        for (int i = 0; i < 4; ++i) { const float x1 = v[2 * i], x2 = v[2 * i + 1]; v[2 * i] = x1 * c[i] - x2 * s[i]; v[2 * i + 1] = x2 * c[i] + x1 * s[i]; }
                    }
                    u32x4 w; w.x = pk2(v[0], v[1]); w.y = pk2(v[2], v[3]); w.z = pk2(v[4], v[5]); w.w = pk2(v[6], v[7]);
                    *(u32x4*)(Q + (size_t)row * 1536 + col) = w;
                }
            }
    }
};
struct EpiK {
    static constexpr bool PERM = true;
    bf16_t* KN; const float* SSQ;
    DI void operator()(const f32x4 (&acc)[2][2][4][2], const g8::Unit& u, int wr, int wc, int fr, int fq) const {
        const int row0 = u.pm * 256 + wr * 64 + fr, col0 = u.pn * 256 + wc * 32 + 8 * fq;
#pragma unroll
        for (int ai = 0; ai < 2; ++ai)
#pragma unroll
            for (int m = 0; m < 4; ++m) {
                const int row = row0 + ai * 128 + m * 16; const float sc = rstd_from_ssq(SSQ, row, 1);
#pragma unroll
                for (int bj = 0; bj < 2; ++bj) {
                    const f32x4 v0 = acc[ai][bj][m][0] * sc, v1 = acc[ai][bj][m][1] * sc;
                    u32x4 w; w.x = pk2(v0[0], v0[1]); w.y = pk2(v0[2], v0[3]); w.z = pk2(v1[0], v1[1]); w.w = pk2(v1[2], v1[3]);
                    *(u32x4*)(KN + (size_t)row * 1024 + col0 + bj * 128) = w;
                }
            }
    }
};
struct EpiVT {
    static constexpr bool PERM = true;
    bf16_t* VT; const float* SSQ;
    DI void operator()(const f32x4 (&acc)[2][2][4][2], const g8::Unit& u, int wr, int wc, int fr, int fq) const {
        const int row0 = u.pm * 256 + wr * 64 + fr, col0 = u.pn * 256 + wc * 32 + 8 * fq;
        float sc[2][8];
#pragma unroll
        for (int bj = 0; bj < 2; ++bj)
#pragma unroll
            for (int i = 0; i < 8; ++i) sc[bj][i] = rstd_from_ssq(SSQ, col0 + bj * 128 + i, 1);
#pragma unroll
        for (int ai = 0; ai < 2; ++ai)
#pragma unroll
            for (int m = 0; m < 4; ++m) {
                const int row = row0 + ai * 128 + m * 16, h = row >> 7, d = row & 127;
#pragma unroll
                for (int bj = 0; bj < 2; ++bj) {
                    const int tok = col0 + bj * 128, b = tok >> 12, s = tok & 4095;
                    const f32x4 a0 = acc[ai][bj][m][0], a1 = acc[ai][bj][m][1];
                    u32x4 w; w.x = pk2(a0[0] * sc[bj][0], a0[1] * sc[bj][1]); w.y = pk2(a0[2] * sc[bj][2], a0[3] * sc[bj][3]);
                    w.z = pk2(a1[0] * sc[bj][4], a1[1] * sc[bj][5]); w.w = pk2(a1[2] * sc[bj][6], a1[3] * sc[bj][7]);
                    *(u32x4*)(VT + ((size_t)((b * 8 + h) * 128 + d)) * SEQ + s) = w;
                }
            }
    }
};
DI void phase_mla_proj(const Params& p, LAS unsigned char* lds, int bid, int G, int l) {
    unsigned char* ws = ows(p);
    const float* SSQ = (const float*)(ws + WS_SSQ); const bf16_t* HB = (const bf16_t*)(ws + WS_HB);
    {
        g8::StaticSched S; S.init(HB + 3072, (const bf16_t*)(ws + WS_WUQ) + (size_t)l * 1536 * 512, NT, 1536, 4096, 512, G, bid);
        EpiQ E{(bf16_t*)(ws + WS_Q), SSQ, (const float*)(ws + WS_COS)};
        g8::gemm_phase<EpiQ, g8::StaticSched, false>(lds, 512, 4096, 512, S, E);
    }
    {
        g8::StaticSched S; S.init(HB + 3584, (const bf16_t*)(ws + WS_WUK) + (size_t)l * 1024 * 512, NT, 1024, 4096, 512, G, bid);
        EpiK E{(bf16_t*)(ws + WS_KN), SSQ};
        g8::gemm_phase<EpiK, g8::StaticSched, false>(lds, 512, 4096, 512, S, E);
    }
    {
        g8::StaticSched S; S.init((const bf16_t*)(ws + WS_WUV) + (size_t)l * 1024 * 512, HB + 3584, 1024, NT, 512, 4096, G, bid);
        EpiVT E{(bf16_t*)(ws + WS_VT), SSQ};
        g8::gemm_phase<EpiVT, g8::StaticSched, false>(lds, 512, 512, 4096, S, E);
    }
}

constexpr int AT_KS = 400, AT_VS = 144;
constexpr int AT_KBUF = 64 * AT_KS, AT_VBUF = 128 * AT_VS;
DI void attn_unit(const bf16_t* Qg, const bf16_t* KNg, const bf16_t* KRg, const bf16_t* VTg, bf16_t* CAT, LAS unsigned char* lds, int b, int h, int qb) {
    const int tid = otid(), lane = tid & 63, wave = __builtin_amdgcn_readfirstlane(tid >> 6), c = lane & 31, hi = lane >> 5;
    const int q0 = qb * 256, qmin = q0 + 32 * wave, qrow = qmin + c, ntile = 4 * (qb + 1), jmax = (qmin + 31) >> 6;
    LAS unsigned char* Kb = lds; LAS unsigned char* Vb = lds + 2 * AT_KBUF;
    bf16x8 qf[12];
    { const bf16_t* qp = Qg + (size_t)(b * SEQ + qrow) * 1536 + h * 192 + 8 * hi;
#pragma unroll
      for (int ks = 0; ks < 12; ++ks) qf[ks] = *(const bf16x8*)(qp + 16 * ks); }
    f32x16 o[4];
#pragma unroll
    for (int d = 0; d < 4; ++d)
#pragma unroll
        for (int r = 0; r < 16; ++r) o[d][r] = 0.f;
    float m_run = -1.0e30f, l_run = 0.f;
    int ksrc_off[3], kdst[3]; bool kfromR[3];
#pragma unroll
    for (int i = 0; i < 3; ++i) { const int id = tid + 512 * i, key = id / 24, cc = id % 24; kdst[i] = key * AT_KS + cc * 16; kfromR[i] = cc >= 16;
        ksrc_off[i] = kfromR[i] ? (key * 64 + 8 * (cc - 16)) : (key * 1024 + h * 128 + 8 * cc); }
    int vsrc_off[2], vdst[2];
#pragma unroll
    for (int i = 0; i < 2; ++i) { const int id = tid + 512 * i, d = id >> 3, cc = id & 7; vdst[i] = d * AT_VS + (cc >> 1) * 32 + (cc & 1) * 8; vsrc_off[i] = d * SEQ + 8 * cc; }
    const bf16_t* KNb = KNg + (size_t)b * SEQ * 1024; const bf16_t* KRb = KRg + (size_t)b * SEQ * 64; const bf16_t* VTb = VTg + (size_t)(b * 8 + h) * 128 * SEQ;
    u32x4 kreg[3], vreg[2];
#define AT_LOAD(j) do { _Pragma("unroll") for (int i = 0; i < 3; ++i) kreg[i] = kfromR[i] ? *(const u32x4*)(KRb + (size_t)(j) * 64 * 64 + ksrc_off[i]) : *(const u32x4*)(KNb + (size_t)(j) * 64 * 1024 + ksrc_off[i]); \
                        _Pragma("unroll") for (int i = 0; i < 2; ++i) vreg[i] = *(const u32x4*)(VTb + (size_t)(j) * 64 + vsrc_off[i]); } while (0)
#define AT_STORE(buf) do { _Pragma("unroll") for (int i = 0; i < 3; ++i) *(LAS u32x4*)(Kb + (buf) * AT_KBUF + kdst[i]) = kreg[i]; \
                           _Pragma("unroll") for (int i = 0; i < 2; ++i) { *(LAS u32x2*)(Vb + (buf) * AT_VBUF + vdst[i]) = (u32x2){vreg[i].x, vreg[i].y}; *(LAS u32x2*)(Vb + (buf) * AT_VBUF + vdst[i] + 16) = (u32x2){vreg[i].z, vreg[i].w}; } } while (0)
    __syncthreads();
    AT_LOAD(0); AT_STORE(0);
    __syncthreads();
    for (int j = 0; j < ntile; ++j) {
        const int buf = j & 1;
        if (j + 1 < ntile) AT_LOAD(j + 1);
        if (j <= jmax) {
            const LAS unsigned char* kb_ = Kb + buf * AT_KBUF + c * AT_KS + 16 * hi;
            f32x16 s0, s1;
#pragma unroll
            for (int r = 0; r < 16; ++r) { s0[r] = 0.f; s1[r] = 0.f; }
#pragma unroll
            for (int ks = 0; ks < 12; ++ks) {
                const bf16x8 a0 = *(const LAS bf16x8*)(kb_ + 32 * ks), a1 = *(const LAS bf16x8*)(kb_ + 32 * AT_KS + 32 * ks);
                s0 = __builtin_amdgcn_mfma_f32_32x32x16_bf16(a0, qf[ks], s0, 0, 0, 0);
                s1 = __builtin_amdgcn_mfma_f32_32x32x16_bf16(a1, qf[ks], s1, 0, 0, 0);
            }
            if (64 * j + 63 > qmin) {
                const int dq = qrow - 64 * j - 4 * hi;
#pragma unroll
                for (int r = 0; r < 16; ++r) { const int kk = (r & 3) + 8 * (r >> 2);
                    if (kk > dq) s0[r] = -__builtin_inff();
                    if (kk + 32 > dq) s1[r] = -__builtin_inff(); }
            }
            float mx = s0[0];
#pragma unroll
            for (int r = 1; r < 16; ++r) mx = fmaxf(mx, s0[r]);
#pragma unroll
            for (int r = 0; r < 16; ++r) mx = fmaxf(mx, s1[r]);
            { auto rr = __builtin_amdgcn_permlane32_swap(__float_as_uint(mx), __float_as_uint(mx), false, false); mx = fmaxf(__uint_as_float(rr[0]), __uint_as_float(rr[1])); }
            if (!__all(mx - m_run <= 8.0f)) {
                const float m_new = fmaxf(m_run, mx), alpha = __builtin_amdgcn_exp2f(m_run - m_new);
                m_run = m_new; l_run *= alpha;
#pragma unroll
                for (int d = 0; d < 4; ++d)
#pragma unroll
                    for (int r = 0; r < 16; ++r) o[d][r] *= alpha;
            }
            float ps = 0.f;
#pragma unroll
            for (int r = 0; r < 16; ++r) { s0[r] = __builtin_amdgcn_exp2f(s0[r] - m_run); s1[r] = __builtin_amdgcn_exp2f(s1[r] - m_run); ps += s0[r] + s1[r]; }
            l_run += ps;
            bf16x8 pb[4];
#pragma unroll
            for (int s2 = 0; s2 < 2; ++s2) {
                u32x4 w0, w1;
                w0.x = pk2(s0[8 * s2 + 0], s0[8 * s2 + 1]); w0.y = pk2(s0[8 * s2 + 2], s0[8 * s2 + 3]); w0.z = pk2(s0[8 * s2 + 4], s0[8 * s2 + 5]); w0.w = pk2(s0[8 * s2 + 6], s0[8 * s2 + 7]);
                w1.x = pk2(s1[8 * s2 + 0], s1[8 * s2 + 1]); w1.y = pk2(s1[8 * s2 + 2], s1[8 * s2 + 3]); w1.z = pk2(s1[8 * s2 + 4], s1[8 * s2 + 5]); w1.w = pk2(s1[8 * s2 + 6], s1[8 * s2 + 7]);
                pb[s2] = __builtin_bit_cast(bf16x8, w0); pb[2 + s2] = __builtin_bit_cast(bf16x8, w1);
            }
            const LAS unsigned char* vb_ = Vb + buf * AT_VBUF + c * AT_VS + 16 * hi;
#pragma unroll
            for (int d = 0; d < 4; ++d)
#pragma unroll
                for (int kk = 0; kk < 4; ++kk) {
                    const bf16x8 av = *(const LAS bf16x8*)(vb_ + d * 32 * AT_VS + kk * 32);
                    o[d] = __builtin_amdgcn_mfma_f32_32x32x16_bf16(av, pb[kk], o[d], 0, 0, 0);
                }
        }
        if (j + 1 < ntile) AT_STORE(buf ^ 1);
        __syncthreads();
    }
#undef AT_LOAD
#undef AT_STORE
    float l_tot; { auto rr = __builtin_amdgcn_permlane32_swap(__float_as_uint(l_run), __float_as_uint(l_run), false, false); l_tot = __uint_as_float(rr[0]) + __uint_as_float(rr[1]); }
    const float inv = rcp_(l_tot);
    bf16_t* op = CAT + (size_t)(b * SEQ + qrow) * DM + 1024 + h * 128 + 4 * hi;
#pragma unroll
    for (int d = 0; d < 4; ++d)
#pragma unroll
        for (int g = 0; g < 4; ++g) {
            const u32x2 w = {pk2(o[d][4 * g] * inv, o[d][4 * g + 1] * inv), pk2(o[d][4 * g + 2] * inv, o[d][4 * g + 3] * inv)};
            *(u32x2*)(op + 32 * d + 8 * g) = w;
        }
}
constexpr int CW_QUEUE = 4096;
constexpr int QWORD_OFF = MOE_LDS_OFF + 2048;
constexpr int KCONV = 10;
DI int q_pop(unsigned* head, LAS unsigned char* lds) {
    __syncthreads();
    if (threadIdx.x == 0) *(LAS unsigned*)(lds + QWORD_OFF) = atomicAdd(head, 1u);
    __syncthreads();
    return __builtin_amdgcn_readfirstlane((int)*(LAS unsigned*)(lds + QWORD_OFF));
}
DI void phase_attn_hgrn(const Params& p, LAS unsigned char* lds, int l) {
    unsigned char* ws = ows(p);
    const bf16_t* Q = (const bf16_t*)(ws + WS_Q); const bf16_t* KN = (const bf16_t*)(ws + WS_KN); const bf16_t* KR = (const bf16_t*)(ws + WS_KR); const bf16_t* VT = (const bf16_t*)(ws + WS_VT);
    const bf16_t* HB = (const bf16_t*)(ws + WS_HB);
    bf16_t* CAT = (bf16_t*)(ws + WS_CAT);
    unsigned* qa = (unsigned*)(ws + WS_CTL) + CW_QUEUE + (l * 3 + 0) * 8 * 16; unsigned* qc = qa + 8 * 16; unsigned* qr = qc + 8 * 16;
    const float* hng = pinT<false>(p, ws, I_HNORM) + l * 512;
    const int x0 = (int)(__builtin_amdgcn_s_getreg((3 << 11) | 20) & 7u);
    const bool has_conv = l + 1 < DEPTH;
    bool conv_first = false;
    if (has_conv) conv_first = q_pop(qr + x0 * 16, lds) < KCONV;
    for (int pass = 0; pass < 2; ++pass) {
        const bool do_conv = (pass == 0) == conv_first;
        if (do_conv && !has_conv) continue;
        for (int dx = 0; dx < 8; ++dx) {
            const int x = (x0 + dx) & 7;
            if (do_conv) {
                const int ncv = (N_CONV_UNITS - x + 7) / 8;
                for (;;) { const int idx = q_pop(qc + x * 16, lds); if (idx >= ncv) break; conv_unit(p, lds, l + 1, x + 8 * idx); }
            } else {
                for (;;) {
                    const int idx = q_pop(qa + x * 16, lds); if (idx >= 66) break;
                    if (idx < 2) { const int bh = 2 * x + idx; hgrn_seq_unit(HB, (const float*)(ws + WS_OH), (const float*)(ws + WS_HU), (const bf16_t*)(ws + WS_HQG), (const float*)(ws + WS_HDL), hng, CAT, lds, bh >> 2, bh & 3); }
                    else { const int j = idx - 2, bh = 4 * x + (j & 3), qb = 15 - (j >> 2); attn_unit(Q, KN, KR, VT, CAT, lds, bh >> 3, bh & 7, qb); }
                }
            }
        }
    }
}

struct EpiOut {
    static constexpr bool PERM = false;
    const float* xres; const bf16_t* xb; float* Y;
    DI void operator()(const f32x4 (&acc)[2][2][4][2], const g8::Unit& u, int wr, int wc, int fr, int fq) const {
        const int row0 = u.pm * 256 + wr * 64 + fr, col0 = u.pn * 256 + wc * 32 + 4 * fq;
#pragma unroll
        for (int ai = 0; ai < 2; ++ai)
#pragma unroll
            for (int m = 0; m < 4; ++m) {
                const size_t rb = (size_t)(row0 + ai * 128 + m * 16) * DM;
#pragma unroll
                for (int bj = 0; bj < 2; ++bj)
#pragma unroll
                    for (int n = 0; n < 2; ++n) { const int col = col0 + bj * 128 + 16 * n; f32x4 x;
                        if (xres) x = *(const f32x4*)(xres + rb + col); else { const u32x2 r = *(const u32x2*)(xb + rb + col); x = (f32x4){bflo(r.x), bfhi(r.x), bflo(r.y), bfhi(r.y)}; }
                        *(f32x4*)(Y + rb + col) = x * ALPHA + acc[ai][bj][m][n]; }
            }
    }
};
DI void phase_outproj(const Params& p, LAS unsigned char* lds, int bid, int G, int l) {
    unsigned char* ws = ows(p);
    g8::StaticSched S; S.init(ws + WS_CAT, (const bf16_t*)(ws + WS_WOUT) + (size_t)l * DM * DM, NT, DM, DM, DM, G, bid);
    EpiOut E{l == 0 ? pinT<false>(p, ws, I_X) : nullptr, (const bf16_t*)(ws + WS_XB), (float*)(ws + WS_Y)};
    g8::gemm_phase<EpiOut, g8::StaticSched, false>(lds, DM, DM, DM, S, E);
}

constexpr int L1_RS = 8208;
constexpr int L1_PART = 16 * L1_RS, L1_STAT = L1_PART + 8 * 16 * 48 * 4, L1_LG = L1_STAT + 128;
static_assert(L1_LG + 16 * 48 * 4 <= MOE_LDS_OFF, "ln1 LDS map");
DI void phase_ln1_router(const Params& p, LAS unsigned char* lds, int bid, int G, int l) {
    unsigned char* ws = ows(p);
    const int tid = otid(), lane = tid & 63, wave = __builtin_amdgcn_readfirstlane(tid >> 6), fr = lane & 15, fq = lane >> 4;
    float* Y = (float*)(ws + WS_Y); bf16_t* X1B = (bf16_t*)(ws + WS_X1B);
    const float* RW = (const float*)(ws + WS_ROUTW) + (size_t)l * 48 * DM; const float* rc0 = (const float*)(ws + WS_ROUTC) + (l * 2 + 0) * 48; const float* rc1 = rc0 + 48;
    unsigned* cnt = (unsigned*)(ws + WS_CTL) + CW_CNT + l * 32 * 16;
    int* TOK = (int*)(ws + WS_TOK); int* ROUTE = (int*)(ws + WS_ROUTE);
    const f32x4 gg = *(const f32x4*)(pinT<false>(p, ws, I_LN1G) + l * DM + 4 * tid), bb = *(const f32x4*)(pinT<false>(p, ws, I_LN1B) + l * DM + 4 * tid);
    LAS float* PART = (LAS float*)(lds + L1_PART); LAS float* STAT = (LAS float*)(lds + L1_STAT); LAS float* LG = (LAS float*)(lds + L1_LG);
    for (int task = bid; task < NT / 16; task += G) {
        const int r0 = task * 16;
        f32x4 xr[16], wbuf[8][3];
        const float* wp = RW + (size_t)fr * DM + 256 * wave + 4 * fq;
        asm volatile("" : "+v"(wp));
#pragma unroll
        for (int s2 = 0; s2 < 8; ++s2)
#pragma unroll
            for (int n = 0; n < 3; ++n) wbuf[s2][n] = *(const f32x4*)(wp + (size_t)(16 * n) * DM + 16 * s2);
#pragma unroll
        for (int i = 0; i < 16; ++i) xr[i] = *(const f32x4*)(Y + (size_t)(r0 + i) * DM + 4 * tid);
        __syncthreads();
#pragma unroll
        for (int i = 0; i < 16; ++i) *(LAS f32x4*)(lds + i * L1_RS + tid * 16) = xr[i];
        __syncthreads();
#pragma unroll
        for (int rr = 0; rr < 2; ++rr) {
            const int row = 2 * wave + rr; float sm = 0.f, sq = 0.f;
#pragma unroll
            for (int j = 0; j < 8; ++j) { const f32x4 v = *(const LAS f32x4*)(lds + row * L1_RS + (4 * lane + 256 * j) * 4); sm += (v.x + v.y) + (v.z + v.w); sq += (v.x * v.x + v.y * v.y) + (v.z * v.z + v.w * v.w); }
            sm = wave_sum(sm); sq = wave_sum(sq);
            const float mean = sm * (1.0f / DM), var = fmaxf(sq * (1.0f / DM) - mean * mean, 0.f);
            if (lane == 0) { STAT[2 * row] = mean; STAT[2 * row + 1] = rsq_(var + EPS); }
        }
        f32x4 acc[3];
#pragma unroll
        for (int n = 0; n < 3; ++n) acc[n] = (f32x4){0.f, 0.f, 0.f, 0.f};
        const LAS unsigned char* ap = lds + fr * L1_RS + (256 * wave + 4 * fq) * 4;
#pragma unroll
        for (int hf = 0; hf < 2; ++hf) {
            if (hf == 1) {
#pragma unroll
                for (int s2 = 0; s2 < 8; ++s2)
#pragma unroll
                    for (int n = 0; n < 3; ++n) wbuf[s2][n] = *(const f32x4*)(wp + (size_t)(16 * n) * DM + 16 * (8 + s2));
            }
#pragma unroll
            for (int s2 = 0; s2 < 8; ++s2) {
                const f32x4 xa = *(const LAS f32x4*)(ap + 64 * (8 * hf + s2));
#pragma unroll
                for (int n = 0; n < 3; ++n)
#pragma unroll
                    for (int i = 0; i < 4; ++i) acc[n] = __builtin_amdgcn_mfma_f32_16x16x4f32(xa[i], wbuf[s2][n][i], acc[n], 0, 0, 0);
            }
        }
#pragma unroll
        for (int n = 0; n < 3; ++n)
#pragma unroll
            for (int i = 0; i < 4; ++i) PART[(wave * 16 + 4 * fq + i) * 48 + 16 * n + fr] = acc[n][i];
        __syncthreads();
#pragma unroll
        for (int rep = 0; rep < 2; ++rep) {
            const int pp = tid + 512 * rep;
            if (pp < 768) { const int row = pp / 48, col = pp % 48; float sacc = 0.f;
#pragma unroll
                for (int w = 0; w < 8; ++w) sacc += PART[(w * 16 + row) * 48 + col];
                LG[pp] = STAT[2 * row + 1] * (sacc - STAT[2 * row] * rc1[col]) + rc0[col]; }
        }
        __syncthreads();
        if (tid < 16) {
            const LAS float* L = LG + tid * 48; const int token = r0 + tid;
            float gm = L[0]; int gi = 0;
#pragma unroll
            for (int j = 1; j < 4; ++j) if (L[j] > gm) { gm = L[j]; gi = j; }
            float gs = 0.f;
#pragma unroll
            for (int j = 0; j < 4; ++j) gs += expf(L[j] - gm);
            const float gval = 1.0f / gs;
            const LAS float* E = L + 4 + gi * 8;
            float v1 = E[0]; int i1 = 0;
#pragma unroll
            for (int j = 1; j < 8; ++j) if (E[j] > v1) { v1 = E[j]; i1 = j; }
            float v2 = -3.0e38f; int i2 = 0;
#pragma unroll
            for (int j = 0; j < 8; ++j) if (j != i1 && E[j] > v2) { v2 = E[j]; i2 = j; }
            const float ex = expf(v2 - v1), p1 = 1.0f / (1.0f + ex), p2 = ex / (1.0f + ex);
            const int e0 = gi * 8 + i1, e1 = gi * 8 + i2;
            const int pos0 = (int)atomicAdd(cnt + e0 * 16, 1u), pos1 = (int)atomicAdd(cnt + e1 * 16, 1u);
            TOK[(size_t)e0 * NT + pos0] = token; TOK[(size_t)e1 * NT + pos1] = token;
            int* rp = ROUTE + (size_t)token * 8;
            rp[0] = e0; rp[1] = pos0; rp[2] = e1; rp[3] = pos1; rp[4] = __float_as_int(gval * p1); rp[5] = __float_as_int(gval * p2);
        }
#pragma unroll
        for (int i = 0; i < 16; ++i) {
            const float mean = STAT[2 * i], rstd = STAT[2 * i + 1];
            const f32x4 xv = *(const LAS f32x4*)(lds + i * L1_RS + tid * 16);
            const f32x4 y = (xv - mean) * rstd * gg + bb;
            *(u32x2*)(X1B + (size_t)(r0 + i) * DM + 4 * tid) = (u32x2){pk2(y.x, y.y), pk2(y.z, y.w)};
        }
    }
}

DI void moe_tables(const Params& p, LAS unsigned char* lds, int l) {
    LAS int* mc = (LAS int*)(lds + MOE_LDS_OFF); LAS int* mp = mc + 32;
    __syncthreads();
    if (threadIdx.x == 0) {
        const unsigned* cnt = (const unsigned*)(ows(p) + WS_CTL) + CW_CNT + l * 32 * 16; int acc = 0;
        for (int e = 0; e < 32; ++e) { int c = (int)__hip_atomic_load(cnt + e * 16, __ATOMIC_RELAXED, __HIP_MEMORY_SCOPE_AGENT); if (c > NT) c = NT; mc[e] = c; mp[e] = acc; acc += (c + 255) >> 8; }
        mp[32] = acc;
    }
    __syncthreads();
}
template <int NCT_SHIFT> struct MoeSched {
    const char* A; const char* Bt; const int* TOK; LAS const int* mc; LAS const int* mp; size_t bexp, btile, atile; int G, c;
    DI bool next(int i, g8::Unit& u) const {
        int rt, ct, e = 0;
        if (G == 256) {
            const int x = c & 7, slot = c >> 3, t0 = mp[4 * x], nt = mp[4 * x + 4] - t0, L = i * 32 + slot;
            if (L >= (nt << NCT_SHIFT)) return false;
            rt = t0 + (L >> NCT_SHIFT); ct = L & ((1 << NCT_SHIFT) - 1);
            e = 4 * x;
            for (int j = 4 * x + 1; j < 4 * x + 4; ++j) if (mp[j] <= rt) e = j;
        } else {
            const int L = i * G + c, T = mp[32]; if (L >= (T << NCT_SHIFT)) return false;
            rt = L >> NCT_SHIFT; ct = L & ((1 << NCT_SHIFT) - 1);
            for (int j = 1; j < 32; ++j) if (mp[j] <= rt) e = j;
        }
        u.pm = rt; u.pn = ct; u.x0 = e; u.x1 = rt - mp[e];
        u.a = A + (size_t)rt * atile; u.b = Bt + (size_t)e * bexp + (size_t)ct * btile; return true;
    }
    DI int tok(const g8::Unit& u, int R) const { const int idx = u.x1 * 256 + R; return idx < mc[u.x0] ? TOK[(size_t)u.x0 * NT + idx] : 0; }
};
struct EpiMoe1 {
    static constexpr bool PERM = true;
    bf16_t* HM;
    DI void operator()(const f32x4 (&acc)[2][2][4][2], const g8::Unit& u, int wr, int wc, int fr, int fq) const {
        const int row0 = u.pm * 256 + wr * 64 + fr, col0 = u.pn * 128 + wc * 32 + 8 * fq;
#pragma unroll
        for (int ai = 0; ai < 2; ++ai)
#pragma unroll
            for (int m = 0; m < 4; ++m) {
                float v[8];
#pragma unroll
                for (int i = 0; i < 4; ++i) { v[i] = siluf_(acc[ai][0][m][0][i]) * acc[ai][1][m][0][i]; v[4 + i] = siluf_(acc[ai][0][m][1][i]) * acc[ai][1][m][1][i]; }
                u32x4 w; w.x = pk2(v[0], v[1]); w.y = pk2(v[2], v[3]); w.z = pk2(v[4], v[5]); w.w = pk2(v[6], v[7]);
                *(u32x4*)(HM + (size_t)(row0 + ai * 128 + m * 16) * DEXP + col0) = w;
            }
    }
};
struct EpiMoe2 {
    static constexpr bool PERM = true;
    bf16_t* YB;
    DI void operator()(const f32x4 (&acc)[2][2][4][2], const g8::Unit& u, int wr, int wc, int fr, int fq) const {
        const int row0 = u.pm * 256 + wr * 64 + fr, col0 = u.pn * 256 + wc * 32 + 8 * fq;
#pragma unroll
        for (int ai = 0; ai < 2; ++ai)
#pragma unroll
            for (int m = 0; m < 4; ++m)
#pragma unroll
                for (int bj = 0; bj < 2; ++bj) {
                    const f32x4 v0 = acc[ai][bj][m][0], v1 = acc[ai][bj][m][1];
                    u32x4 w; w.x = pk2(v0[0], v0[1]); w.y = pk2(v0[2], v0[3]); w.z = pk2(v1[0], v1[1]); w.w = pk2(v1[2], v1[3]);
                    *(u32x4*)(YB + (size_t)(row0 + ai * 128 + m * 16) * DM + col0 + bj * 128) = w;
                }
    }
};
DI void phase_moe1(const Params& p, LAS unsigned char* lds, int bid, int G, int l) {
    unsigned char* ws = ows(p);
    moe_tables(p, lds, l);
    MoeSched<2> S{(const char*)(ws + WS_X1B), (const char*)(ws + WS_WGU) + (size_t)l * NEXP * 1024 * DM * 2, (const int*)(ws + WS_TOK), (LAS const int*)(lds + MOE_LDS_OFF), (LAS const int*)(lds + MOE_LDS_OFF) + 32,
                  (size_t)1024 * DM * 2, (size_t)256 * DM * 2, 0, G, bid};
    EpiMoe1 E{(bf16_t*)(ws + WS_HM)};
    g8::gemm_phase<EpiMoe1, MoeSched<2>, true>(lds, DM, DM, DM, S, E);
}
DI void phase_moe2(const Params& p, LAS unsigned char* lds, int bid, int G, int l) {
    unsigned char* ws = ows(p);
    moe_tables(p, lds, l);
    MoeSched<3> S{(const char*)(ws + WS_HM), (const char*)(ws + WS_WD) + (size_t)l * NEXP * DM * DEXP * 2, nullptr, (LAS const int*)(lds + MOE_LDS_OFF), (LAS const int*)(lds + MOE_LDS_OFF) + 32,
                  (size_t)DM * DEXP * 2, (size_t)256 * DEXP * 2, (size_t)256 * DEXP * 2, G, bid};
    EpiMoe2 E{(bf16_t*)(ws + WS_YB)};
    g8::gemm_phase<EpiMoe2, MoeSched<3>, false>(lds, DEXP, DEXP, DEXP, S, E);
}

DI void phase_ln2(const Params& p, LAS unsigned char* lds, int bid, int G, int l) {
    unsigned char* ws = ows(p);
    moe_tables(p, lds, l);
    LAS const int* mp = (LAS const int*)(lds + MOE_LDS_OFF) + 32;
    const int tid = otid(), lane = tid & 63, wave = tid >> 6;
    const bf16_t* X1B = (const bf16_t*)(ws + WS_X1B); const bf16_t* YB = (const bf16_t*)(ws + WS_YB); const int* ROUTE = (const int*)(ws + WS_ROUTE);
    const float* g = pinT<false>(p, ws, I_LN2G) + l * DM; const float* bt = pinT<false>(p, ws, I_LN2B) + l * DM;
    float* out = p.out; bf16_t* XB = (bf16_t*)(ws + WS_XB);
    for (int row = bid * 8 + wave; row < NT; row += G * 8) {
        const int* rp = ROUTE + (size_t)row * 8;
        const int e0 = rp[0], pos0 = rp[1], e1 = rp[2], pos1 = rp[3]; const float g0 = __int_as_float(rp[4]), g1 = __int_as_float(rp[5]);
        const size_t s0 = (size_t)(256 * mp[e0] + pos0), s1 = (size_t)(256 * mp[e1] + pos1);
        f32x4 v[8]; float sm = 0.f;
#pragma unroll
        for (int j = 0; j < 8; ++j) {
            const int col = 4 * lane + 256 * j;
            const u32x2 xr_ = *(const u32x2*)(X1B + (size_t)row * DM + col); const f32x4 x = {bflo(xr_.x), bfhi(xr_.x), bflo(xr_.y), bfhi(xr_.y)};
            const u32x2 a = *(const u32x2*)(YB + s0 * DM + col), b = *(const u32x2*)(YB + s1 * DM + col);
            const f32x4 ya = {bflo(a.x), bfhi(a.x), bflo(a.y), bfhi(a.y)}, yb = {bflo(b.x), bfhi(b.x), bflo(b.y), bfhi(b.y)};
            v[j] = x * ALPHA + (ya * g0 + yb * g1);
            sm += (v[j].x + v[j].y) + (v[j].z + v[j].w);
        }
        const float mean = wave_sum(sm) * (1.0f / DM); float sq = 0.f;
#pragma unroll
        for (int j = 0; j < 8; ++j) { v[j] = v[j] - mean; sq += (v[j].x * v[j].x + v[j].y * v[j].y) + (v[j].z * v[j].z + v[j].w * v[j].w); }
        const float rstd = rsq_(wave_sum(sq) * (1.0f / DM) + EPS);
#pragma unroll
        for (int j = 0; j < 8; ++j) {
            const int col = 4 * lane + 256 * j;
            const f32x4 y = v[j] * rstd * *(const f32x4*)(g + col) + *(const f32x4*)(bt + col);
            if (l == DEPTH - 1) *(f32x4*)(out + (size_t)row * DM + col) = y;
            else *(u32x2*)(XB + (size_t)row * DM + col) = (u32x2){pk2(y.x, y.y), pk2(y.z, y.w)};
        }
    }
}


#define GAS __attribute__((address_space(1)))
typedef GAS unsigned gu32;
#define XB_TMO      128
#define XB_XCNT(j)  (256  + 64 * (j))
#define XB_XSUB(j)  (1280 + 64 * (j))
#define XB_XGEN(j)  (2304 + 64 * (j))
#define XB_TOP      3328
#define XB_TOPGEN   3392
#define XCD_BAR_WORDS 3456
#define XB_SPIN_CAP (1u << 18)

__device__ __forceinline__ unsigned xb_ld(unsigned* p)              { return __hip_atomic_load(p, __ATOMIC_RELAXED, __HIP_MEMORY_SCOPE_AGENT); }
__device__ __forceinline__ unsigned xb_add(unsigned* p, unsigned v) { return __hip_atomic_fetch_add(p, v, __ATOMIC_RELAXED, __HIP_MEMORY_SCOPE_AGENT); }
__device__ __forceinline__ unsigned xb_xcc_id() { return (unsigned)__builtin_amdgcn_s_getreg((3 << 11) | 20) & 0xFu; }
#define XB_SPIN(cond, bar) do { unsigned _sp = 0; while (cond) { __builtin_amdgcn_s_sleep(1); \
    if ((++_sp & 255u) == 0u) { if (xb_ld(&(bar)[XB_TMO])) break; if (_sp > XB_SPIN_CAP) { atomicAdd(&(bar)[XB_TMO], 1u); break; } } } } while (0)

struct XcdBarrier {
    unsigned* bar; unsigned x;
    volatile LAS unsigned* st;
};

__device__ __forceinline__ XcdBarrier xcd_barrier_post(unsigned* bar, volatile LAS unsigned* st) {
    XcdBarrier b; b.bar = bar; b.x = xb_xcc_id(); b.st = st;
    if (threadIdx.x == 0) (void)xb_add(&bar[XB_XCNT(b.x)], 1u);
    return b;
}
__device__ __forceinline__ void xcd_barrier_complete(unsigned* bar, unsigned x, unsigned& nloc, unsigned& nx) {
    const unsigned G = gridDim.x * gridDim.y * gridDim.z;
    unsigned sum, cnt, mine, sp = 0u;
    for (;;) {
        sum = 0u; cnt = 0u; mine = 0u;
#pragma unroll
        for (unsigned j = 0; j < 16; ++j) { const unsigned c = xb_ld(&bar[XB_XCNT(j)]); sum += c; cnt += (c > 0u) ? 1u : 0u; mine = (j == x) ? c : mine; }
        if (sum == G) break;
        __builtin_amdgcn_s_sleep(1);
        if ((++sp & 255u) == 0u) { if (xb_ld(&bar[XB_TMO])) break; if (sp > XB_SPIN_CAP) { atomicAdd(&bar[XB_TMO], 1u); break; } }
    }
    nloc = mine > 0u ? mine : 1u; nx = cnt > 0u ? cnt : 1u;
}

__device__ __forceinline__ void xcd_barrier(const XcdBarrier& b) {
    __attribute__((address_space(1))) unsigned* barp = (__attribute__((address_space(1))) unsigned*)b.bar; asm volatile("" : "+s"(barp));
    asm volatile("s_waitcnt vmcnt(0)" ::: "memory");
    __syncthreads();
    if (threadIdx.x == 0) {
        unsigned* bar = (unsigned*)barp;
        __builtin_amdgcn_s_waitcnt(0);
        unsigned nloc = b.st[0], nx = b.st[1];
        if (nloc == 0u) { xcd_barrier_complete(bar, xb_xcc_id(), nloc, nx); b.st[0] = nloc; b.st[1] = nx; }
        const unsigned bx = xb_xcc_id();
        const unsigned old = xb_add(&bar[XB_XSUB(bx)], 1u);
        const unsigned gen = old / nloc;
        if (old + 1u == (gen + 1u) * nloc) {
            __builtin_amdgcn_fence(__ATOMIC_RELEASE, "agent");
            asm volatile("s_waitcnt vmcnt(0)" ::: "memory");
            const unsigned og = xb_add(&bar[XB_TOP], 1u);
            const unsigned tg = og / nx;
            if (og + 1u == (tg + 1u) * nx) xb_add(&bar[XB_TOPGEN], 1u);
            else XB_SPIN(xb_ld(&bar[XB_TOPGEN]) == tg, bar);
            __builtin_amdgcn_fence(__ATOMIC_ACQUIRE, "agent");
            xb_add(&bar[XB_XGEN(bx)], 1u);
            asm volatile("s_waitcnt vmcnt(0)" ::: "memory");
        } else {
            XB_SPIN(xb_ld(&bar[XB_XGEN(bx)]) == gen, bar);
            __builtin_amdgcn_fence(__ATOMIC_ACQUIRE, "agent");
            asm volatile("s_waitcnt vmcnt(0)" ::: "memory");
        }
    }
    __syncthreads();
}


constexpr int BARST_OFF = MOE_LDS_OFF + 1024;
#ifndef REP_KS
#define REP_KS 1
#endif
#ifndef REP_LN2
#define REP_LN2 1
#endif
#ifndef REP_INP
#define REP_INP 1
#endif
#ifndef REP_MOE1
#define REP_MOE1 1
#endif
__global__ void __launch_bounds__(NTHR, 2) mega_fwd(Params p) {
    extern __shared__ __attribute__((aligned(16))) unsigned char lds_[];
    LAS unsigned char* lds = (LAS unsigned char*)lds_;
    const int bid0 = blockIdx.x, G0 = gridDim.x;
    if (threadIdx.x == 0) *(LAS u32x4*)(lds + BARST_OFF) = (u32x4){0u, 0u, 0u, 0u};
    __syncthreads();
    XcdBarrier bar = xcd_barrier_post((unsigned*)(p.ws + WS_CTL) + CW_BAR, (volatile LAS unsigned*)(lds + BARST_OFF));
#define OPQ() do { bid = bid0; G = G0; asm volatile("" : "+s"(bid), "+s"(G)); } while (0)
    int bid, G; OPQ();
    phase_prologue(p, lds, bid, G);
    xcd_barrier(bar);
    for (int l = 0; l < DEPTH; ++l) {
        for (int r_ = 0; r_ < REP_INP; ++r_) { OPQ(); phase_inproj(p, lds, bid, G, l); }
        xcd_barrier(bar);
        for (int r_ = 0; r_ < REP_KS; ++r_) { OPQ(); phase_krope(p, lds, bid, G, l);
        OPQ(); phase_sgu(p, lds, bid, G, l);
        OPQ(); phase_hgrn_local(p, lds, bid, G, l); }
        __syncthreads();
        OPQ(); phase_mla_proj(p, lds, bid, G, l);
        xcd_barrier(bar);
        OPQ(); phase_attn_hgrn(p, lds, l);
        xcd_barrier(bar);
        OPQ(); phase_outproj(p, lds, bid, G, l);
        xcd_barrier(bar);
        OPQ(); phase_ln1_router(p, lds, bid, G, l);
        xcd_barrier(bar);
        for (int r_ = 0; r_ < REP_MOE1; ++r_) { OPQ(); phase_moe1(p, lds, bid, G, l); }
        xcd_barrier(bar);
        OPQ(); phase_moe2(p, lds, bid, G, l);
        xcd_barrier(bar);
        for (int r_ = 0; r_ < REP_LN2; ++r_) { OPQ(); phase_ln2(p, lds, bid, G, l); }
        xcd_barrier(bar);
    }
#undef OPQ
}

extern "C" void kernel_launch(void* const* d_in, const int* in_sizes, int n_in, void* d_out, int out_size, void* d_ws, size_t ws_size, hipStream_t stream) {
    static int grid = 0;
    if (grid == 0) {
        if (n_in != 25 || out_size != NT * DM || ws_size < WS_END) { fprintf(stderr, "kernel_launch: unexpected sizes n_in %d out %d ws %zu (need %zu)\n", n_in, out_size, ws_size, (size_t)WS_END); grid = -1; return; }
        int dev = 0, cus = 0, per_cu = 0;
        if (hipGetDevice(&dev) != hipSuccess || hipDeviceGetAttribute(&cus, hipDeviceAttributeMultiprocessorCount, dev) != hipSuccess) { grid = -1; return; }
        if (hipFuncSetAttribute((const void*)mega_fwd, hipFuncAttributeMaxDynamicSharedMemorySize, LDS_BYTES) != hipSuccess) { fprintf(stderr, "kernel_launch: hipFuncSetAttribute failed\n"); grid = -1; return; }
        if (hipOccupancyMaxActiveBlocksPerMultiprocessor(&per_cu, (const void*)mega_fwd, NTHR, LDS_BYTES) != hipSuccess || per_cu < 1) { fprintf(stderr, "kernel_launch: occupancy query says %d blocks per CU\n", per_cu); (void)hipGetLastError(); grid = -1; return; }
        grid = cus;
    }
    if (grid < 0) return;
    (void)hipMemsetAsync((char*)d_ws + WS_CTL, 0, CTL_BYTES, stream);
    Params p{};
    for (int i = 0; i < 25; ++i) p.in[i] = (const float*)d_in[i];
    p.out = (float*)d_out; p.ws = (unsigned char*)d_ws; p.layer = 0; p.pad = 0;
    hipLaunchKernelGGL(mega_fwd, dim3(grid), dim3(NTHR), LDS_BYTES, stream, p);
}
```

```cpp
#include <hip/hip_runtime.h>
#include <cstdio>
#include <cstdint>

#define DI __device__ __forceinline__
#define LAS __attribute__((address_space(3)))
typedef unsigned short bf16_t;
typedef short bf16x8 __attribute__((ext_vector_type(8)));
typedef short s16x4 __attribute__((ext_vector_type(4)));
typedef float f32x2 __attribute__((ext_vector_type(2)));
typedef float f32x4 __attribute__((ext_vector_type(4)));
typedef float f32x16 __attribute__((ext_vector_type(16)));
typedef unsigned u32x2 __attribute__((ext_vector_type(2)));
typedef unsigned u32x4 __attribute__((ext_vector_type(4)));
typedef __bf16 bf2_t __attribute__((ext_vector_type(2)));

constexpr int DM = 2048, BATCH = 4, SEQ = 4096, NT = BATCH * SEQ, DEPTH = 4;
constexpr int DIN = 4160, DIN_MAIN = 4096;
constexpr int NEXP = 32, DEXP = 512;
constexpr int MAXSLOT = 40960;
constexpr float ALPHA = 1.681792830507429f;
constexpr float EPS = 1e-5f;
constexpr float QSCALE = 0.07216878364870323f * 1.4426950408889634f;

constexpr size_t MiB = 1u << 20;
constexpr size_t al(size_t x) { return (x + MiB - 1) / MiB * MiB; }
constexpr size_t WS_CTL = 0, CTL_BYTES = 1 * MiB;
constexpr size_t WS_WIN = WS_CTL + CTL_BYTES;
constexpr size_t WS_WUQ = WS_WIN + al((size_t)DEPTH * DIN * DM * 2);
constexpr size_t WS_WUK = WS_WUQ + al((size_t)DEPTH * 1536 * 512 * 2);
constexpr size_t WS_WUV = WS_WUK + al((size_t)DEPTH * 1024 * 512 * 2);
constexpr size_t WS_WOUT = WS_WUV + al((size_t)DEPTH * 1024 * 512 * 2);
constexpr size_t WS_WGU = WS_WOUT + al((size_t)DEPTH * DM * DM * 2);
constexpr size_t WS_WD = WS_WGU + al((size_t)DEPTH * NEXP * 1024 * DM * 2);
constexpr size_t WS_SGUW = WS_WD + al((size_t)DEPTH * NEXP * DM * DEXP * 2);
constexpr size_t WS_ROUTW = WS_SGUW + al((size_t)DEPTH * 4 * 128 * 128 * 2);
constexpr size_t WS_ROUTC = WS_ROUTW + al((size_t)DEPTH * 48 * DM * 4);
constexpr size_t WS_LB = WS_ROUTC + MiB;
constexpr size_t WS_COS = WS_LB + MiB;
constexpr size_t WS_XB = WS_COS + al((size_t)NT * 64 * 4);
constexpr size_t WS_Y = WS_XB + al((size_t)NT * DM * 2);
constexpr size_t WS_X1B = WS_Y + al((size_t)NT * DM * 4);
constexpr size_t WS_HB = WS_X1B + al((size_t)NT * DM * 2);
constexpr size_t WS_LOGF = WS_HB + al((size_t)NT * 4096 * 2);
constexpr size_t WS_KR = WS_LOGF + al((size_t)NT * 512 * 4);
constexpr size_t WS_SSQ = WS_KR + al((size_t)NT * 64 * 2);
constexpr size_t WS_Q = WS_SSQ + al((size_t)NT * 16 * 4);
constexpr size_t WS_KN = WS_Q + al((size_t)NT * 1536 * 2);
constexpr size_t WS_VT = WS_KN + al((size_t)NT * 1024 * 2);
constexpr size_t WS_OH = WS_VT + al((size_t)NT * 1024 * 2);
constexpr size_t WS_CAT = WS_OH + al((size_t)NT * 512 * 4);
constexpr size_t WS_ROUTE = WS_CAT + al((size_t)NT * DM * 2);
constexpr size_t WS_TOK = WS_ROUTE + al((size_t)NT * 8 * 4);
constexpr size_t WS_HM = WS_TOK + al((size_t)NEXP * NT * 4);
constexpr size_t WS_YB = WS_HM + al((size_t)MAXSLOT * DEXP * 2);
constexpr size_t WS_HU = WS_YB + al((size_t)MAXSLOT * DM * 2);
constexpr size_t WS_HQG = WS_HU + al((size_t)1024 * 65536);
constexpr size_t WS_HDL = WS_HQG + al((size_t)1024 * 16384);
constexpr size_t WS_END = WS_HDL + al((size_t)1024 * 512);

constexpr int CW_TMO = 0;
constexpr int CW_CNT = 1024;
constexpr int CW_BAR = 8192;

constexpr int MOE_LDS_OFF = 159744;
constexpr int LDS_BYTES = 163840;
constexpr int NTHR = 512;

DI unsigned pk2(float lo, float hi) { bf2_t b = __builtin_convertvector((f32x2){lo, hi}, bf2_t); return __builtin_bit_cast(unsigned, b); }
DI bf16_t f2bf(float f) { return (bf16_t)(pk2(f, 0.f) & 0xffffu); }
DI float bflo(unsigned u) { return __uint_as_float(u << 16); }
DI float bfhi(unsigned u) { return __uint_as_float(u & 0xffff0000u); }
DI float bf2f(bf16_t h) { return __uint_as_float((unsigned)h << 16); }
DI float wave_sum(float v) {
#pragma unroll
    for (int o = 1; o < 64; o <<= 1) v += __shfl_xor(v, o);
    return v;
}
DI int otid() { int t = (int)threadIdx.x; asm volatile("" : "+v"(t)); return t; }
DI float rcp_(float x) { return __builtin_amdgcn_rcpf(x); }
DI float rsq_(float x) { return __builtin_amdgcn_rsqf(x); }
DI float sigmoidf_(float x) { return rcp_(1.0f + __expf(-x)); }
DI float siluf_(float x) { return x * rcp_(1.0f + __expf(-x)); }
DI float geluf_(float x) { const float u = 1.5957691216057308f * (x + 0.044715f * x * x * x); return x * rcp_(1.0f + __expf(-u)); }

struct Params {
    const float* in[25];
    float* out;
    unsigned char* ws;
    int layer;
    int pad;
};
constexpr size_t PTR_TAB_BYTES = 65536;
template <bool DIRECT> DI const float* pinT(const Params& p, unsigned char* ws, int i) {
    if constexpr (DIRECT) return p.in[i];
    else return (const float*)(const __attribute__((address_space(1))) float*)(((const unsigned long long*)(ws + WS_CTL + PTR_TAB_BYTES))[i]);
}
DI unsigned char* ows(const Params& p) { __attribute__((address_space(1))) unsigned char* w = (__attribute__((address_space(1))) unsigned char*)p.ws; asm volatile("" : "+s"(w)); return (unsigned char*)w; }

namespace g8 {
constexpr int BM = 256, BK = 64, HALF = 128, HTB = HALF * BK * 2, STAGE_BYTES = 8 * HTB, NXCD = 8, WGM = 8;
DI int lds_byte(int r, int c) { const int st = (r >> 4) * 2 + (c >> 5), rr = r & 15, cc = c & 31, ob = rr * 64 + cc * 2; return st * 1024 + (ob ^ (((ob >> 9) & 1) << 5)); }
DI void stage_rc(int b, int& R, int& C) { const int st = b / 1024, sb = b % 1024, swz = sb ^ (((sb >> 9) & 1) << 5); R = (st >> 1) * 16 + swz / 64; C = (st & 1) * 32 + (swz % 64) / 2; }
DI int perm32(int rho) { const int n = rho >> 4, i = rho & 15; return 8 * (i >> 2) + 4 * n + (i & 3); }

struct Unit { const char* a; const char* b; int pm, pn, x0, x1; };

struct StaticSched {
    const char* A; const char* Bt; int lda, ldb, nM, nN, nwg, G, c;
    DI void init(const void* A_, const void* Bt_, int M, int N, int lda_, int ldb_, int G_, int c_) { A = (const char*)A_; Bt = (const char*)Bt_; lda = lda_; ldb = ldb_; nM = M / BM; nN = N / BM; nwg = nM * nN; G = G_; c = c_; }
    DI bool next(int i, Unit& u) const {
        const long L = (long)i * G + c; if (L >= nwg) return false;
        int wgid = (int)L; { const int q = nwg / NXCD, r = nwg % NXCD, xcd = wgid % NXCD, off = wgid / NXCD; wgid = (xcd < r ? xcd * (q + 1) : r * (q + 1) + (xcd - r) * q) + off; }
        const int nig = WGM * nN, gid = wgid / nig, fm = gid * WGM, gsz = (nM - fm) < WGM ? (nM - fm) : WGM;
        u.pm = fm + ((wgid % nig) % gsz); u.pn = (wgid % nig) / gsz; u.x0 = 0; u.x1 = 0;
        u.a = A + (size_t)u.pm * BM * lda * 2; u.b = Bt + (size_t)u.pn * BM * ldb * 2; return true;
    }
    DI int tok(const Unit&, int) const { return 0; }
};

template <class Epi, class Sched, bool GATHER>
DI void gemm_phase(LAS unsigned char* lds, const int K, const int lda, const int ldb, const Sched& S, const Epi& E) {
    const int tid = otid(), wid = __builtin_amdgcn_readfirstlane(tid >> 6), lane = tid & 63, wr = wid >> 2, wc = wid & 3, fr = lane & 15, fq = lane >> 4;
    const int nt = K / BK;
    unsigned voffA[2], voffB[2]; int RA[2], CA[2];
#pragma unroll
    for (int i = 0; i < 2; ++i) { int R, C; stage_rc(tid * 16 + i * 8192, R, C); const int Rb = Epi::PERM ? ((R & ~31) + perm32(R & 31)) : R;
        voffA[i] = (unsigned)(R * lda + C) * 2u; voffB[i] = (unsigned)(Rb * ldb + C) * 2u; RA[i] = R; CA[i] = C; }
    const size_t kstep = (size_t)(BK * 2);
    const size_t hstepA = (size_t)HALF * lda * 2, hstep = (size_t)HALF * ldb * 2;
    const unsigned ldsw = (unsigned)wid * 1024u;
    const int aoff = lds_byte(wr * 64 + fr, fq * 8), boff = lds_byte(wc * 32 + fr, fq * 8);
    unsigned gC[2][2], gN[2][2], g2[2][2];
#define G8_SA(b, h) (((b) * 2 + (h)) * HTB)
#define G8_SB(b, h) ((4 + (b) * 2 + (h)) * HTB)
#define G8_DMA(bufoff, ptr, _i) __builtin_amdgcn_global_load_lds((const unsigned*)(ptr), (LAS unsigned*)(lds + (bufoff) + ldsw + (_i) * 8192), 16, 0, 0)
#define G8_STAGE_B(bufoff, gbase) do { _Pragma("unroll") for (int _i = 0; _i < 2; ++_i) G8_DMA(bufoff, (const char*)(gbase) + voffB[_i], _i); } while (0)
#define G8_STAGE_A(bufoff, gbase, h, GO) do { _Pragma("unroll") for (int _i = 0; _i < 2; ++_i) { \
        if constexpr (GATHER) G8_DMA(bufoff, (const char*)(gbase) + GO[h][_i], _i); else G8_DMA(bufoff, (const char*)(gbase) + (h) * hstepA + voffA[_i], _i); } } while (0)
#define G8_LDA(dst, b, h) do { _Pragma("unroll") for (int m = 0; m < 4; ++m) _Pragma("unroll") for (int k = 0; k < 2; ++k) dst[m][k] = *(const LAS bf16x8*)(lds + G8_SA(b, h) + aoff + m * 2048 + k * 1024); } while (0)
#define G8_LDB(dst, b, h) do { _Pragma("unroll") for (int n = 0; n < 2; ++n) _Pragma("unroll") for (int k = 0; k < 2; ++k) dst[n][k] = *(const LAS bf16x8*)(lds + G8_SB(b, h) + boff + n * 2048 + k * 1024); } while (0)
#define G8_MMA(ai, bj, At, Bt) do { __builtin_amdgcn_s_setprio(1); _Pragma("unroll") for (int m = 0; m < 4; ++m) _Pragma("unroll") for (int n = 0; n < 2; ++n) _Pragma("unroll") for (int k = 0; k < 2; ++k) \
        acc[ai][bj][m][n] = __builtin_amdgcn_mfma_f32_16x16x32_bf16(Bt[n][k], At[m][k], acc[ai][bj][m][n], 0, 0, 0); __builtin_amdgcn_s_setprio(0); } while (0)
#define G8_WAIT_V(n) asm volatile("s_waitcnt vmcnt(" #n ")" ::: "memory")
#define G8_WAIT_L(n) asm volatile("s_waitcnt lgkmcnt(" #n ")" ::: "memory")
#define G8_BAR __builtin_amdgcn_s_barrier()
#define G8_SCHED __builtin_amdgcn_sched_barrier(0)
#define G8_GOFF(dst, u) do { if constexpr (GATHER) { _Pragma("unroll") for (int _h = 0; _h < 2; ++_h) _Pragma("unroll") for (int _i = 0; _i < 2; ++_i) \
        dst[_h][_i] = (unsigned)(S.tok(u, _h * HALF + RA[_i]) * lda + CA[_i]) * 2u; } } while (0)
    Unit cur, nxt; int ui = 0;
    if (!S.next(0, cur)) return;
    f32x4 acc[2][2][4][2];
#pragma unroll
    for (int a = 0; a < 2; ++a)
#pragma unroll
        for (int b = 0; b < 2; ++b)
#pragma unroll
            for (int m = 0; m < 4; ++m)
#pragma unroll
                for (int n = 0; n < 2; ++n) acc[a][b][m][n] = (f32x4){0.f, 0.f, 0.f, 0.f};
    bf16x8 At[4][2], B0[2][2], B1[2][2];
    const char* cA = cur.a; const char* cB = cur.b;
#pragma unroll
    for (int h = 0; h < 2; ++h)
#pragma unroll
        for (int i = 0; i < 2; ++i) { gC[h][i] = 0u; gN[h][i] = 0u; g2[h][i] = 0u; }
    G8_GOFF(gC, cur);
    G8_STAGE_B(G8_SB(0, 0), cB); G8_STAGE_B(G8_SB(0, 1), cB + hstep); G8_STAGE_A(G8_SA(0, 0), cA, 0, gC); G8_STAGE_A(G8_SA(0, 1), cA, 1, gC);
    if (wr == 1) G8_BAR;
    G8_WAIT_V(2); G8_BAR;
    G8_STAGE_B(G8_SB(1, 0), cB + kstep); G8_STAGE_A(G8_SA(1, 0), cA + kstep, 0, gC); G8_STAGE_B(G8_SB(1, 1), cB + hstep + kstep);
    G8_WAIT_V(6); G8_BAR;
    for (;;) {
        const bool has_next = S.next(ui + 1, nxt);
        const char* nA = has_next ? nxt.a : cA; const char* nB = has_next ? nxt.b : cB;
        if constexpr (GATHER) { if (has_next) { G8_GOFF(gN, nxt); } else {
#pragma unroll
            for (int h = 0; h < 2; ++h)
#pragma unroll
                for (int i = 0; i < 2; ++i) gN[h][i] = gC[h][i]; } }
        for (int t = 0; t < nt; t += 2) {
            const bool last = (t == nt - 2);
            const char* a1 = cA + (size_t)(t + 1) * kstep;
            const char* a2 = last ? nA : cA + (size_t)(t + 2) * kstep; const char* b2 = last ? nB : cB + (size_t)(t + 2) * kstep;
            const char* a3 = a2 + kstep; const char* b3 = b2 + kstep;
            if constexpr (GATHER) {
#pragma unroll
                for (int h = 0; h < 2; ++h)
#pragma unroll
                    for (int i = 0; i < 2; ++i) g2[h][i] = last ? gN[h][i] : gC[h][i]; }
            G8_LDB(B0, 0, 0); G8_LDB(B1, 0, 1); G8_SCHED; G8_LDA(At, 0, 0); G8_STAGE_A(G8_SA(1, 1), a1, 1, gC);
            G8_WAIT_V(8); G8_WAIT_L(0); G8_BAR; G8_MMA(0, 0, At, B0); G8_MMA(0, 1, At, B1); G8_BAR; G8_SCHED;
            G8_LDA(At, 0, 1); G8_STAGE_B(G8_SB(0, 0), b2); G8_STAGE_B(G8_SB(0, 1), b2 + hstep); G8_STAGE_A(G8_SA(0, 0), a2, 0, g2);
            G8_WAIT_V(8); G8_WAIT_L(0); G8_BAR; G8_MMA(1, 0, At, B0); G8_MMA(1, 1, At, B1); G8_BAR; G8_SCHED;
            G8_LDB(B0, 1, 0); G8_LDB(B1, 1, 1); G8_SCHED; G8_LDA(At, 1, 0); G8_STAGE_A(G8_SA(0, 1), a2, 1, g2);
            G8_WAIT_V(8); G8_WAIT_L(0); G8_BAR; G8_MMA(0, 0, At, B0); G8_MMA(0, 1, At, B1); G8_BAR; G8_SCHED;
            G8_LDA(At, 1, 1); G8_STAGE_B(G8_SB(1, 0), b3); G8_STAGE_B(G8_SB(1, 1), b3 + hstep); G8_STAGE_A(G8_SA(1, 0), a3, 0, g2);
            G8_WAIT_V(8); G8_WAIT_L(0); G8_BAR; G8_MMA(1, 0, At, B0); G8_MMA(1, 1, At, B1); G8_BAR; G8_SCHED;
        }
        if (wr == 0) G8_BAR;
        E(acc, cur, wr, wc, fr, fq);
        if (!has_next) break;
#pragma unroll
        for (int a = 0; a < 2; ++a)
#pragma unroll
            for (int b = 0; b < 2; ++b)
#pragma unroll
                for (int m = 0; m < 4; ++m)
#pragma unroll
                    for (int n = 0; n < 2; ++n) acc[a][b][m][n] = (f32x4){0.f, 0.f, 0.f, 0.f};
        cur = nxt; cA = nA; cB = nB; ++ui;
        if constexpr (GATHER) {
#pragma unroll
            for (int h = 0; h < 2; ++h)
#pragma unroll
                for (int i = 0; i < 2; ++i) gC[h][i] = gN[h][i]; }
        if (wr == 1) G8_BAR;
    }
    G8_WAIT_V(0);
    G8_BAR;
#undef G8_SA
#undef G8_SB
#undef G8_DMA
#undef G8_STAGE_A
#undef G8_STAGE_B
#undef G8_LDA
#undef G8_LDB
#undef G8_MMA
#undef G8_WAIT_V
#undef G8_WAIT_L
#undef G8_BAR
#undef G8_SCHED
#undef G8_GOFF
}
}

enum { I_X = 0, I_POS, I_WIN, I_SGU_LNG, I_SGU_LNB, I_SGU_WS, I_SGU_B, I_LBLOG, I_HNORM, I_QNG, I_WUQ, I_KVNG, I_WUKV, I_WOUT, I_LN1G, I_LN1B,
       I_RGW, I_RGB, I_REW, I_REB, I_EWG, I_EWU, I_EWD, I_LN2G, I_LN2B };

enum { TK_WIN = 0, TK_WUQ, TK_WUKV, TK_WOUT, TK_GATE, TK_UP, TK_DOWN };
struct ConvItem { const float* src; bf16_t* dst0; bf16_t* dst1; const float* sc; int K, N, kind, k0, n0; };
DI void conv_load8(const ConvItem& c, u32x4 (&v)[8], int half, int lane) {
    const int c16 = lane & 15, r4 = lane >> 4;
    const unsigned voff = (unsigned)(((r4 + 32 * half) * c.N + 4 * c16) * 4);
    const char* base = (const char*)(c.src + (size_t)c.k0 * c.N + c.n0);
    const unsigned rstep = (unsigned)c.N * 16u;
#pragma unroll
    for (int i = 0; i < 8; ++i) { const unsigned vo = voff + (unsigned)i * rstep; asm volatile("global_load_dwordx4 %0, %1, %2 nt" : "=v"(v[i]) : "v"(vo), "s"(base) : "memory"); }
}
template <int N> DI void conv_wait(u32x4 (&a)[8], u32x4 (&b)[8]) {
    static_assert(N == 0 || N == 8, "conv_wait");
    if constexpr (N == 8) asm volatile("s_waitcnt vmcnt(8)" : "+v"(a[0]), "+v"(a[1]), "+v"(a[2]), "+v"(a[3]), "+v"(a[4]), "+v"(a[5]), "+v"(a[6]), "+v"(a[7]) :: "memory");
    else asm volatile("s_waitcnt vmcnt(0)" : "+v"(a[0]), "+v"(a[1]), "+v"(a[2]), "+v"(a[3]), "+v"(a[4]), "+v"(a[5]), "+v"(a[6]), "+v"(a[7]) :: "memory");
    asm volatile("" : "+v"(b[0]), "+v"(b[1]), "+v"(b[2]), "+v"(b[3]), "+v"(b[4]), "+v"(b[5]), "+v"(b[6]), "+v"(b[7]) :: "memory");
}
DI void conv_lds_write(const u32x4 (&lo)[8], const u32x4 (&hi)[8], LAS float* scr, int lane) {
    const int c16 = lane & 15, r4 = lane >> 4;
#pragma unroll
    for (int i = 0; i < 8; ++i) { LAS unsigned* d = (LAS unsigned*)scr + (4 * i + r4) * 65 + 4 * c16; d[0] = lo[i].x; d[1] = lo[i].y; d[2] = lo[i].z; d[3] = lo[i].w;
                                  LAS unsigned* e = d + 32 * 65; e[0] = hi[i].x; e[1] = hi[i].y; e[2] = hi[i].z; e[3] = hi[i].w; }
    asm volatile("s_waitcnt lgkmcnt(0)" ::: "memory");
}
DI void conv_out(const ConvItem& ci, LAS float* scr, int lane) {
    const int K = ci.K, kind = ci.kind;
    const int c = lane & 7;
    float s8[8];
#pragma unroll
    for (int i = 0; i < 8; ++i) s8[i] = ci.sc ? ci.sc[ci.k0 + 8 * c + i] : 1.0f;
#pragma unroll
    for (int j = 0; j < 8; ++j) {
        const int nl = (lane >> 3) + 8 * j, n = ci.n0 + nl; const LAS float* s = scr + (8 * c) * 65 + nl;
        u32x4 o; o.x = pk2(s[0 * 65] * s8[0], s[1 * 65] * s8[1]); o.y = pk2(s[2 * 65] * s8[2], s[3 * 65] * s8[3]); o.z = pk2(s[4 * 65] * s8[4], s[5 * 65] * s8[5]); o.w = pk2(s[6 * 65] * s8[6], s[7 * 65] * s8[7]);
        bf16_t* d = ci.dst0; int row = n;
        if (kind == TK_WIN) { if (n >= 4096) { const int jj = n - 4096; row = 4096 + 2 * (jj & 31) + (jj >> 5); } }
        else if (kind == TK_WUQ) { const int h = n / 192, cc = n % 192; if (cc >= 128) { const int jj = cc - 128; row = h * 192 + 128 + 2 * (jj & 31) + (jj >> 5); } }
        else if (kind == TK_WUKV) { const int h = n >> 8, cc = n & 255; if (cc < 128) row = h * 128 + cc; else { d = ci.dst1; row = h * 128 + cc - 128; } }
        else if (kind == TK_GATE) row = (n >> 7) * 256 + (n & 127);
        else if (kind == TK_UP) row = (n >> 7) * 256 + 128 + (n & 127);
        *(u32x4*)(d + (size_t)row * K + ci.k0 + 8 * c) = o;
    }
    asm volatile("s_waitcnt lgkmcnt(0)" ::: "memory");
}

constexpr int IT_WIN = 32 * 65, IT_WUQ = 8 * 24, IT_WUKV = 8 * 32, IT_WOUT = 32 * 32, IT_E = 256, IT_LAYER = IT_WIN + IT_WUQ + IT_WUKV + IT_WOUT + NEXP * 3 * IT_E;
struct ConvPtrs { const float *win, *wuq, *qng, *wukv, *kvng, *wout, *ewg, *ewu, *ewd; };
DI const float* uni_ptr(const float* q) { unsigned long long v = (unsigned long long)q; const unsigned lo = __builtin_amdgcn_readfirstlane((unsigned)v), hi = __builtin_amdgcn_readfirstlane((unsigned)(v >> 32));
    return (const float*)(const __attribute__((address_space(1))) float*)(((unsigned long long)hi << 32) | lo); }
template <bool DIRECT> DI ConvPtrs conv_ptrs(const Params& p, unsigned char* ws) {
    ConvPtrs c; c.win = uni_ptr(pinT<DIRECT>(p, ws, I_WIN)); c.wuq = uni_ptr(pinT<DIRECT>(p, ws, I_WUQ)); c.qng = uni_ptr(pinT<DIRECT>(p, ws, I_QNG)); c.wukv = uni_ptr(pinT<DIRECT>(p, ws, I_WUKV));
    c.kvng = uni_ptr(pinT<DIRECT>(p, ws, I_KVNG)); c.wout = uni_ptr(pinT<DIRECT>(p, ws, I_WOUT)); c.ewg = uni_ptr(pinT<DIRECT>(p, ws, I_EWG)); c.ewu = uni_ptr(pinT<DIRECT>(p, ws, I_EWU)); c.ewd = uni_ptr(pinT<DIRECT>(p, ws, I_EWD));
    return c;
}
DI ConvItem conv_desc(const ConvPtrs& P, unsigned char* ws, int l, int r) {
    ConvItem c; c.dst1 = nullptr; c.sc = nullptr; int item;
    if (r < IT_WIN) { c.src = P.win + (size_t)l * DM * DIN; c.K = DM; c.N = DIN; c.kind = TK_WIN; c.dst0 = (bf16_t*)(ws + WS_WIN) + (size_t)l * DIN * DM; item = r; }
    else if ((r -= IT_WIN) < IT_WUQ) { c.src = P.wuq + (size_t)l * 512 * 1536; c.K = 512; c.N = 1536; c.kind = TK_WUQ; c.dst0 = (bf16_t*)(ws + WS_WUQ) + (size_t)l * 1536 * 512; c.sc = P.qng + l * 512; item = r; }
    else if ((r -= IT_WUQ) < IT_WUKV) { c.src = P.wukv + (size_t)l * 512 * 2048; c.K = 512; c.N = 2048; c.kind = TK_WUKV; c.dst0 = (bf16_t*)(ws + WS_WUK) + (size_t)l * 1024 * 512; c.dst1 = (bf16_t*)(ws + WS_WUV) + (size_t)l * 1024 * 512; c.sc = P.kvng + l * 512; item = r; }
    else if ((r -= IT_WUKV) < IT_WOUT) { c.src = P.wout + (size_t)l * DM * DM; c.K = DM; c.N = DM; c.kind = TK_WOUT; c.dst0 = (bf16_t*)(ws + WS_WOUT) + (size_t)l * DM * DM; item = r; }
    else { r -= IT_WOUT; const int e = r / (3 * IT_E), r2 = r % (3 * IT_E), ty = r2 / IT_E; item = r2 % IT_E; const size_t le = (size_t)l * NEXP + e;
        if (ty == 0) { c.src = P.ewg + le * DM * DEXP; c.K = DM; c.N = DEXP; c.kind = TK_GATE; c.dst0 = (bf16_t*)(ws + WS_WGU) + le * 1024 * DM; }
        else if (ty == 1) { c.src = P.ewu + le * DM * DEXP; c.K = DM; c.N = DEXP; c.kind = TK_UP; c.dst0 = (bf16_t*)(ws + WS_WGU) + le * 1024 * DM; }
        else { c.src = P.ewd + le * DEXP * DM; c.K = DEXP; c.N = DM; c.kind = TK_DOWN; c.dst0 = (bf16_t*)(ws + WS_WD) + le * DM * DEXP; } }
    const int nblk = c.N / 64; c.k0 = 64 * (item / nblk); c.n0 = 64 * (item % nblk);
    return c;
}
template <bool DIRECT> DI void conv_range(const Params& p, unsigned char* ws, int l, int first, int step, int end, LAS float* scr, int lane) {
    if (first >= end) return;
    const ConvPtrs P = conv_ptrs<DIRECT>(p, ws);
    u32x4 X[8], Z[8];
    if constexpr (DIRECT) {
        for (int it = first; it < end; it += step) { const ConvItem c = conv_desc(P, ws, l, it); conv_load8(c, X, 0, lane); conv_load8(c, Z, 1, lane); conv_wait<0>(X, Z); conv_lds_write(X, Z, scr, lane); conv_out(c, scr, lane); }
        return;
    }
    u32x4 Y[8];
    ConvItem ca = conv_desc(P, ws, l, first), cb = ca;
    conv_load8(ca, X, 0, lane); conv_load8(ca, Z, 1, lane);
    for (int it = first; ; it += 2 * step) {
        const bool hb = it + step < end;
        if (hb) { cb = conv_desc(P, ws, l, it + step); conv_load8(cb, Y, 0, lane); conv_wait<8>(X, Z); } else conv_wait<0>(X, Z);
        conv_lds_write(X, Z, scr, lane);
        if (hb) conv_load8(cb, Z, 1, lane);
        conv_out(ca, scr, lane);
        if (!hb) break;
        const bool ha = it + 2 * step < end;
        if (ha) { ca = conv_desc(P, ws, l, it + 2 * step); conv_load8(ca, X, 0, lane); conv_wait<8>(Y, Z); } else conv_wait<0>(Y, Z);
        conv_lds_write(Y, Z, scr, lane);
        if (ha) conv_load8(ca, Z, 1, lane);
        conv_out(cb, scr, lane);
        if (!ha) break;
    }
}
constexpr int CONV_UNIT = 64, N_CONV_UNITS = (IT_LAYER + CONV_UNIT - 1) / CONV_UNIT;
DI void conv_unit(const Params& p, LAS unsigned char* lds, int l, int u) {
    unsigned char* ws = ows(p);
    const int tid = otid(), lane = tid & 63, wave = __builtin_amdgcn_readfirstlane(tid >> 6);
    LAS float* scr = (LAS float*)(lds + wave * 16640);
    const int hi = (u + 1) * CONV_UNIT < IT_LAYER ? (u + 1) * CONV_UNIT : IT_LAYER;
    conv_range<false>(p, ws, l, u * CONV_UNIT + wave, 8, hi, scr, lane);
}

DI void phase_prologue(const Params& p, LAS unsigned char* lds, int bid, int G) {
    const int tid = otid(), lane = tid & 63, wave = __builtin_amdgcn_readfirstlane(tid >> 6);
    unsigned char* ws = ows(p);
    LAS float* scr = (LAS float*)(lds + wave * 16640);
    const int gw = bid * 8 + wave, NGW = G * 8;
    if (bid == 0 && tid < 25) ((unsigned long long*)(ws + WS_CTL + PTR_TAB_BYTES))[tid] = (unsigned long long)p.in[tid];
    conv_range<true>(p, ws, 0, gw, NGW, IT_LAYER, scr, lane);
    const int gt = bid * NTHR + tid, NG = G * NTHR;
    {
        const f32x4* x4 = (const f32x4*)p.in[I_X]; u32x2* xb = (u32x2*)(ws + WS_XB);
        for (int i = gt; i < NT * DM / 4; i += NG) { const f32x4 v = x4[i]; xb[i] = (u32x2){pk2(v.x, v.y), pk2(v.z, v.w)}; }
    }
    {
        float* cs = (float*)(ws + WS_COS); const int* pos = (const int*)p.in[I_POS];
        for (int i = gt; i < NT * 32; i += NG) {
            const int tok = i >> 5, j = i & 31;
            const float inv = 1.0f / powf(10000.0f, (float)(2 * j) / 64.0f);
            const float ang = (float)pos[tok] * inv;
            const double a = (double)ang; const double k = rint(a * 0.15915494309189535); const double rr = a - k * 6.283185307179586476925;
            const float rf = (float)rr;
            cs[i] = cosf(rf); cs[NT * 32 + i] = sinf(rf);
        }
    }
    {
        float* lb = (float*)(ws + WS_LB); const float* lg = p.in[I_LBLOG];
        for (int c = gt; c < 512; c += NG) {
            float v[DEPTH], mx = -3.0e38f;
            for (int l = 0; l < DEPTH; ++l) { v[l] = lg[l * 512 + c]; mx = fmaxf(mx, v[l]); }
            float s = 0.f; for (int l = 0; l < DEPTH; ++l) { v[l] = expf(v[l] - mx); s += v[l]; }
            float cum = 0.f, first = 0.f;
            for (int l = 0; l < DEPTH; ++l) { cum += v[l] / s; if (l == 0) first = cum; lb[l * 512 + c] = cum - first; }
        }
    }
    {
        bf16_t* o = (bf16_t*)(ws + WS_SGUW); const float* w = p.in[I_SGU_WS];
        for (int i = gt; i < DEPTH * 4 * 128 * 128; i += NG) { const int s = i & 127, t = (i >> 7) & 127; o[i] = f2bf(s <= t ? w[i] : 0.f); }
    }
    {
        const float* rgw = p.in[I_RGW]; const float* rew = p.in[I_REW]; const float* l1g = p.in[I_LN1G]; const float* l1b = p.in[I_LN1B]; const float* rgb = p.in[I_RGB]; const float* reb = p.in[I_REB];
        float* rw = (float*)(ws + WS_ROUTW);
        for (int i = gt; i < DEPTH * 48 * DM; i += NG) {
            const int k = i % DM, n = (i / DM) % 48, l = i / (DM * 48);
            float w = 0.f;
            if (n < 4) w = rgw[((size_t)l * DM + k) * 4 + n]; else if (n < 36) w = rew[((size_t)l * DM + k) * 32 + (n - 4)];
            rw[i] = w * l1g[l * DM + k];
        }
        float* rc = (float*)(ws + WS_ROUTC);
        for (int it = gw; it < DEPTH * 48; it += NGW) {
            const int l = it / 48, n = it % 48; float s1 = 0.f, s0 = 0.f;
            if (n < 36) for (int k = lane; k < DM; k += 64) {
                const float w = (n < 4) ? rgw[((size_t)l * DM + k) * 4 + n] : rew[((size_t)l * DM + k) * 32 + (n - 4)];
                s1 += w * l1g[l * DM + k]; s0 += w * l1b[l * DM + k]; }
            s1 = wave_sum(s1); s0 = wave_sum(s0);
            if (lane == 0) { const float bias = (n < 4) ? rgb[l * 4 + n] : (n < 36 ? reb[l * 32 + n - 4] : 0.f); rc[(l * 2 + 0) * 48 + n] = s0 + bias; rc[(l * 2 + 1) * 48 + n] = s1; }
        }
    }
}

struct EpiInProj {
    static constexpr bool PERM = true;
    bf16_t* HB; float* LOGF; float* SSQ; const float* lb;
    template <int KIND> DI void run(const f32x4 (&acc)[2][2][4][2], const g8::Unit& u, int wr, int wc, int fr, int fq) const {
        const int row0 = u.pm * 256 + wr * 64 + fr, col0 = u.pn * 256 + wc * 32 + 8 * fq;
        float lbv[2][8];
        if constexpr (KIND == 2) {
#pragma unroll
            for (int bj = 0; bj < 2; ++bj)
#pragma unroll
                for (int i = 0; i < 8; ++i) lbv[bj][i] = lb[col0 - 1536 + bj * 128 + i];
        }
#pragma unroll
        for (int ai = 0; ai < 2; ++ai)
#pragma unroll
            for (int m = 0; m < 4; ++m) {
                const int row = row0 + ai * 128 + m * 16; float ssq = 0.f;
#pragma unroll
                for (int bj = 0; bj < 2; ++bj) {
                    float v[8];
#pragma unroll
                    for (int i = 0; i < 4; ++i) { v[i] = acc[ai][bj][m][0][i]; v[4 + i] = acc[ai][bj][m][1][i]; }
                    const int col = col0 + bj * 128;
                    if constexpr (KIND == 0) {
#pragma unroll
                        for (int i = 0; i < 8; ++i) v[i] = geluf_(v[i]);
                    } else if constexpr (KIND == 1) {
#pragma unroll
                        for (int i = 0; i < 8; ++i) v[i] = siluf_(v[i]);
                    } else if constexpr (KIND == 2) {
                        float lf[8];
#pragma unroll
                        for (int i = 0; i < 8; ++i) { const float e = __expf(v[i]), l_ = lbv[bj][i];
                            const float f = l_ + (1.0f - l_) * rcp_(1.0f + __expf(-v[i]));
                            lf[i] = logf(f); v[i] = (1.0f - l_) * rcp_(1.0f + e); }
                        float* lp = LOGF + (size_t)row * 512 + (col - 1536);
                        *(f32x4*)lp = (f32x4){lf[0], lf[1], lf[2], lf[3]}; *(f32x4*)(lp + 4) = (f32x4){lf[4], lf[5], lf[6], lf[7]};
                    } else if constexpr (KIND == 4) {
#pragma unroll
                        for (int i = 0; i < 8; ++i) ssq += v[i] * v[i];
                    }
                    u32x4 w; w.x = pk2(v[0], v[1]); w.y = pk2(v[2], v[3]); w.z = pk2(v[4], v[5]); w.w = pk2(v[6], v[7]);
                    *(u32x4*)(HB + (size_t)row * 4096 + col) = w;
                }
                if constexpr (KIND == 4) {
                    ssq += __shfl_xor(ssq, 16); ssq += __shfl_xor(ssq, 32);
                    if (fq == 0) SSQ[(size_t)row * 16 + (u.pn - 12) * 4 + wc] = ssq;
                }
            }
    }
    DI void operator()(const f32x4 (&acc)[2][2][4][2], const g8::Unit& u, int wr, int wc, int fr, int fq) const {
        const int pn = u.pn;
        if (pn < 4) run<0>(acc, u, wr, wc, fr, fq);
        else if (pn < 6) run<1>(acc, u, wr, wc, fr, fq);
        else if (pn < 8) run<2>(acc, u, wr, wc, fr, fq);
        else if (pn < 10) run<3>(acc, u, wr, wc, fr, fq);
        else if (pn < 12) run<1>(acc, u, wr, wc, fr, fq);
        else run<4>(acc, u, wr, wc, fr, fq);
    }
};
DI void phase_inproj(const Params& p, LAS unsigned char* lds, int bid, int G, int l) {
    unsigned char* ws = ows(p);
    g8::StaticSched S; S.init(ws + WS_XB, (bf16_t*)(ws + WS_WIN) + (size_t)l * DIN * DM, NT, DIN_MAIN, DM, DM, G, bid);
    EpiInProj E{(bf16_t*)(ws + WS_HB), (float*)(ws + WS_LOGF), (float*)(ws + WS_SSQ), (const float*)(ws + WS_LB) + l * 512};
    g8::gemm_phase<EpiInProj, g8::StaticSched, false>(lds, DM, DM, DM, S, E);
}

DI void phase_krope(const Params& p, LAS unsigned char* lds, int bid, int G, int l) {
    unsigned char* ws = ows(p);
    const int tid = otid(), lane = tid & 63, wave = __builtin_amdgcn_readfirstlane(tid >> 6), fr = lane & 15, fq = lane >> 4;
    const bf16_t* X = (const bf16_t*)(ws + WS_XB); const bf16_t* W = (const bf16_t*)(ws + WS_WIN) + ((size_t)l * DIN + 4096) * DM;
    const float* cs = (const float*)(ws + WS_COS); bf16_t* KR = (bf16_t*)(ws + WS_KR);
    LAS float* PART = (LAS float*)lds;
    for (int task = bid; task < NT / 16; task += G) {
        const int r0 = task * 16;
        f32x4 acc[4];
#pragma unroll
        for (int n = 0; n < 4; ++n) acc[n] = (f32x4){0.f, 0.f, 0.f, 0.f};
        const bf16_t* ap = X + (size_t)(r0 + fr) * DM + 256 * wave + 8 * fq;
        const bf16_t* bp = W + (size_t)fr * DM + 256 * wave + 8 * fq;
#pragma unroll
        for (int s2 = 0; s2 < 8; ++s2) {
            const bf16x8 a = *(const bf16x8*)(ap + 32 * s2);
#pragma unroll
            for (int n = 0; n < 4; ++n) { const bf16x8 b = *(const bf16x8*)(bp + (size_t)(16 * n) * DM + 32 * s2); acc[n] = __builtin_amdgcn_mfma_f32_16x16x32_bf16(a, b, acc[n], 0, 0, 0); }
        }
        __syncthreads();
#pragma unroll
        for (int n = 0; n < 4; ++n)
#pragma unroll
            for (int i = 0; i < 4; ++i) PART[(wave * 16 + 4 * fq + i) * 64 + 16 * n + fr] = acc[n][i];
        __syncthreads();
        {
            const int row = tid >> 5, j = tid & 31; float x1 = 0.f, x2 = 0.f;
#pragma unroll
            for (int w = 0; w < 8; ++w) { const f32x2 v = *(const LAS f32x2*)(PART + (w * 16 + row) * 64 + 2 * j); x1 += v.x; x2 += v.y; }
            const size_t grow = (size_t)(r0 + row);
            const float c = cs[grow * 32 + j], sn = cs[(size_t)NT * 32 + grow * 32 + j];
            *(unsigned*)(KR + grow * 64 + 2 * j) = pk2(x1 * c - x2 * sn, x2 * c + x1 * sn);
        }
    }
}

DI void phase_sgu(const Params& p, LAS unsigned char* lds, int bid, int G, int l) {
    unsigned char* ws = ows(p);
    const int tid = otid(), lane = tid & 63, wave = tid >> 6, fr = lane & 15, fq = lane >> 4;
    const bf16_t* HB = (const bf16_t*)(ws + WS_HB); bf16_t* CAT = (bf16_t*)(ws + WS_CAT);
    const bf16_t* SW = (const bf16_t*)(ws + WS_SGUW) + (size_t)l * 4 * 128 * 128;
    const float* lng = pinT<false>(p, ws, I_SGU_LNG) + l * 512; const float* lnb = pinT<false>(p, ws, I_SGU_LNB) + l * 512; const float* sb = pinT<false>(p, ws, I_SGU_B) + l * 512;
    constexpr int TS = 272;
    LAS unsigned char* T = lds;
    for (int unit = bid; unit < 128 * 4; unit += G) {
        const int ci = unit >> 2, g = unit & 3, rbase = ci * 128;
        __syncthreads();
        for (int rr = 0; rr < 4; ++rr) {
            const int s = wave * 16 + rr * 4 + fq, row = rbase + s;
            float v[4][8]; float sm = 0.f;
#pragma unroll
            for (int j = 0; j < 4; ++j) { const u32x4 raw = *(const u32x4*)(HB + (size_t)row * 4096 + 512 + 128 * j + 8 * fr);
                v[j][0] = bflo(raw.x); v[j][1] = bfhi(raw.x); v[j][2] = bflo(raw.y); v[j][3] = bfhi(raw.y); v[j][4] = bflo(raw.z); v[j][5] = bfhi(raw.z); v[j][6] = bflo(raw.w); v[j][7] = bfhi(raw.w);
#pragma unroll
                for (int i = 0; i < 8; ++i) sm += v[j][i]; }
            sm += __shfl_xor(sm, 1); sm += __shfl_xor(sm, 2); sm += __shfl_xor(sm, 4); sm += __shfl_xor(sm, 8);
            const float mean = sm * (1.0f / 512.0f); float sq = 0.f;
#pragma unroll
            for (int j = 0; j < 4; ++j)
#pragma unroll
                for (int i = 0; i < 8; ++i) { v[j][i] -= mean; sq += v[j][i] * v[j][i]; }
            sq += __shfl_xor(sq, 1); sq += __shfl_xor(sq, 2); sq += __shfl_xor(sq, 4); sq += __shfl_xor(sq, 8);
            const float rstd = rsq_(sq * (1.0f / 512.0f) + EPS);
#pragma unroll
            for (int j = 0; j < 4; ++j) if (j == g) {
#pragma unroll
                for (int i = 0; i < 8; ++i) { const int c = 128 * j + 8 * fr + i, d = 8 * fr + i; const float y = v[j][i] * rstd * lng[c] + lnb[c];
                    *(LAS bf16_t*)(T + d * TS + s * 2) = f2bf(y); }
            }
        }
        __syncthreads();
        f32x4 acc[8];
#pragma unroll
        for (int n = 0; n < 8; ++n) acc[n] = (f32x4){0.f, 0.f, 0.f, 0.f};
        const bf16_t* wp = SW + ((size_t)g * 128 + wave * 16 + fr) * 128 + 8 * fq;
        const int ksmax = wave >> 1;
        for (int ks = 0; ks <= ksmax; ++ks) {
            const bf16x8 a = *(const bf16x8*)(wp + 32 * ks);
#pragma unroll
            for (int n = 0; n < 8; ++n) { const bf16x8 b = *(const LAS bf16x8*)(T + (16 * n + fr) * TS + (32 * ks + 8 * fq) * 2); acc[n] = __builtin_amdgcn_mfma_f32_16x16x32_bf16(a, b, acc[n], 0, 0, 0); }
        }
#pragma unroll
        for (int i = 0; i < 4; ++i) {
            const int t = wave * 16 + 4 * fq + i, row = rbase + t; const float bias = sb[g * 128 + t];
#pragma unroll
            for (int n = 0; n < 8; ++n) { const int c = g * 128 + 16 * n + fr; const float uu = bf2f(HB[(size_t)row * 4096 + c]);
                CAT[(size_t)row * DM + c] = f2bf(uu * (acc[n][i] + bias)); }
        }
    }
}

constexpr int HQ_OFF = 0, HK_OFF = 17408, HG_OFF = 34816, HKD_OFF = 52224, HV_OFF = 70656, HP_OFF = 89088, HSEG_OFF = 98304;
constexpr int HS_T = 272, HS_S = 144;
#define HG_BAR() do { asm volatile("s_waitcnt lgkmcnt(0)" ::: "memory"); __builtin_amdgcn_s_barrier(); asm volatile("" ::: "memory"); } while (0)
DI void hgrn_local_unit(const bf16_t* HB, const float* LOGF, float* OI, float* UU, bf16_t* QGg, float* DLg, LAS unsigned char* lds, int b, int h, int c) {
    const int tid = otid(), lane = tid & 63, wave = __builtin_amdgcn_readfirstlane(tid >> 6), fr = lane & 15, fq = lane >> 4;
    const int kp = lane, seg = wave;
    const size_t unit = (size_t)((b * 4 + h) * 64 + c), rowb = (size_t)b * SEQ;
    f32x2 lf[8]; unsigned qr[8], kr[8], vr[8];
#pragma unroll
    for (int i = 0; i < 8; ++i) { const size_t row = rowb + c * 64 + 8 * seg + i;
        lf[i] = *(const f32x2*)(LOGF + row * 512 + h * 128 + 2 * kp); const bf16_t* hp = HB + row * 4096 + h * 128 + 2 * kp;
        qr[i] = *(const unsigned*)(hp + 1024); kr[i] = *(const unsigned*)(hp + 1536); vr[i] = *(const unsigned*)(hp + 2048); }
    __syncthreads();
    if (tid < 128) { const int t = (tid < 64) ? (tid >> 2) : 32 + ((tid - 64) >> 2), s0 = ((tid < 64) ? 16 : 48) + 4 * (tid & 3);
        unsigned z = 0u; asm volatile("" : "+v"(z));
        *(LAS u32x2*)(lds + HP_OFF + t * HS_S + s0 * 2) = (u32x2){z, z}; }
    { float c0 = 0.f, c1 = 0.f;
#pragma unroll
      for (int i = 0; i < 8; ++i) { c0 += lf[i].x; c1 += lf[i].y; lf[i].x = c0; lf[i].y = c1; }
      *(LAS f32x2*)(lds + HSEG_OFF + (seg * 128 + 2 * kp) * 4) = (f32x2){c0, c1}; }
    HG_BAR();
    { f32x2 off = {0.f, 0.f}, R = {0.f, 0.f}, GL = {0.f, 0.f};
#pragma unroll
      for (int j = 0; j < 8; ++j) { const f32x2 tj = *(const LAS f32x2*)(lds + HSEG_OFF + (j * 128 + 2 * kp) * 4); if (j < seg) off += tj; if (j < 4) R += tj; GL += tj; }
      const f32x2 eR = {__expf(R.x), __expf(R.y)}, eGR = {__expf(GL.x - R.x), __expf(GL.y - R.y)};
      float kd0[8], kd1[8];
#pragma unroll
      for (int i = 0; i < 8; ++i) {
          const int t = 8 * seg + i; const float g0 = off.x + lf[i].x, g1 = off.y + lf[i].y;
          const float e10 = __expf(g0 - R.x), e11 = __expf(g1 - R.y), e20 = __expf(R.x - g0), e21 = __expf(R.y - g1), e30 = e10 * eR.x, e31 = e11 * eR.y, e40 = e20 * eGR.x, e41 = e21 * eGR.y;
          const float q0 = bflo(qr[i]), q1 = bfhi(qr[i]), k0 = bflo(kr[i]), k1 = bfhi(kr[i]);
          *(LAS unsigned*)(lds + HQ_OFF + t * HS_T + kp * 4) = pk2(q0 * e10, q1 * e11);
          *(LAS unsigned*)(lds + HK_OFF + t * HS_T + kp * 4) = pk2(k0 * e20, k1 * e21);
          *(LAS unsigned*)(lds + HG_OFF + t * HS_T + kp * 4) = pk2(q0 * e30, q1 * e31);
          kd0[i] = k0 * e40; kd1[i] = k1 * e41;
      }
      *(LAS u32x4*)(lds + HKD_OFF + (2 * kp) * HS_S + 16 * seg) = (u32x4){pk2(kd0[0], kd0[1]), pk2(kd0[2], kd0[3]), pk2(kd0[4], kd0[5]), pk2(kd0[6], kd0[7])};
      *(LAS u32x4*)(lds + HKD_OFF + (2 * kp + 1) * HS_S + 16 * seg) = (u32x4){pk2(kd1[0], kd1[1]), pk2(kd1[2], kd1[3]), pk2(kd1[4], kd1[5]), pk2(kd1[6], kd1[7])};
      u32x4 v0, v1;
      v0.x = (vr[0] & 0xffffu) | (vr[1] << 16); v0.y = (vr[2] & 0xffffu) | (vr[3] << 16); v0.z = (vr[4] & 0xffffu) | (vr[5] << 16); v0.w = (vr[6] & 0xffffu) | (vr[7] << 16);
      v1.x = (vr[0] >> 16) | (vr[1] & 0xffff0000u); v1.y = (vr[2] >> 16) | (vr[3] & 0xffff0000u); v1.z = (vr[4] >> 16) | (vr[5] & 0xffff0000u); v1.w = (vr[6] >> 16) | (vr[7] & 0xffff0000u);
      *(LAS u32x4*)(lds + HV_OFF + (2 * kp) * HS_S + 16 * seg) = v0;
      *(LAS u32x4*)(lds + HV_OFF + (2 * kp + 1) * HS_S + 16 * seg) = v1;
      if (seg == 0) *(f32x2*)(DLg + unit * 128 + 2 * kp) = (f32x2){__expf(GL.x), __expf(GL.y)};
    }
    HG_BAR();
    for (int rep = 0; rep < 2; ++rep) {
        const int idx = wave + 8 * rep; if (idx >= 10) break;
        const int a = (int)((0x3221110000ULL >> (4 * idx)) & 0xf), bt = (int)((0x3323213210ULL >> (4 * idx)) & 0xf);
        f32x4 pacc = {0.f, 0.f, 0.f, 0.f};
#pragma unroll
        for (int ks = 0; ks < 4; ++ks) {
            const bf16x8 af = *(const LAS bf16x8*)(lds + HK_OFF + (16 * a + fr) * HS_T + (32 * ks + 8 * fq) * 2);
            const bf16x8 bf = *(const LAS bf16x8*)(lds + HQ_OFF + (16 * bt + fr) * HS_T + (32 * ks + 8 * fq) * 2);
            pacc = __builtin_amdgcn_mfma_f32_16x16x32_bf16(af, bf, pacc, 0, 0, 0);
        }
        const int t = 16 * bt + fr, s0 = 16 * a + 4 * fq;
#pragma unroll
        for (int i = 0; i < 4; ++i) if (s0 + i > t) pacc[i] = 0.f;
        *(LAS u32x2*)(lds + HP_OFF + t * HS_S + s0 * 2) = (u32x2){pk2(pacc[0], pacc[1]), pk2(pacc[2], pacc[3])};
    }
#pragma unroll
    for (int jj = 0; jj < 2; ++jj) { const int pp = tid + 512 * jj, t = pp >> 4, c16 = pp & 15;
        *(u32x4*)(QGg + unit * 8192 + t * 128 + c16 * 8) = *(const LAS u32x4*)(lds + HG_OFF + t * HS_T + c16 * 16); }
    HG_BAR();
    {
        bf16x8 vf[2];
#pragma unroll
        for (int ss = 0; ss < 2; ++ss) vf[ss] = *(const LAS bf16x8*)(lds + HV_OFF + (16 * wave + fr) * HS_S + (32 * ss + 8 * fq) * 2);
        u32x4* oi = (u32x4*)OI + (unit * 8 + wave) * 2 * 64 + lane;
        f32x4 oacc[4];
#pragma unroll
        for (int bt = 0; bt < 4; ++bt) {
            f32x4 acc = {0.f, 0.f, 0.f, 0.f};
#pragma unroll
            for (int ss = 0; ss < 2; ++ss) if (32 * ss <= 16 * bt + 15) {
                const bf16x8 pf = *(const LAS bf16x8*)(lds + HP_OFF + (16 * bt + fr) * HS_S + (32 * ss + 8 * fq) * 2);
                acc = __builtin_amdgcn_mfma_f32_16x16x32_bf16(pf, vf[ss], acc, 0, 0, 0);
            }
            oacc[bt] = acc;
        }
#pragma unroll
        for (int pr = 0; pr < 2; ++pr) oi[pr * 64] = (u32x4){pk2(oacc[2 * pr][0], oacc[2 * pr][1]), pk2(oacc[2 * pr][2], oacc[2 * pr][3]), pk2(oacc[2 * pr + 1][0], oacc[2 * pr + 1][1]), pk2(oacc[2 * pr + 1][2], oacc[2 * pr + 1][3])};
        u32x4* uu = (u32x4*)UU + (unit * 8 + wave) * 4 * 64 + lane;
        f32x4 uacc[8];
#pragma unroll
        for (int a = 0; a < 8; ++a) {
            f32x4 acc = {0.f, 0.f, 0.f, 0.f};
#pragma unroll
            for (int ss = 0; ss < 2; ++ss) {
                const bf16x8 kf = *(const LAS bf16x8*)(lds + HKD_OFF + (16 * a + fr) * HS_S + (32 * ss + 8 * fq) * 2);
                acc = __builtin_amdgcn_mfma_f32_16x16x32_bf16(kf, vf[ss], acc, 0, 0, 0);
            }
            uacc[a] = acc;
        }
#pragma unroll
        for (int a2 = 0; a2 < 4; ++a2) uu[a2 * 64] = (u32x4){pk2(uacc[2 * a2][0], uacc[2 * a2][1]), pk2(uacc[2 * a2][2], uacc[2 * a2][3]), pk2(uacc[2 * a2 + 1][0], uacc[2 * a2 + 1][1]), pk2(uacc[2 * a2 + 1][2], uacc[2 * a2 + 1][3])};
    }
}
DI void phase_hgrn_local(const Params& p, LAS unsigned char* lds, int bid, int G, int l) {
    unsigned char* ws = ows(p);
    for (int u = bid; u < 1024; u += G) { const int bh = u >> 6, c = u & 63;
        hgrn_local_unit((const bf16_t*)(ws + WS_HB), (const float*)(ws + WS_LOGF), (float*)(ws + WS_OH), (float*)(ws + WS_HU), (bf16_t*)(ws + WS_HQG), (float*)(ws + WS_HDL), lds, bh >> 2, bh & 3, c); }
}
constexpr int SQ_OFF = 0, SOT_OFF = 34816, SSS_OFF = 67584, SDL_OFF = 71680;
struct HsW { u32x4 oi[2], u[4]; };
struct HsQ { u32x4 q[2]; f32x4 d; };
DI void hgrn_seq_unit(const bf16_t* HB, const float* OI, const float* UU, const bf16_t* QGg, const float* DLg, const float* ng, bf16_t* CAT, LAS unsigned char* lds, int b, int h) {
    const int tid = otid(), lane = tid & 63, wave = __builtin_amdgcn_readfirstlane(tid >> 6), fr = lane & 15, fq = lane >> 4;
    const size_t unit0 = (size_t)((b * 4 + h) * 64), rowb = (size_t)b * SEQ;
    f32x4 S[8];
#pragma unroll
    for (int a = 0; a < 8; ++a) S[a] = (f32x4){0.f, 0.f, 0.f, 0.f};
    HsW w0, w1, w2; HsQ q1, q2; u32x4 g0[2], g1[2];
    w2 = HsW{}; q2 = HsQ{};
#define HS_LOADW(W, c) do { const size_t un = unit0 + (c); const u32x4* oi_ = (const u32x4*)OI + (un * 8 + wave) * 2 * 64 + lane; const u32x4* uu_ = (const u32x4*)UU + (un * 8 + wave) * 4 * 64 + lane; \
        asm volatile("" : "+v"(oi_), "+v"(uu_)); W.oi[0] = oi_[0]; W.oi[1] = oi_[64]; W.u[0] = uu_[0]; W.u[1] = uu_[64]; W.u[2] = uu_[128]; W.u[3] = uu_[192]; } while (0)
#define HS_LOADQ(Qs, c) do { _Pragma("unroll") for (int jj = 0; jj < 2; ++jj) { const int pp = tid + 512 * jj; Qs.q[jj] = *(const u32x4*)(QGg + (unit0 + (c)) * 8192 + (pp >> 4) * 128 + (pp & 15) * 8); } \
        Qs.d = (tid < 32) ? *(const f32x4*)(DLg + (unit0 + (c)) * 128 + 4 * (tid & 31)) : (f32x4){0.f, 0.f, 0.f, 0.f}; } while (0)
#define HS_STOREQ(Qs, buf) do { _Pragma("unroll") for (int jj = 0; jj < 2; ++jj) { const int pp = tid + 512 * jj; *(LAS u32x4*)(lds + SQ_OFF + (buf) * 17408 + (pp >> 4) * HS_T + (pp & 15) * 16) = Qs.q[jj]; } \
        if (tid < 32) *(LAS f32x4*)(lds + SDL_OFF + (buf) * 512 + tid * 16) = Qs.d; } while (0)
#define HS_LOADG(Gs, c) do { _Pragma("unroll") for (int jj = 0; jj < 2; ++jj) Gs[jj] = *(const u32x4*)(HB + (rowb + (c) * 64 + (lane >> 1) + 32 * jj) * 4096 + 2560 + h * 128 + 16 * wave + 8 * (lane & 1)); } while (0)
    const int v0 = h * 128 + 16 * wave + 8 * (lane & 1);
    const f32x4 gn0 = *(const f32x4*)(ng + v0), gn1 = *(const f32x4*)(ng + v0 + 4);
    __syncthreads();
    HS_LOADQ(q1, 0); HS_LOADW(w0, 0); HS_LOADG(g0, 0);
    HS_STOREQ(q1, 0);
    HS_LOADQ(q1, 1); HS_LOADW(w1, 1);
    HG_BAR();
    for (int c = 0; c < SEQ / 64; ++c) {
        const int buf = c & 1;
        if (c + 2 < SEQ / 64) { HS_LOADQ(q2, c + 2); HS_LOADW(w2, c + 2); }
        if (c + 1 < SEQ / 64) HS_LOADG(g1, c + 1);
        f32x4 o[4];
        {
            bf16x8 sf[4];
#pragma unroll
            for (int a2 = 0; a2 < 4; ++a2) { const u32x4 w = {pk2(S[2 * a2][0], S[2 * a2][1]), pk2(S[2 * a2][2], S[2 * a2][3]), pk2(S[2 * a2 + 1][0], S[2 * a2 + 1][1]), pk2(S[2 * a2 + 1][2], S[2 * a2 + 1][3])}; sf[a2] = __builtin_bit_cast(bf16x8, w); }
#pragma unroll
            for (int bt = 0; bt < 4; ++bt) {
                const u32x4 ow = w0.oi[bt >> 1];
                f32x4 acc = (bt & 1) ? (f32x4){bflo(ow.z), bfhi(ow.z), bflo(ow.w), bfhi(ow.w)} : (f32x4){bflo(ow.x), bfhi(ow.x), bflo(ow.y), bfhi(ow.y)};
#pragma unroll
                for (int a2 = 0; a2 < 4; ++a2) {
                    const LAS unsigned char* gp = lds + SQ_OFF + buf * 17408 + (16 * bt + fr) * HS_T + (32 * a2 + 4 * fq) * 2;
                    const u32x2 lo = *(const LAS u32x2*)gp, hi = *(const LAS u32x2*)(gp + 32);
                    const u32x4 w = {lo.x, lo.y, hi.x, hi.y};
                    acc = __builtin_amdgcn_mfma_f32_16x16x32_bf16(__builtin_bit_cast(bf16x8, w), sf[a2], acc, 0, 0, 0);
                }
                o[bt] = acc;
            }
#pragma unroll
            for (int a = 0; a < 8; ++a) { const u32x4 uw = w0.u[a >> 1];
                const f32x4 uv = (a & 1) ? (f32x4){bflo(uw.z), bfhi(uw.z), bflo(uw.w), bfhi(uw.w)} : (f32x4){bflo(uw.x), bfhi(uw.x), bflo(uw.y), bfhi(uw.y)};
                S[a] = S[a] * *(const LAS f32x4*)(lds + SDL_OFF + buf * 512 + (16 * a + 4 * fq) * 4) + uv; }
        }
        LAS unsigned char* ot = lds + SOT_OFF + wave * 4096;
#pragma unroll
        for (int bt = 0; bt < 4; ++bt)
#pragma unroll
            for (int i = 0; i < 4; ++i) *(LAS float*)(ot + (16 * bt + 4 * fq + i) * 64 + fr * 4) = o[bt][i];
        asm volatile("s_waitcnt lgkmcnt(0)" ::: "memory");
        f32x4 orow[2][2];
#pragma unroll
        for (int jj = 0; jj < 2; ++jj) {
            const LAS unsigned char* rp = ot + ((lane >> 1) + 32 * jj) * 64 + (lane & 1) * 32;
            orow[jj][0] = *(const LAS f32x4*)rp; orow[jj][1] = *(const LAS f32x4*)(rp + 16);
            const f32x4 a = orow[jj][0], bb = orow[jj][1];
            float q2s = (a.x * a.x + a.y * a.y) + (a.z * a.z + a.w * a.w) + (bb.x * bb.x + bb.y * bb.y) + (bb.z * bb.z + bb.w * bb.w);
            q2s += __shfl_xor(q2s, 1);
            if ((lane & 1) == 0) *(LAS float*)(lds + SSS_OFF + buf * 2048 + (((lane >> 1) + 32 * jj) * 8 + wave) * 4) = q2s;
        }
        if (c + 1 < SEQ / 64) HS_STOREQ(q1, buf ^ 1);
        HG_BAR();
#pragma unroll
        for (int jj = 0; jj < 2; ++jj) {
            const int t = (lane >> 1) + 32 * jj;
            const LAS float* sp = (const LAS float*)(lds + SSS_OFF + buf * 2048 + t * 32);
            const f32x4 s0 = *(const LAS f32x4*)sp, s1 = *(const LAS f32x4*)(sp + 4);
            const float ssum = (s0.x + s0.y) + (s0.z + s0.w) + (s1.x + s1.y) + (s1.z + s1.w);
            const float rstd = rsq_(ssum * (1.0f / 128.0f) + EPS);
            const u32x4 g = g0[jj];
            const f32x4 y0 = orow[jj][0] * rstd * gn0 * (f32x4){bflo(g.x), bfhi(g.x), bflo(g.y), bfhi(g.y)};
            const f32x4 y1 = orow[jj][1] * rstd * gn1 * (f32x4){bflo(g.z), bfhi(g.z), bflo(g.w), bfhi(g.w)};
            *(u32x4*)(CAT + (rowb + c * 64 + t) * DM + 512 + v0) = (u32x4){pk2(y0.x, y0.y), pk2(y0.z, y0.w), pk2(y1.x, y1.y), pk2(y1.z, y1.w)};
        }
        w0 = w1; w1 = w2; q1 = q2; g0[0] = g1[0]; g0[1] = g1[1];
    }
#undef HS_LOADQ
#undef HS_STOREQ
#undef HS_LOADW
#undef HS_LOADG
}
#undef HG_BAR

DI float rstd_from_ssq(const float* SSQ, int row, int which) {
    const f32x4 a = *(const f32x4*)(SSQ + (size_t)row * 16 + which * 8), b = *(const f32x4*)(SSQ + (size_t)row * 16 + which * 8 + 4);
    const float s = (a.x + a.y) + (a.z + a.w) + (b.x + b.y) + (b.z + b.w);
    return rsq_(s * (1.0f / 512.0f) + EPS);
}
struct EpiQ {
    static constexpr bool PERM = true;
    bf16_t* Q; const float* SSQ; const float* cs;
    DI void operator()(const f32x4 (&acc)[2][2][4][2], const g8::Unit& u, int wr, int wc, int fr, int fq) const {
        const int row0 = u.pm * 256 + wr * 64 + fr, col0 = u.pn * 256 + wc * 32 + 8 * fq;
#pragma unroll
        for (int ai = 0; ai < 2; ++ai)
#pragma unroll
            for (int m = 0; m < 4; ++m) {
                const int row = row0 + ai * 128 + m * 16; const float sc = rstd_from_ssq(SSQ, row, 0) * QSCALE;
#pragma unroll
                for (int bj = 0; bj < 2; ++bj) {
                    const int col = col0 + bj * 128, cc = col % 192;
                    float v[8];
#pragma unroll
                    for (int i = 0; i < 4; ++i) { v[i] = acc[ai][bj][m][0][i] * sc; v[4 + i] = acc[ai][bj][m][1][i] * sc; }
                    if (cc >= 128) {
                        const int j0 = (cc - 128) >> 1;
                        const f32x4 c = *(const f32x4*)(cs + (size_t)row * 32 + j0), s = *(const f32x4*)(cs + (size_t)NT * 32 + (size_t)row * 32 + j0);
#pragma unroll
                        for (int i = 0; i < 4; ++i) { const float x1 = v[2 * i], x2 = v[2 * i + 1]; v[2 * i] = x1 * c[i] - x2 * s[i]; v[2 * i + 1] = x2 * c[i] + x1 * s[i]; }
                    }
                    u32x4 w; w.x = pk2(v[0], v[1]); w.y = pk2(v[2], v[3]); w.z = pk2(v[4], v[5]); w.w = pk2(v[6], v[7]);
                    *(u32x4*)(Q + (size_t)row * 1536 + col) = w;
                }
            }
    }
};
struct EpiK {
    static constexpr bool PERM = true;
    bf16_t* KN; const float* SSQ;
    DI void operator()(const f32x4 (&acc)[2][2][4][2], const g8::Unit& u, int wr, int wc, int fr, int fq) const {
        const int row0 = u.pm * 256 + wr * 64 + fr, col0 = u.pn * 256 + wc * 32 + 8 * fq;
#pragma unroll
        for (int ai = 0; ai < 2; ++ai)
#pragma unroll
            for (int m = 0; m < 4; ++m) {
                const int row = row0 + ai * 128 + m * 16; const float sc = rstd_from_ssq(SSQ, row, 1);
#pragma unroll
                for (int bj = 0; bj < 2; ++bj) {
                    const f32x4 v0 = acc[ai][bj][m][0] * sc, v1 = acc[ai][bj][m][1] * sc;
                    u32x4 w; w.x = pk2(v0[0], v0[1]); w.y = pk2(v0[2], v0[3]); w.z = pk2(v1[0], v1[1]); w.w = pk2(v1[2], v1[3]);
                    *(u32x4*)(KN + (size_t)row * 1024 + col0 + bj * 128) = w;
                }
            }
    }
};
struct EpiVT {
    static constexpr bool PERM = true;
    bf16_t* VT; const float* SSQ;
    DI void operator()(const f32x4 (&acc)[2][2][4][2], const g8::Unit& u, int wr, int wc, int fr, int fq) const {
        const int row0 = u.pm * 256 + wr * 64 + fr, col0 = u.pn * 256 + wc * 32 + 8 * fq;
        float sc[2][8];
#pragma unroll
        for (int bj = 0; bj < 2; ++bj)
#pragma unroll
            for (int i = 0; i < 8; ++i) sc[bj][i] = rstd_from_ssq(SSQ, col0 + bj * 128 + i, 1);
#pragma unroll
        for (int ai = 0; ai < 2; ++ai)
#pragma unroll
            for (int m = 0; m < 4; ++m) {
                const int row = row0 + ai * 128 + m * 16, h = row >> 7, d = row & 127;
#pragma unroll
                for (int bj = 0; bj < 2; ++bj) {
                    const int tok = col0 + bj * 128, b = tok >> 12, s = tok & 4095;
                    const f32x4 a0 = acc[ai][bj][m][0], a1 = acc[ai][bj][m][1];
                    u32x4 w; w.x = pk2(a0[0] * sc[bj][0], a0[1] * sc[bj][1]); w.y = pk2(a0[2] * sc[bj][2], a0[3] * sc[bj][3]);
                    w.z = pk2(a1[0] * sc[bj][4], a1[1] * sc[bj][5]); w.w = pk2(a1[2] * sc[bj][6], a1[3] * sc[bj][7]);
                    *(u32x4*)(VT + ((size_t)((b * 8 + h) * 128 + d)) * SEQ + s) = w;
                }
            }
    }
};
DI void phase_mla_proj(const Params& p, LAS unsigned char* lds, int bid, int G, int l) {
    unsigned char* ws = ows(p);
    const float* SSQ = (const float*)(ws + WS_SSQ); const bf16_t* HB = (const bf16_t*)(ws + WS_HB);
    {
        g8::StaticSched S; S.init(HB + 3072, (const bf16_t*)(ws + WS_WUQ) + (size_t)l * 1536 * 512, NT, 1536, 4096, 512, G, bid);
        EpiQ E{(bf16_t*)(ws + WS_Q), SSQ, (const float*)(ws + WS_COS)};
        g8::gemm_phase<EpiQ, g8::StaticSched, false>(lds, 512, 4096, 512, S, E);
    }
    {
        g8::StaticSched S; S.init(HB + 3584, (const bf16_t*)(ws + WS_WUK) + (size_t)l * 1024 * 512, NT, 1024, 4096, 512, G, bid);
        EpiK E{(bf16_t*)(ws + WS_KN), SSQ};
        g8::gemm_phase<EpiK, g8::StaticSched, false>(lds, 512, 4096, 512, S, E);
    }
    {
        g8::StaticSched S; S.init((const bf16_t*)(ws + WS_WUV) + (size_t)l * 1024 * 512, HB + 3584, 1024, NT, 512, 4096, G, bid);
        EpiVT E{(bf16_t*)(ws + WS_VT), SSQ};
        g8::gemm_phase<EpiVT, g8::StaticSched, false>(lds, 512, 512, 4096, S, E);
    }
}

constexpr int AT_KS = 400, AT_VS = 144;
constexpr int AT_KBUF = 64 * AT_KS, AT_VBUF = 128 * AT_VS;
DI void attn_unit(const bf16_t* Qg, const bf16_t* KNg, const bf16_t* KRg, const bf16_t* VTg, bf16_t* CAT, LAS unsigned char* lds, int b, int h, int qb) {
    const int tid = otid(), lane = tid & 63, wave = __builtin_amdgcn_readfirstlane(tid >> 6), c = lane & 31, hi = lane >> 5;
    const int q0 = qb * 256, qmin = q0 + 32 * wave, qrow = qmin + c, ntile = 4 * (qb + 1), jmax = (qmin + 31) >> 6;
    LAS unsigned char* Kb = lds; LAS unsigned char* Vb = lds + 2 * AT_KBUF;
    bf16x8 qf[12];
    { const bf16_t* qp = Qg + (size_t)(b * SEQ + qrow) * 1536 + h * 192 + 8 * hi;
#pragma unroll
      for (int ks = 0; ks < 12; ++ks) qf[ks] = *(const bf16x8*)(qp + 16 * ks); }
    f32x16 o[4];
#pragma unroll
    for (int d = 0; d < 4; ++d)
#pragma unroll
        for (int r = 0; r < 16; ++r) o[d][r] = 0.f;
    float m_run = -1.0e30f, l_run = 0.f;
    int ksrc_off[3], kdst[3]; bool kfromR[3];
#pragma unroll
    for (int i = 0; i < 3; ++i) { const int id = tid + 512 * i, key = id / 24, cc = id % 24; kdst[i] = key * AT_KS + cc * 16; kfromR[i] = cc >= 16;
        ksrc_off[i] = kfromR[i] ? (key * 64 + 8 * (cc - 16)) : (key * 1024 + h * 128 + 8 * cc); }
    int vsrc_off[2], vdst[2];
#pragma unroll
    for (int i = 0; i < 2; ++i) { const int id = tid + 512 * i, d = id >> 3, cc = id & 7; vdst[i] = d * AT_VS + (cc >> 1) * 32 + (cc & 1) * 8; vsrc_off[i] = d * SEQ + 8 * cc; }
    const bf16_t* KNb = KNg + (size_t)b * SEQ * 1024; const bf16_t* KRb = KRg + (size_t)b * SEQ * 64; const bf16_t* VTb = VTg + (size_t)(b * 8 + h) * 128 * SEQ;
    u32x4 kreg[3], vreg[2];
#define AT_LOAD(j) do { _Pragma("unroll") for (int i = 0; i < 3; ++i) kreg[i] = kfromR[i] ? *(const u32x4*)(KRb + (size_t)(j) * 64 * 64 + ksrc_off[i]) : *(const u32x4*)(KNb + (size_t)(j) * 64 * 1024 + ksrc_off[i]); \
                        _Pragma("unroll") for (int i = 0; i < 2; ++i) vreg[i] = *(const u32x4*)(VTb + (size_t)(j) * 64 + vsrc_off[i]); } while (0)
#define AT_STORE(buf) do { _Pragma("unroll") for (int i = 0; i < 3; ++i) *(LAS u32x4*)(Kb + (buf) * AT_KBUF + kdst[i]) = kreg[i]; \
                           _Pragma("unroll") for (int i = 0; i < 2; ++i) { *(LAS u32x2*)(Vb + (buf) * AT_VBUF + vdst[i]) = (u32x2){vreg[i].x, vreg[i].y}; *(LAS u32x2*)(Vb + (buf) * AT_VBUF + vdst[i] + 16) = (u32x2){vreg[i].z, vreg[i].w}; } } while (0)
    __syncthreads();
    AT_LOAD(0); AT_STORE(0);
    __syncthreads();
    for (int j = 0; j < ntile; ++j) {
        const int buf = j & 1;
        if (j + 1 < ntile) AT_LOAD(j + 1);
        if (j <= jmax) {
            const LAS unsigned char* kb_ = Kb + buf * AT_KBUF + c * AT_KS + 16 * hi;
            f32x16 s0, s1;
#pragma unroll
            for (int r = 0; r < 16; ++r) { s0[r] = 0.f; s1[r] = 0.f; }
#pragma unroll
            for (int ks = 0; ks < 12; ++ks) {
                const bf16x8 a0 = *(const LAS bf16x8*)(kb_ + 32 * ks), a1 = *(const LAS bf16x8*)(kb_ + 32 * AT_KS + 32 * ks);
                s0 = __builtin_amdgcn_mfma_f32_32x32x16_bf16(a0, qf[ks], s0, 0, 0, 0);
                s1 = __builtin_amdgcn_mfma_f32_32x32x16_bf16(a1, qf[ks], s1, 0, 0, 0);
            }
            if (64 * j + 63 > qmin) {
                const int dq = qrow - 64 * j - 4 * hi;
#pragma unroll
                for (int r = 0; r < 16; ++r) { const int kk = (r & 3) + 8 * (r >> 2);
                    if (kk > dq) s0[r] = -__builtin_inff();
                    if (kk + 32 > dq) s1[r] = -__builtin_inff(); }
            }
            float mx = s0[0];
#pragma unroll
            for (int r = 1; r < 16; ++r) mx = fmaxf(mx, s0[r]);
#pragma unroll
            for (int r = 0; r < 16; ++r) mx = fmaxf(mx, s1[r]);
            { auto rr = __builtin_amdgcn_permlane32_swap(__float_as_uint(mx), __float_as_uint(mx), false, false); mx = fmaxf(__uint_as_float(rr[0]), __uint_as_float(rr[1])); }
            if (!__all(mx - m_run <= 8.0f)) {
                const float m_new = fmaxf(m_run, mx), alpha = __builtin_amdgcn_exp2f(m_run - m_new);
                m_run = m_new; l_run *= alpha;
#pragma unroll
                for (int d = 0; d < 4; ++d)
#pragma unroll
                    for (int r = 0; r < 16; ++r) o[d][r] *= alpha;
            }
            float ps = 0.f;
#pragma unroll
            for (int r = 0; r < 16; ++r) { s0[r] = __builtin_amdgcn_exp2f(s0[r] - m_run); s1[r] = __builtin_amdgcn_exp2f(s1[r] - m_run); ps += s0[r] + s1[r]; }
            l_run += ps;
            bf16x8 pb[4];
#pragma unroll
            for (int s2 = 0; s2 < 2; ++s2) {
                u32x4 w0, w1;
                w0.x = pk2(s0[8 * s2 + 0], s0[8 * s2 + 1]); w0.y = pk2(s0[8 * s2 + 2], s0[8 * s2 + 3]); w0.z = pk2(s0[8 * s2 + 4], s0[8 * s2 + 5]); w0.w = pk2(s0[8 * s2 + 6], s0[8 * s2 + 7]);
                w1.x = pk2(s1[8 * s2 + 0], s1[8 * s2 + 1]); w1.y = pk2(s1[8 * s2 + 2], s1[8 * s2 + 3]); w1.z = pk2(s1[8 * s2 + 4], s1[8 * s2 + 5]); w1.w = pk2(s1[8 * s2 + 6], s1[8 * s2 + 7]);
                pb[s2] = __builtin_bit_cast(bf16x8, w0); pb[2 + s2] = __builtin_bit_cast(bf16x8, w1);
            }
            const LAS unsigned char* vb_ = Vb + buf * AT_VBUF + c * AT_VS + 16 * hi;
#pragma unroll
            for (int d = 0; d < 4; ++d)
#pragma unroll
                for (int kk = 0; kk < 4; ++kk) {
                    const bf16x8 av = *(const LAS bf16x8*)(vb_ + d * 32 * AT_VS + kk * 32);
                    o[d] = __builtin_amdgcn_mfma_f32_32x32x16_bf16(av, pb[kk], o[d], 0, 0, 0);
                }
        }
        if (j + 1 < ntile) AT_STORE(buf ^ 1);
        __syncthreads();
    }
#undef AT_LOAD
#undef AT_STORE
    float l_tot; { auto rr = __builtin_amdgcn_permlane32_swap(__float_as_uint(l_run), __float_as_uint(l_run), false, false); l_tot = __uint_as_float(rr[0]) + __uint_as_float(rr[1]); }
    const float inv = rcp_(l_tot);
    bf16_t* op = CAT + (size_t)(b * SEQ + qrow) * DM + 1024 + h * 128 + 4 * hi;
#pragma unroll
    for (int d = 0; d < 4; ++d)
#pragma unroll
        for (int g = 0; g < 4; ++g) {
            const u32x2 w = {pk2(o[d][4 * g] * inv, o[d][4 * g + 1] * inv), pk2(o[d][4 * g + 2] * inv, o[d][4 * g + 3] * inv)};
            *(u32x2*)(op + 32 * d + 8 * g) = w;
        }
}
constexpr int CW_QUEUE = 4096;
constexpr int QWORD_OFF = MOE_LDS_OFF + 2048;
constexpr int KCONV = 10;
DI int q_pop(unsigned* head, LAS unsigned char* lds) {
    __syncthreads();
    if (threadIdx.x == 0) *(LAS unsigned*)(lds + QWORD_OFF) = atomicAdd(head, 1u);
    __syncthreads();
    return __builtin_amdgcn_readfirstlane((int)*(LAS unsigned*)(lds + QWORD_OFF));
}
DI void phase_attn_hgrn(const Params& p, LAS unsigned char* lds, int l) {
    unsigned char* ws0 = ows(p);
    unsigned* qa = (unsigned*)(ws0 + WS_CTL) + CW_QUEUE + (l * 3 + 0) * 8 * 16; unsigned* qc = qa + 8 * 16; unsigned* qr = qc + 8 * 16;
    const int x0 = (int)(__builtin_amdgcn_s_getreg((3 << 11) | 20) & 7u);
    const bool has_conv = l + 1 < DEPTH;
    bool conv_first = false;
    if (has_conv) conv_first = q_pop(qr + x0 * 16, lds) < KCONV;
    for (int pass = 0; pass < 2; ++pass) {
        const bool do_conv = (pass == 0) == conv_first;
        if (do_conv && !has_conv) continue;
        for (int dx = 0; dx < 8; ++dx) {
            const int x = (x0 + dx) & 7;
            if (do_conv) {
                const int ncv = (N_CONV_UNITS - x + 7) / 8;
                for (;;) { const int idx = q_pop(qc + x * 16, lds); if (idx >= ncv) break; conv_unit(p, lds, l + 1, x + 8 * idx); }
            } else {
                for (;;) {
                    const int idx = q_pop(qa + x * 16, lds); if (idx >= 66) break;
                    unsigned char* ws = ows(p);
                    if (idx < 2) { const int bh = 2 * x + idx; hgrn_seq_unit((const bf16_t*)(ws + WS_HB), (const float*)(ws + WS_OH), (const float*)(ws + WS_HU), (const bf16_t*)(ws + WS_HQG), (const float*)(ws + WS_HDL),
                                                                               pinT<false>(p, ws, I_HNORM) + l * 512, (bf16_t*)(ws + WS_CAT), lds, bh >> 2, bh & 3); }
                    else { const int j = idx - 2, bh = 4 * x + (j & 3), qb = 15 - (j >> 2);
                           attn_unit((const bf16_t*)(ws + WS_Q), (const bf16_t*)(ws + WS_KN), (const bf16_t*)(ws + WS_KR), (const bf16_t*)(ws + WS_VT), (bf16_t*)(ws + WS_CAT), lds, bh >> 3, bh & 7, qb); }
                }
            }
        }
    }
}

struct EpiOut {
    static constexpr bool PERM = false;
    const float* xres; const bf16_t* xb; float* Y;
    DI void operator()(const f32x4 (&acc)[2][2][4][2], const g8::Unit& u, int wr, int wc, int fr, int fq) const {
        const int row0 = u.pm * 256 + wr * 64 + fr, col0 = u.pn * 256 + wc * 32 + 4 * fq;
#pragma unroll
        for (int ai = 0; ai < 2; ++ai)
#pragma unroll
            for (int m = 0; m < 4; ++m) {
                const size_t rb = (size_t)(row0 + ai * 128 + m * 16) * DM;
#pragma unroll
                for (int bj = 0; bj < 2; ++bj)
#pragma unroll
                    for (int n = 0; n < 2; ++n) { const int col = col0 + bj * 128 + 16 * n; f32x4 x;
                        if (xres) x = *(const f32x4*)(xres + rb + col); else { const u32x2 r = *(const u32x2*)(xb + rb + col); x = (f32x4){bflo(r.x), bfhi(r.x), bflo(r.y), bfhi(r.y)}; }
                        *(f32x4*)(Y + rb + col) = x * ALPHA + acc[ai][bj][m][n]; }
            }
    }
};
DI void phase_outproj(const Params& p, LAS unsigned char* lds, int bid, int G, int l) {
    unsigned char* ws = ows(p);
    g8::StaticSched S; S.init(ws + WS_CAT, (const bf16_t*)(ws + WS_WOUT) + (size_t)l * DM * DM, NT, DM, DM, DM, G, bid);
    EpiOut E{l == 0 ? pinT<false>(p, ws, I_X) : nullptr, (const bf16_t*)(ws + WS_XB), (float*)(ws + WS_Y)};
    g8::gemm_phase<EpiOut, g8::StaticSched, false>(lds, DM, DM, DM, S, E);
}

constexpr int L1_RS = 8208;
constexpr int L1_PART = 16 * L1_RS, L1_STAT = L1_PART + 8 * 16 * 48 * 4, L1_LG = L1_STAT + 128;
static_assert(L1_LG + 16 * 48 * 4 <= MOE_LDS_OFF, "ln1 LDS map");
DI void phase_ln1_router(const Params& p, LAS unsigned char* lds, int bid, int G, int l) {
    unsigned char* ws = ows(p);
    const int tid = otid(), lane = tid & 63, wave = __builtin_amdgcn_readfirstlane(tid >> 6), fr = lane & 15, fq = lane >> 4;
    float* Y = (float*)(ws + WS_Y); bf16_t* X1B = (bf16_t*)(ws + WS_X1B);
    const float* RW = (const float*)(ws + WS_ROUTW) + (size_t)l * 48 * DM; const float* rc0 = (const float*)(ws + WS_ROUTC) + (l * 2 + 0) * 48; const float* rc1 = rc0 + 48;
    unsigned* cnt = (unsigned*)(ws + WS_CTL) + CW_CNT + l * 32 * 16;
    int* TOK = (int*)(ws + WS_TOK); int* ROUTE = (int*)(ws + WS_ROUTE);
    const f32x4 gg = *(const f32x4*)(pinT<false>(p, ws, I_LN1G) + l * DM + 4 * tid), bb = *(const f32x4*)(pinT<false>(p, ws, I_LN1B) + l * DM + 4 * tid);
    LAS float* PART = (LAS float*)(lds + L1_PART); LAS float* STAT = (LAS float*)(lds + L1_STAT); LAS float* LG = (LAS float*)(lds + L1_LG);
    for (int task = bid; task < NT / 16; task += G) {
        const int r0 = task * 16;
        f32x4 xr[16], wbuf[8][3];
        const float* wp = RW + (size_t)fr * DM + 256 * wave + 4 * fq;
        asm volatile("" : "+v"(wp));
#pragma unroll
        for (int s2 = 0; s2 < 8; ++s2)
#pragma unroll
            for (int n = 0; n < 3; ++n) wbuf[s2][n] = *(const f32x4*)(wp + (size_t)(16 * n) * DM + 16 * s2);
#pragma unroll
        for (int i = 0; i < 16; ++i) xr[i] = *(const f32x4*)(Y + (size_t)(r0 + i) * DM + 4 * tid);
        __syncthreads();
#pragma unroll
        for (int i = 0; i < 16; ++i) *(LAS f32x4*)(lds + i * L1_RS + tid * 16) = xr[i];
        __syncthreads();
#pragma unroll
        for (int rr = 0; rr < 2; ++rr) {
            const int row = 2 * wave + rr; float sm = 0.f, sq = 0.f;
#pragma unroll
            for (int j = 0; j < 8; ++j) { const f32x4 v = *(const LAS f32x4*)(lds + row * L1_RS + (4 * lane + 256 * j) * 4); sm += (v.x + v.y) + (v.z + v.w); sq += (v.x * v.x + v.y * v.y) + (v.z * v.z + v.w * v.w); }
            sm = wave_sum(sm); sq = wave_sum(sq);
            const float mean = sm * (1.0f / DM), var = fmaxf(sq * (1.0f / DM) - mean * mean, 0.f);
            if (lane == 0) { STAT[2 * row] = mean; STAT[2 * row + 1] = rsq_(var + EPS); }
        }
        f32x4 acc[3];
#pragma unroll
        for (int n = 0; n < 3; ++n) acc[n] = (f32x4){0.f, 0.f, 0.f, 0.f};
        const LAS unsigned char* ap = lds + fr * L1_RS + (256 * wave + 4 * fq) * 4;
#pragma unroll
        for (int hf = 0; hf < 2; ++hf) {
            if (hf == 1) {
#pragma unroll
                for (int s2 = 0; s2 < 8; ++s2)
#pragma unroll
                    for (int n = 0; n < 3; ++n) wbuf[s2][n] = *(const f32x4*)(wp + (size_t)(16 * n) * DM + 16 * (8 + s2));
            }
#pragma unroll
            for (int s2 = 0; s2 < 8; ++s2) {
                const f32x4 xa = *(const LAS f32x4*)(ap + 64 * (8 * hf + s2));
#pragma unroll
                for (int n = 0; n < 3; ++n)
#pragma unroll
                    for (int i = 0; i < 4; ++i) acc[n] = __builtin_amdgcn_mfma_f32_16x16x4f32(xa[i], wbuf[s2][n][i], acc[n], 0, 0, 0);
            }
        }
#pragma unroll
        for (int n = 0; n < 3; ++n)
#pragma unroll
            for (int i = 0; i < 4; ++i) PART[(wave * 16 + 4 * fq + i) * 48 + 16 * n + fr] = acc[n][i];
        __syncthreads();
#pragma unroll
        for (int rep = 0; rep < 2; ++rep) {
            const int pp = tid + 512 * rep;
            if (pp < 768) { const int row = pp / 48, col = pp % 48; float sacc = 0.f;
#pragma unroll
                for (int w = 0; w < 8; ++w) sacc += PART[(w * 16 + row) * 48 + col];
                LG[pp] = STAT[2 * row + 1] * (sacc - STAT[2 * row] * rc1[col]) + rc0[col]; }
        }
        __syncthreads();
        if (tid < 16) {
            const LAS float* L = LG + tid * 48; const int token = r0 + tid;
            float gm = L[0]; int gi = 0;
#pragma unroll
            for (int j = 1; j < 4; ++j) if (L[j] > gm) { gm = L[j]; gi = j; }
            float gs = 0.f;
#pragma unroll
            for (int j = 0; j < 4; ++j) gs += expf(L[j] - gm);
            const float gval = 1.0f / gs;
            const LAS float* E = L + 4 + gi * 8;
            float v1 = E[0]; int i1 = 0;
#pragma unroll
            for (int j = 1; j < 8; ++j) if (E[j] > v1) { v1 = E[j]; i1 = j; }
            float v2 = -3.0e38f; int i2 = 0;
#pragma unroll
            for (int j = 0; j < 8; ++j) if (j != i1 && E[j] > v2) { v2 = E[j]; i2 = j; }
            const float ex = expf(v2 - v1), p1 = 1.0f / (1.0f + ex), p2 = ex / (1.0f + ex);
            const int e0 = gi * 8 + i1, e1 = gi * 8 + i2;
            const int pos0 = (int)atomicAdd(cnt + e0 * 16, 1u), pos1 = (int)atomicAdd(cnt + e1 * 16, 1u);
            TOK[(size_t)e0 * NT + pos0] = token; TOK[(size_t)e1 * NT + pos1] = token;
            int* rp = ROUTE + (size_t)token * 8;
            rp[0] = e0; rp[1] = pos0; rp[2] = e1; rp[3] = pos1; rp[4] = __float_as_int(gval * p1); rp[5] = __float_as_int(gval * p2);
        }
#pragma unroll
        for (int i = 0; i < 16; ++i) {
            const float mean = STAT[2 * i], rstd = STAT[2 * i + 1];
            const f32x4 xv = *(const LAS f32x4*)(lds + i * L1_RS + tid * 16);
            const f32x4 y = (xv - mean) * rstd * gg + bb;
            *(u32x2*)(X1B + (size_t)(r0 + i) * DM + 4 * tid) = (u32x2){pk2(y.x, y.y), pk2(y.z, y.w)};
        }
    }
}

DI void moe_tables(const Params& p, LAS unsigned char* lds, int l) {
    LAS int* mc = (LAS int*)(lds + MOE_LDS_OFF); LAS int* mp = mc + 32;
    __syncthreads();
    if (threadIdx.x == 0) {
        const unsigned* cnt = (const unsigned*)(ows(p) + WS_CTL) + CW_CNT + l * 32 * 16; int acc = 0;
        for (int e = 0; e < 32; ++e) { int c = (int)__hip_atomic_load(cnt + e * 16, __ATOMIC_RELAXED, __HIP_MEMORY_SCOPE_AGENT); if (c > NT) c = NT; mc[e] = c; mp[e] = acc; acc += (c + 255) >> 8; }
        mp[32] = acc;
    }
    __syncthreads();
}
template <int NCT_SHIFT> struct MoeSched {
    const char* A; const char* Bt; const int* TOK; LAS const int* mc; LAS const int* mp; size_t bexp, btile, atile; int G, c;
    DI bool next(int i, g8::Unit& u) const {
        int rt, ct, e = 0;
        if (G == 256) {
            const int x = c & 7, slot = c >> 3, t0 = mp[4 * x], nt = mp[4 * x + 4] - t0, L = i * 32 + slot;
            if (L >= (nt << NCT_SHIFT)) return false;
            rt = t0 + (L >> NCT_SHIFT); ct = L & ((1 << NCT_SHIFT) - 1);
            e = 4 * x;
            for (int j = 4 * x + 1; j < 4 * x + 4; ++j) if (mp[j] <= rt) e = j;
        } else {
            const int L = i * G + c, T = mp[32]; if (L >= (T << NCT_SHIFT)) return false;
            rt = L >> NCT_SHIFT; ct = L & ((1 << NCT_SHIFT) - 1);
            for (int j = 1; j < 32; ++j) if (mp[j] <= rt) e = j;
        }
        u.pm = rt; u.pn = ct; u.x0 = e; u.x1 = rt - mp[e];
        u.a = A + (size_t)rt * atile; u.b = Bt + (size_t)e * bexp + (size_t)ct * btile; return true;
    }
    DI int tok(const g8::Unit& u, int R) const { const int idx = u.x1 * 256 + R; return idx < mc[u.x0] ? TOK[(size_t)u.x0 * NT + idx] : 0; }
};
struct EpiMoe1 {
    static constexpr bool PERM = true;
    bf16_t* HM;
    DI void operator()(const f32x4 (&acc)[2][2][4][2], const g8::Unit& u, int wr, int wc, int fr, int fq) const {
        const int row0 = u.pm * 256 + wr * 64 + fr, col0 = u.pn * 128 + wc * 32 + 8 * fq;
#pragma unroll
        for (int ai = 0; ai < 2; ++ai)
#pragma unroll
            for (int m = 0; m < 4; ++m) {
                float v[8];
#pragma unroll
                for (int i = 0; i < 4; ++i) { v[i] = siluf_(acc[ai][0][m][0][i]) * acc[ai][1][m][0][i]; v[4 + i] = siluf_(acc[ai][0][m][1][i]) * acc[ai][1][m][1][i]; }
                u32x4 w; w.x = pk2(v[0], v[1]); w.y = pk2(v[2], v[3]); w.z = pk2(v[4], v[5]); w.w = pk2(v[6], v[7]);
                *(u32x4*)(HM + (size_t)(row0 + ai * 128 + m * 16) * DEXP + col0) = w;
            }
    }
};
struct EpiMoe2 {
    static constexpr bool PERM = true;
    bf16_t* YB;
    DI void operator()(const f32x4 (&acc)[2][2][4][2], const g8::Unit& u, int wr, int wc, int fr, int fq) const {
        const int row0 = u.pm * 256 + wr * 64 + fr, col0 = u.pn * 256 + wc * 32 + 8 * fq;
#pragma unroll
        for (int ai = 0; ai < 2; ++ai)
#pragma unroll
            for (int m = 0; m < 4; ++m)
#pragma unroll
                for (int bj = 0; bj < 2; ++bj) {
                    const f32x4 v0 = acc[ai][bj][m][0], v1 = acc[ai][bj][m][1];
                    u32x4 w; w.x = pk2(v0[0], v0[1]); w.y = pk2(v0[2], v0[3]); w.z = pk2(v1[0], v1[1]); w.w = pk2(v1[2], v1[3]);
                    *(u32x4*)(YB + (size_t)(row0 + ai * 128 + m * 16) * DM + col0 + bj * 128) = w;
                }
    }
};
DI void phase_moe1(const Params& p, LAS unsigned char* lds, int bid, int G, int l) {
    unsigned char* ws = ows(p);
    moe_tables(p, lds, l);
    MoeSched<2> S{(const char*)(ws + WS_X1B), (const char*)(ws + WS_WGU) + (size_t)l * NEXP * 1024 * DM * 2, (const int*)(ws + WS_TOK), (LAS const int*)(lds + MOE_LDS_OFF), (LAS const int*)(lds + MOE_LDS_OFF) + 32,
                  (size_t)1024 * DM * 2, (size_t)256 * DM * 2, 0, G, bid};
    EpiMoe1 E{(bf16_t*)(ws + WS_HM)};
    g8::gemm_phase<EpiMoe1, MoeSched<2>, true>(lds, DM, DM, DM, S, E);
}
DI void phase_moe2(const Params& p, LAS unsigned char* lds, int bid, int G, int l) {
    unsigned char* ws = ows(p);
    moe_tables(p, lds, l);
    MoeSched<3> S{(const char*)(ws + WS_HM), (const char*)(ws + WS_WD) + (size_t)l * NEXP * DM * DEXP * 2, nullptr, (LAS const int*)(lds + MOE_LDS_OFF), (LAS const int*)(lds + MOE_LDS_OFF) + 32,
                  (size_t)DM * DEXP * 2, (size_t)256 * DEXP * 2, (size_t)256 * DEXP * 2, G, bid};
    EpiMoe2 E{(bf16_t*)(ws + WS_YB)};
    g8::gemm_phase<EpiMoe2, MoeSched<3>, false>(lds, DEXP, DEXP, DEXP, S, E);
}

DI void phase_ln2(const Params& p, LAS unsigned char* lds, int bid, int G, int l) {
    unsigned char* ws = ows(p);
    moe_tables(p, lds, l);
    LAS const int* mp = (LAS const int*)(lds + MOE_LDS_OFF) + 32;
    const int tid = otid(), lane = tid & 63, wave = tid >> 6;
    const bf16_t* X1B = (const bf16_t*)(ws + WS_X1B); const bf16_t* YB = (const bf16_t*)(ws + WS_YB); const int* ROUTE = (const int*)(ws + WS_ROUTE);
    const float* g = pinT<false>(p, ws, I_LN2G) + l * DM; const float* bt = pinT<false>(p, ws, I_LN2B) + l * DM;
    float* out = p.out; bf16_t* XB = (bf16_t*)(ws + WS_XB);
    for (int row = bid * 8 + wave; row < NT; row += G * 8) {
        const int* rp = ROUTE + (size_t)row * 8;
        const int e0 = rp[0], pos0 = rp[1], e1 = rp[2], pos1 = rp[3]; const float g0 = __int_as_float(rp[4]), g1 = __int_as_float(rp[5]);
        const size_t s0 = (size_t)(256 * mp[e0] + pos0), s1 = (size_t)(256 * mp[e1] + pos1);
        f32x4 v[8]; float sm = 0.f;
#pragma unroll
        for (int j = 0; j < 8; ++j) {
            const int col = 4 * lane + 256 * j;
            const u32x2 xr_ = *(const u32x2*)(X1B + (size_t)row * DM + col); const f32x4 x = {bflo(xr_.x), bfhi(xr_.x), bflo(xr_.y), bfhi(xr_.y)};
            const u32x2 a = *(const u32x2*)(YB + s0 * DM + col), b = *(const u32x2*)(YB + s1 * DM + col);
            const f32x4 ya = {bflo(a.x), bfhi(a.x), bflo(a.y), bfhi(a.y)}, yb = {bflo(b.x), bfhi(b.x), bflo(b.y), bfhi(b.y)};
            v[j] = x * ALPHA + (ya * g0 + yb * g1);
            sm += (v[j].x + v[j].y) + (v[j].z + v[j].w);
        }
        const float mean = wave_sum(sm) * (1.0f / DM); float sq = 0.f;
#pragma unroll
        for (int j = 0; j < 8; ++j) { v[j] = v[j] - mean; sq += (v[j].x * v[j].x + v[j].y * v[j].y) + (v[j].z * v[j].z + v[j].w * v[j].w); }
        const float rstd = rsq_(wave_sum(sq) * (1.0f / DM) + EPS);
#pragma unroll
        for (int j = 0; j < 8; ++j) {
            const int col = 4 * lane + 256 * j;
            const f32x4 y = v[j] * rstd * *(const f32x4*)(g + col) + *(const f32x4*)(bt + col);
            if (l == DEPTH - 1) *(f32x4*)(out + (size_t)row * DM + col) = y;
            else *(u32x2*)(XB + (size_t)row * DM + col) = (u32x2){pk2(y.x, y.y), pk2(y.z, y.w)};
        }
    }
}


#define GAS __attribute__((address_space(1)))
typedef GAS unsigned gu32;
#define XB_TMO      128
#define XB_XCNT(j)  (256  + 64 * (j))
#define XB_XSUB(j)  (1280 + 64 * (j))
#define XB_XGEN(j)  (2304 + 64 * (j))
#define XB_TOP      3328
#define XB_TOPGEN   3392
#define XCD_BAR_WORDS 3456
#define XB_SPIN_CAP (1u << 18)

__device__ __forceinline__ unsigned xb_ld(unsigned* p)              { return __hip_atomic_load(p, __ATOMIC_RELAXED, __HIP_MEMORY_SCOPE_AGENT); }
__device__ __forceinline__ unsigned xb_add(unsigned* p, unsigned v) { return __hip_atomic_fetch_add(p, v, __ATOMIC_RELAXED, __HIP_MEMORY_SCOPE_AGENT); }
__device__ __forceinline__ unsigned xb_xcc_id() { return (unsigned)__builtin_amdgcn_s_getreg((3 << 11) | 20) & 0xFu; }
#define XB_SPIN(cond, bar) do { unsigned _sp = 0; while (cond) { __builtin_amdgcn_s_sleep(1); \
    if ((++_sp & 255u) == 0u) { if (xb_ld(&(bar)[XB_TMO])) break; if (_sp > XB_SPIN_CAP) { atomicAdd(&(bar)[XB_TMO], 1u); break; } } } } while (0)

struct XcdBarrier {
    unsigned* bar; unsigned x;
    volatile LAS unsigned* st;
};

__device__ __forceinline__ XcdBarrier xcd_barrier_post(unsigned* bar, volatile LAS unsigned* st) {
    XcdBarrier b; b.bar = bar; b.x = xb_xcc_id(); b.st = st;
    if (threadIdx.x == 0) (void)xb_add(&bar[XB_XCNT(b.x)], 1u);
    return b;
}
__device__ __forceinline__ void xcd_barrier_complete(unsigned* bar, unsigned x, unsigned& nloc, unsigned& nx) {
    const unsigned G = gridDim.x * gridDim.y * gridDim.z;
    unsigned sum, cnt, mine, sp = 0u;
    for (;;) {
        sum = 0u; cnt = 0u; mine = 0u;
#pragma unroll
        for (unsigned j = 0; j < 16; ++j) { const unsigned c = xb_ld(&bar[XB_XCNT(j)]); sum += c; cnt += (c > 0u) ? 1u : 0u; mine = (j == x) ? c : mine; }
        if (sum == G) break;
        __builtin_amdgcn_s_sleep(1);
        if ((++sp & 255u) == 0u) { if (xb_ld(&bar[XB_TMO])) break; if (sp > XB_SPIN_CAP) { atomicAdd(&bar[XB_TMO], 1u); break; } }
    }
    nloc = mine > 0u ? mine : 1u; nx = cnt > 0u ? cnt : 1u;
}

__device__ __forceinline__ void xcd_barrier(const XcdBarrier& b) {
    __attribute__((address_space(1))) unsigned* barp = (__attribute__((address_space(1))) unsigned*)b.bar; asm volatile("" : "+s"(barp));
    asm volatile("s_waitcnt vmcnt(0)" ::: "memory");
    __syncthreads();
    if (threadIdx.x == 0) {
        unsigned* bar = (unsigned*)barp;
        __builtin_amdgcn_s_waitcnt(0);
        unsigned nloc = b.st[0], nx = b.st[1];
        if (nloc == 0u) { xcd_barrier_complete(bar, xb_xcc_id(), nloc, nx); b.st[0] = nloc; b.st[1] = nx; }
        const unsigned bx = xb_xcc_id();
        const unsigned old = xb_add(&bar[XB_XSUB(bx)], 1u);
        const unsigned gen = old / nloc;
        if (old + 1u == (gen + 1u) * nloc) {
            __builtin_amdgcn_fence(__ATOMIC_RELEASE, "agent");
            asm volatile("s_waitcnt vmcnt(0)" ::: "memory");
            const unsigned og = xb_add(&bar[XB_TOP], 1u);
            const unsigned tg = og / nx;
            if (og + 1u == (tg + 1u) * nx) xb_add(&bar[XB_TOPGEN], 1u);
            else XB_SPIN(xb_ld(&bar[XB_TOPGEN]) == tg, bar);
            __builtin_amdgcn_fence(__ATOMIC_ACQUIRE, "agent");
            xb_add(&bar[XB_XGEN(bx)], 1u);
            asm volatile("s_waitcnt vmcnt(0)" ::: "memory");
        } else {
            XB_SPIN(xb_ld(&bar[XB_XGEN(bx)]) == gen, bar);
            __builtin_amdgcn_fence(__ATOMIC_ACQUIRE, "agent");
            asm volatile("s_waitcnt vmcnt(0)" ::: "memory");
        }
    }
    __syncthreads();
}


constexpr int BARST_OFF = MOE_LDS_OFF + 1024;
#ifndef REP_KS
#define REP_KS 1
#endif
#ifndef REP_LN2
#define REP_LN2 1
#endif
#ifndef REP_INP
#define REP_INP 1
#endif
#ifndef REP_MOE1
#define REP_MOE1 1
#endif
__global__ void __launch_bounds__(NTHR, 2) mega_fwd(Params p) {
    extern __shared__ __attribute__((aligned(16))) unsigned char lds_[];
    LAS unsigned char* lds = (LAS unsigned char*)lds_;
    const int bid0 = blockIdx.x, G0 = gridDim.x;
    if (threadIdx.x == 0) *(LAS u32x4*)(lds + BARST_OFF) = (u32x4){0u, 0u, 0u, 0u};
    __syncthreads();
    XcdBarrier bar = xcd_barrier_post((unsigned*)(p.ws + WS_CTL) + CW_BAR, (volatile LAS unsigned*)(lds + BARST_OFF));
#define OPQ() do { bid = bid0; G = G0; asm volatile("" : "+s"(bid), "+s"(G)); } while (0)
    int bid, G; OPQ();
    phase_prologue(p, lds, bid, G);
    xcd_barrier(bar);
    for (int l = 0; l < DEPTH; ++l) {
        for (int r_ = 0; r_ < REP_INP; ++r_) { OPQ(); phase_inproj(p, lds, bid, G, l); }
        xcd_barrier(bar);
        for (int r_ = 0; r_ < REP_KS; ++r_) { OPQ(); phase_krope(p, lds, bid, G, l);
        OPQ(); phase_sgu(p, lds, bid, G, l);
        OPQ(); phase_hgrn_local(p, lds, bid, G, l); }
        __syncthreads();
        OPQ(); phase_mla_proj(p, lds, bid, G, l);
        xcd_barrier(bar);
        OPQ(); phase_attn_hgrn(p, lds, l);
        xcd_barrier(bar);
        OPQ(); phase_outproj(p, lds, bid, G, l);
        xcd_barrier(bar);
        OPQ(); phase_ln1_router(p, lds, bid, G, l);
        xcd_barrier(bar);
        for (int r_ = 0; r_ < REP_MOE1; ++r_) { OPQ(); phase_moe1(p, lds, bid, G, l); }
        xcd_barrier(bar);
        OPQ(); phase_moe2(p, lds, bid, G, l);
        xcd_barrier(bar);
        for (int r_ = 0; r_ < REP_LN2; ++r_) { OPQ(); phase_ln2(p, lds, bid, G, l); }
        xcd_barrier(bar);
    }
#undef OPQ
}

extern "C" void kernel_launch(void* const* d_in, const int* in_sizes, int n_in, void* d_out, int out_size, void* d_ws, size_t ws_size, hipStream_t stream) {
    static int grid = 0;
    if (grid == 0) {
        if (n_in != 25 || out_size != NT * DM || ws_size < WS_END) { fprintf(stderr, "kernel_launch: unexpected sizes n_in %d out %d ws %zu (need %zu)\n", n_in, out_size, ws_size, (size_t)WS_END); grid = -1; return; }
        int dev = 0, cus = 0, per_cu = 0;
        if (hipGetDevice(&dev) != hipSuccess || hipDeviceGetAttribute(&cus, hipDeviceAttributeMultiprocessorCount, dev) != hipSuccess) { grid = -1; return; }
        if (hipFuncSetAttribute((const void*)mega_fwd, hipFuncAttributeMaxDynamicSharedMemorySize, LDS_BYTES) != hipSuccess) { fprintf(stderr, "kernel_launch: hipFuncSetAttribute failed\n"); grid = -1; return; }
        if (hipOccupancyMaxActiveBlocksPerMultiprocessor(&per_cu, (const void*)mega_fwd, NTHR, LDS_BYTES) != hipSuccess || per_cu < 1) { fprintf(stderr, "kernel_launch: occupancy query says %d blocks per CU\n", per_cu); (void)hipGetLastError(); grid = -1; return; }
        grid = cus;
    }
    if (grid < 0) return;
    (void)hipMemsetAsync((char*)d_ws + WS_CTL, 0, CTL_BYTES, stream);
    Params p{};
    for (int i = 0; i < 25; ++i) p.in[i] = (const float*)d_in[i];
    p.out = (float*)d_out; p.ws = (unsigned char*)d_ws; p.layer = 0; p.pad = 0;
    hipLaunchKernelGGL(mega_fwd, dim3(grid), dim3(NTHR), LDS_BYTES, stream, p);
}
```

```cpp
#include <hip/hip_runtime.h>
#include <cstdio>
#include <cstdint>

#define DI __device__ __forceinline__
#define LAS __attribute__((address_space(3)))
typedef unsigned short bf16_t;
typedef short bf16x8 __attribute__((ext_vector_type(8)));
typedef short s16x4 __attribute__((ext_vector_type(4)));
typedef float f32x2 __attribute__((ext_vector_type(2)));
typedef float f32x4 __attribute__((ext_vector_type(4)));
typedef float f32x16 __attribute__((ext_vector_type(16)));
typedef unsigned u32x2 __attribute__((ext_vector_type(2)));
typedef unsigned u32x4 __attribute__((ext_vector_type(4)));
typedef __bf16 bf2_t __attribute__((ext_vector_type(2)));

constexpr int DM = 2048, BATCH = 4, SEQ = 4096, NT = BATCH * SEQ, DEPTH = 4;
constexpr int DIN = 4160, DIN_MAIN = 4096;
constexpr int NEXP = 32, DEXP = 512;
constexpr int MAXSLOT = 40960;
constexpr float ALPHA = 1.681792830507429f;
constexpr float EPS = 1e-5f;
constexpr float QSCALE = 0.07216878364870323f * 1.4426950408889634f;

constexpr size_t MiB = 1u << 20;
constexpr size_t al(size_t x) { return (x + MiB - 1) / MiB * MiB; }
constexpr size_t WS_CTL = 0, CTL_BYTES = 1 * MiB;
constexpr size_t WS_WIN = WS_CTL + CTL_BYTES;
constexpr size_t WS_WUQ = WS_WIN + al((size_t)DEPTH * DIN * DM * 2);
constexpr size_t WS_WUK = WS_WUQ + al((size_t)DEPTH * 1536 * 512 * 2);
constexpr size_t WS_WUV = WS_WUK + al((size_t)DEPTH * 1024 * 512 * 2);
constexpr size_t WS_WOUT = WS_WUV + al((size_t)DEPTH * 1024 * 512 * 2);
constexpr size_t WS_WGU = WS_WOUT + al((size_t)DEPTH * DM * DM * 2);
constexpr size_t WS_WD = WS_WGU + al((size_t)DEPTH * NEXP * 1024 * DM * 2);
constexpr size_t WS_SGUW = WS_WD + al((size_t)DEPTH * NEXP * DM * DEXP * 2);
constexpr size_t WS_ROUTW = WS_SGUW + al((size_t)DEPTH * 4 * 128 * 128 * 2);
constexpr size_t WS_ROUTC = WS_ROUTW + al((size_t)DEPTH * 48 * DM * 4);
constexpr size_t WS_LB = WS_ROUTC + MiB;
constexpr size_t WS_COS = WS_LB + MiB;
constexpr size_t WS_XB = WS_COS + al((size_t)NT * 64 * 4);
constexpr size_t WS_Y = WS_XB + al((size_t)NT * DM * 2);
constexpr size_t WS_X1B = WS_Y + al((size_t)NT * DM * 4);
constexpr size_t WS_HB = WS_X1B + al((size_t)NT * DM * 2);
constexpr size_t WS_LOGF = WS_HB + al((size_t)NT * 4096 * 2);
constexpr size_t WS_KR = WS_LOGF + al((size_t)NT * 512 * 4);
constexpr size_t WS_SSQ = WS_KR + al((size_t)NT * 64 * 2);
constexpr size_t WS_Q = WS_SSQ + al((size_t)NT * 16 * 4);
constexpr size_t WS_KN = WS_Q + al((size_t)NT * 1536 * 2);
constexpr size_t WS_VT = WS_KN + al((size_t)NT * 1024 * 2);
constexpr size_t WS_OH = WS_VT + al((size_t)NT * 1024 * 2);
constexpr size_t WS_CAT = WS_OH + al((size_t)NT * 512 * 4);
constexpr size_t WS_ROUTE = WS_CAT + al((size_t)NT * DM * 2);
constexpr size_t WS_TOK = WS_ROUTE + al((size_t)NT * 8 * 4);
constexpr size_t WS_HM = WS_TOK + al((size_t)NEXP * NT * 4);
constexpr size_t WS_YB = WS_HM + al((size_t)MAXSLOT * DEXP * 2);
constexpr size_t WS_HU = WS_YB + al((size_t)MAXSLOT * DM * 2);
constexpr size_t WS_HQG = WS_HU + al((size_t)1024 * 65536);
constexpr size_t WS_HDL = WS_HQG + al((size_t)1024 * 16384);
constexpr size_t WS_END = WS_HDL + al((size_t)1024 * 512);

constexpr int CW_TMO = 0;
constexpr int CW_CNT = 1024;
constexpr int CW_BAR = 8192;

constexpr int MOE_LDS_OFF = 159744;
constexpr int LDS_BYTES = 163840;
constexpr int NTHR = 512;

DI unsigned pk2(float lo, float hi) { bf2_t b = __builtin_convertvector((f32x2){lo, hi}, bf2_t); return __builtin_bit_cast(unsigned, b); }
DI bf16_t f2bf(float f) { return (bf16_t)(pk2(f, 0.f) & 0xffffu); }
DI float bflo(unsigned u) { return __uint_as_float(u << 16); }
DI float bfhi(unsigned u) { return __uint_as_float(u & 0xffff0000u); }
DI float bf2f(bf16_t h) { return __uint_as_float((unsigned)h << 16); }
DI float wave_sum(float v) {
#pragma unroll
    for (int o = 1; o < 64; o <<= 1) v += __shfl_xor(v, o);
    return v;
}
DI int otid() { int t = (int)threadIdx.x; asm volatile("" : "+v"(t)); return t; }
DI float rcp_(float x) { return __builtin_amdgcn_rcpf(x); }
DI float rsq_(float x) { return __builtin_amdgcn_rsqf(x); }
DI float sigmoidf_(float x) { return rcp_(1.0f + __expf(-x)); }
DI float siluf_(float x) { return x * rcp_(1.0f + __expf(-x)); }
DI float geluf_(float x) { const float u = 1.5957691216057308f * (x + 0.044715f * x * x * x); return x * rcp_(1.0f + __expf(-u)); }

struct Params {
    const float* in[25];
    float* out;
    unsigned char* ws;
    int layer;
    int pad;
};
constexpr size_t PTR_TAB_BYTES = 65536;
template <bool DIRECT> DI const float* pinT(const Params& p, unsigned char* ws, int i) {
    if constexpr (DIRECT) return p.in[i];
    else return (const float*)(const __attribute__((address_space(1))) float*)(((const unsigned long long*)(ws + WS_CTL + PTR_TAB_BYTES))[i]);
}
DI unsigned char* ows(const Params& p) { __attribute__((address_space(1))) unsigned char* w = (__attribute__((address_space(1))) unsigned char*)p.ws; asm volatile("" : "+s"(w)); return (unsigned char*)w; }

namespace g8 {
constexpr int BM = 256, BK = 64, HALF = 128, HTB = HALF * BK * 2, STAGE_BYTES = 8 * HTB, NXCD = 8, WGM = 8;
DI int lds_byte(int r, int c) { const int st = (r >> 4) * 2 + (c >> 5), rr = r & 15, cc = c & 31, ob = rr * 64 + cc * 2; return st * 1024 + (ob ^ (((ob >> 9) & 1) << 5)); }
DI void stage_rc(int b, int& R, int& C) { const int st = b / 1024, sb = b % 1024, swz = sb ^ (((sb >> 9) & 1) << 5); R = (st >> 1) * 16 + swz / 64; C = (st & 1) * 32 + (swz % 64) / 2; }
DI int perm32(int rho) { const int n = rho >> 4, i = rho & 15; return 8 * (i >> 2) + 4 * n + (i & 3); }

struct Unit { const char* a; const char* b; int pm, pn, x0, x1; };

struct StaticSched {
    const char* A; const char* Bt; int lda, ldb, nM, nN, nwg, G, c;
    DI void init(const void* A_, const void* Bt_, int M, int N, int lda_, int ldb_, int G_, int c_) { A = (const char*)A_; Bt = (const char*)Bt_; lda = lda_; ldb = ldb_; nM = M / BM; nN = N / BM; nwg = nM * nN; G = G_; c = c_; }
    DI bool next(int i, Unit& u) const {
        const long L = (long)i * G + c; if (L >= nwg) return false;
        int wgid = (int)L; { const int q = nwg / NXCD, r = nwg % NXCD, xcd = wgid % NXCD, off = wgid / NXCD; wgid = (xcd < r ? xcd * (q + 1) : r * (q + 1) + (xcd - r) * q) + off; }
        const int nig = WGM * nN, gid = wgid / nig, fm = gid * WGM, gsz = (nM - fm) < WGM ? (nM - fm) : WGM;
        u.pm = fm + ((wgid % nig) % gsz); u.pn = (wgid % nig) / gsz; u.x0 = 0; u.x1 = 0;
        u.a = A + (size_t)u.pm * BM * lda * 2; u.b = Bt + (size_t)u.pn * BM * ldb * 2; return true;
    }
    DI int tok(const Unit&, int) const { return 0; }
};

template <class Epi, class Sched, bool GATHER>
DI void gemm_phase(LAS unsigned char* lds, const int K, const int lda, const int ldb, const Sched& S, const Epi& E) {
    const int tid = otid(), wid = __builtin_amdgcn_readfirstlane(tid >> 6), lane = tid & 63, wr = wid >> 2, wc = wid & 3, fr = lane & 15, fq = lane >> 4;
    const int nt = K / BK;
    unsigned voffA[2], voffB[2]; int RA[2], CA[2];
#pragma unroll
    for (int i = 0; i < 2; ++i) { int R, C; stage_rc(tid * 16 + i * 8192, R, C); const int Rb = Epi::PERM ? ((R & ~31) + perm32(R & 31)) : R;
        voffA[i] = (unsigned)(R * lda + C) * 2u; voffB[i] = (unsigned)(Rb * ldb + C) * 2u; RA[i] = R; CA[i] = C; }
    const size_t kstep = (size_t)(BK * 2);
    const size_t hstepA = (size_t)HALF * lda * 2, hstep = (size_t)HALF * ldb * 2;
    const unsigned ldsw = (unsigned)wid * 1024u;
    const int aoff = lds_byte(wr * 64 + fr, fq * 8), boff = lds_byte(wc * 32 + fr, fq * 8);
    unsigned gC[2][2], gN[2][2], g2[2][2];
#define G8_SA(b, h) (((b) * 2 + (h)) * HTB)
#define G8_SB(b, h) ((4 + (b) * 2 + (h)) * HTB)
#define G8_DMA(bufoff, ptr, _i) __builtin_amdgcn_global_load_lds((const unsigned*)(ptr), (LAS unsigned*)(lds + (bufoff) + ldsw + (_i) * 8192), 16, 0, 0)
#define G8_STAGE_B(bufoff, gbase) do { _Pragma("unroll") for (int _i = 0; _i < 2; ++_i) G8_DMA(bufoff, (const char*)(gbase) + voffB[_i], _i); } while (0)
#define G8_STAGE_A(bufoff, gbase, h, GO) do { _Pragma("unroll") for (int _i = 0; _i < 2; ++_i) { \
        if constexpr (GATHER) G8_DMA(bufoff, (const char*)(gbase) + GO[h][_i], _i); else G8_DMA(bufoff, (const char*)(gbase) + (h) * hstepA + voffA[_i], _i); } } while (0)
#define G8_LDA(dst, b, h) do { _Pragma("unroll") for (int m = 0; m < 4; ++m) _Pragma("unroll") for (int k = 0; k < 2; ++k) dst[m][k] = *(const LAS bf16x8*)(lds + G8_SA(b, h) + aoff + m * 2048 + k * 1024); } while (0)
#define G8_LDB(dst, b, h) do { _Pragma("unroll") for (int n = 0; n < 2; ++n) _Pragma("unroll") for (int k = 0; k < 2; ++k) dst[n][k] = *(const LAS bf16x8*)(lds + G8_SB(b, h) + boff + n * 2048 + k * 1024); } while (0)
#define G8_MMA(ai, bj, At, Bt) do { __builtin_amdgcn_s_setprio(1); _Pragma("unroll") for (int m = 0; m < 4; ++m) _Pragma("unroll") for (int n = 0; n < 2; ++n) _Pragma("unroll") for (int k = 0; k < 2; ++k) \
        acc[ai][bj][m][n] = __builtin_amdgcn_mfma_f32_16x16x32_bf16(Bt[n][k], At[m][k], acc[ai][bj][m][n], 0, 0, 0); __builtin_amdgcn_s_setprio(0); } while (0)
#define G8_WAIT_V(n) asm volatile("s_waitcnt vmcnt(" #n ")" ::: "memory")
#define G8_WAIT_L(n) asm volatile("s_waitcnt lgkmcnt(" #n ")" ::: "memory")
#define G8_BAR __builtin_amdgcn_s_barrier()
#define G8_SCHED __builtin_amdgcn_sched_barrier(0)
#define G8_GOFF(dst, u) do { if constexpr (GATHER) { _Pragma("unroll") for (int _h = 0; _h < 2; ++_h) _Pragma("unroll") for (int _i = 0; _i < 2; ++_i) \
        dst[_h][_i] = (unsigned)(S.tok(u, _h * HALF + RA[_i]) * lda + CA[_i]) * 2u; } } while (0)
    Unit cur, nxt; int ui = 0;
    if (!S.next(0, cur)) return;
    f32x4 acc[2][2][4][2];
#pragma unroll
    for (int a = 0; a < 2; ++a)
#pragma unroll
        for (int b = 0; b < 2; ++b)
#pragma unroll
            for (int m = 0; m < 4; ++m)
#pragma unroll
                for (int n = 0; n < 2; ++n) acc[a][b][m][n] = (f32x4){0.f, 0.f, 0.f, 0.f};
    bf16x8 At[4][2], B0[2][2], B1[2][2];
    const char* cA = cur.a; const char* cB = cur.b;
#pragma unroll
    for (int h = 0; h < 2; ++h)
#pragma unroll
        for (int i = 0; i < 2; ++i) { gC[h][i] = 0u; gN[h][i] = 0u; g2[h][i] = 0u; }
    G8_GOFF(gC, cur);
    G8_STAGE_B(G8_SB(0, 0), cB); G8_STAGE_B(G8_SB(0, 1), cB + hstep); G8_STAGE_A(G8_SA(0, 0), cA, 0, gC); G8_STAGE_A(G8_SA(0, 1), cA, 1, gC);
    if (wr == 1) G8_BAR;
    G8_WAIT_V(2); G8_BAR;
    G8_STAGE_B(G8_SB(1, 0), cB + kstep); G8_STAGE_A(G8_SA(1, 0), cA + kstep, 0, gC); G8_STAGE_B(G8_SB(1, 1), cB + hstep + kstep);
    G8_WAIT_V(6); G8_BAR;
    for (;;) {
        const bool has_next = S.next(ui + 1, nxt);
        const char* nA = has_next ? nxt.a : cA; const char* nB = has_next ? nxt.b : cB;
        if constexpr (GATHER) { if (has_next) { G8_GOFF(gN, nxt); } else {
#pragma unroll
            for (int h = 0; h < 2; ++h)
#pragma unroll
                for (int i = 0; i < 2; ++i) gN[h][i] = gC[h][i]; } }
        for (int t = 0; t < nt; t += 2) {
            const bool last = (t == nt - 2);
            const char* a1 = cA + (size_t)(t + 1) * kstep;
            const char* a2 = last ? nA : cA + (size_t)(t + 2) * kstep; const char* b2 = last ? nB : cB + (size_t)(t + 2) * kstep;
            const char* a3 = a2 + kstep; const char* b3 = b2 + kstep;
            if constexpr (GATHER) {
#pragma unroll
                for (int h = 0; h < 2; ++h)
#pragma unroll
                    for (int i = 0; i < 2; ++i) g2[h][i] = last ? gN[h][i] : gC[h][i]; }
            G8_LDB(B0, 0, 0); G8_LDB(B1, 0, 1); G8_SCHED; G8_LDA(At, 0, 0); G8_STAGE_A(G8_SA(1, 1), a1, 1, gC);
            G8_WAIT_V(8); G8_WAIT_L(0); G8_BAR; G8_MMA(0, 0, At, B0); G8_MMA(0, 1, At, B1); G8_BAR; G8_SCHED;
            G8_LDA(At, 0, 1); G8_STAGE_B(G8_SB(0, 0), b2); G8_STAGE_B(G8_SB(0, 1), b2 + hstep); G8_STAGE_A(G8_SA(0, 0), a2, 0, g2);
            G8_WAIT_V(8); G8_WAIT_L(0); G8_BAR; G8_MMA(1, 0, At, B0); G8_MMA(1, 1, At, B1); G8_BAR; G8_SCHED;
            G8_LDB(B0, 1, 0); G8_LDB(B1, 1, 1); G8_SCHED; G8_LDA(At, 1, 0); G8_STAGE_A(G8_SA(0, 1), a2, 1, g2);
            G8_WAIT_V(8); G8_WAIT_L(0); G8_BAR; G8_MMA(0, 0, At, B0); G8_MMA(0, 1, At, B1); G8_BAR; G8_SCHED;
            G8_LDA(At, 1, 1); G8_STAGE_B(G8_SB(1, 0), b3); G8_STAGE_B(G8_SB(1, 1), b3 + hstep); G8_STAGE_A(G8_SA(1, 0), a3, 0, g2);
            G8_WAIT_V(8); G8_WAIT_L(0); G8_BAR; G8_MMA(1, 0, At, B0); G8_MMA(1, 1, At, B1); G8_BAR; G8_SCHED;
        }
        if (wr == 0) G8_BAR;
        E(acc, cur, wr, wc, fr, fq);
        if (!has_next) break;
#pragma unroll
        for (int a = 0; a < 2; ++a)
#pragma unroll
            for (int b = 0; b < 2; ++b)
#pragma unroll
                for (int m = 0; m < 4; ++m)
#pragma unroll
                    for (int n = 0; n < 2; ++n) acc[a][b][m][n] = (f32x4){0.f, 0.f, 0.f, 0.f};
        cur = nxt; cA = nA; cB = nB; ++ui;
        if constexpr (GATHER) {
#pragma unroll
            for (int h = 0; h < 2; ++h)
#pragma unroll
                for (int i = 0; i < 2; ++i) gC[h][i] = gN[h][i]; }
        if (wr == 1) G8_BAR;
    }
    G8_WAIT_V(0);
    G8_BAR;
#undef G8_SA
#undef G8_SB
#undef G8_DMA
#undef G8_STAGE_A
#undef G8_STAGE_B
#undef G8_LDA
#undef G8_LDB
#undef G8_MMA
#undef G8_WAIT_V
#undef G8_WAIT_L
#undef G8_BAR
#undef G8_SCHED
#undef G8_GOFF
}
}

enum { I_X = 0, I_POS, I_WIN, I_SGU_LNG, I_SGU_LNB, I_SGU_WS, I_SGU_B, I_LBLOG, I_HNORM, I_QNG, I_WUQ, I_KVNG, I_WUKV, I_WOUT, I_LN1G, I_LN1B,
       I_RGW, I_RGB, I_REW, I_REB, I_EWG, I_EWU, I_EWD, I_LN2G, I_LN2B };

enum { TK_WIN = 0, TK_WUQ, TK_WUKV, TK_WOUT, TK_GATE, TK_UP, TK_DOWN };
struct ConvItem { const float* src; bf16_t* dst0; bf16_t* dst1; const float* sc; int K, N, kind, k0, n0; };
DI void conv_load8(const ConvItem& c, u32x4 (&v)[8], int half, int lane) {
    const int c16 = lane & 15, r4 = lane >> 4;
    const unsigned voff = (unsigned)(((r4 + 32 * half) * c.N + 4 * c16) * 4);
    const char* base = (const char*)(c.src + (size_t)c.k0 * c.N + c.n0);
    const unsigned rstep = (unsigned)c.N * 16u;
#pragma unroll
    for (int i = 0; i < 8; ++i) { const unsigned vo = voff + (unsigned)i * rstep; asm volatile("global_load_dwordx4 %0, %1, %2 nt" : "=v"(v[i]) : "v"(vo), "s"(base) : "memory"); }
}
template <int N> DI void conv_wait(u32x4 (&a)[8], u32x4 (&b)[8]) {
    static_assert(N == 0 || N == 8, "conv_wait");
    if constexpr (N == 8) asm volatile("s_waitcnt vmcnt(8)" : "+v"(a[0]), "+v"(a[1]), "+v"(a[2]), "+v"(a[3]), "+v"(a[4]), "+v"(a[5]), "+v"(a[6]), "+v"(a[7]) :: "memory");
    else asm volatile("s_waitcnt vmcnt(0)" : "+v"(a[0]), "+v"(a[1]), "+v"(a[2]), "+v"(a[3]), "+v"(a[4]), "+v"(a[5]), "+v"(a[6]), "+v"(a[7]) :: "memory");
    asm volatile("" : "+v"(b[0]), "+v"(b[1]), "+v"(b[2]), "+v"(b[3]), "+v"(b[4]), "+v"(b[5]), "+v"(b[6]), "+v"(b[7]) :: "memory");
}
DI void conv_lds_write(const u32x4 (&lo)[8], const u32x4 (&hi)[8], LAS float* scr, int lane) {
    const int c16 = lane & 15, r4 = lane >> 4;
#pragma unroll
    for (int i = 0; i < 8; ++i) { LAS unsigned* d = (LAS unsigned*)scr + (4 * i + r4) * 65 + 4 * c16; d[0] = lo[i].x; d[1] = lo[i].y; d[2] = lo[i].z; d[3] = lo[i].w;
                                  LAS unsigned* e = d + 32 * 65; e[0] = hi[i].x; e[1] = hi[i].y; e[2] = hi[i].z; e[3] = hi[i].w; }
    asm volatile("s_waitcnt lgkmcnt(0)" ::: "memory");
}
DI void conv_out(const ConvItem& ci, LAS float* scr, int lane) {
    const int K = ci.K, kind = ci.kind;
    const int c = lane & 7;
    float s8[8];
#pragma unroll
    for (int i = 0; i < 8; ++i) s8[i] = ci.sc ? ci.sc[ci.k0 + 8 * c + i] : 1.0f;
#pragma unroll
    for (int j = 0; j < 8; ++j) {
        const int nl = (lane >> 3) + 8 * j, n = ci.n0 + nl; const LAS float* s = scr + (8 * c) * 65 + nl;
        u32x4 o; o.x = pk2(s[0 * 65] * s8[0], s[1 * 65] * s8[1]); o.y = pk2(s[2 * 65] * s8[2], s[3 * 65] * s8[3]); o.z = pk2(s[4 * 65] * s8[4], s[5 * 65] * s8[5]); o.w = pk2(s[6 * 65] * s8[6], s[7 * 65] * s8[7]);
        bf16_t* d = ci.dst0; int row = n;
        if (kind == TK_WIN) { if (n >= 4096) { const int jj = n - 4096; row = 4096 + 2 * (jj & 31) + (jj >> 5); } }
        else if (kind == TK_WUQ) { const int h = n / 192, cc = n % 192; if (cc >= 128) { const int jj = cc - 128; row = h * 192 + 128 + 2 * (jj & 31) + (jj >> 5); } }
        else if (kind == TK_WUKV) { const int h = n >> 8, cc = n & 255; if (cc < 128) row = h * 128 + cc; else { d = ci.dst1; row = h * 128 + cc - 128; } }
        else if (kind == TK_GATE) row = (n >> 7) * 256 + (n & 127);
        else if (kind == TK_UP) row = (n >> 7) * 256 + 128 + (n & 127);
        *(u32x4*)(d + (size_t)row * K + ci.k0 + 8 * c) = o;
    }
    asm volatile("s_waitcnt lgkmcnt(0)" ::: "memory");
}

constexpr int IT_WIN = 32 * 65, IT_WUQ = 8 * 24, IT_WUKV = 8 * 32, IT_WOUT = 32 * 32, IT_E = 256, IT_LAYER = IT_WIN + IT_WUQ + IT_WUKV + IT_WOUT + NEXP * 3 * IT_E;
struct ConvPtrs { const float *win, *wuq, *qng, *wukv, *kvng, *wout, *ewg, *ewu, *ewd; };
DI const float* uni_ptr(const float* q) { unsigned long long v = (unsigned long long)q; const unsigned lo = __builtin_amdgcn_readfirstlane((unsigned)v), hi = __builtin_amdgcn_readfirstlane((unsigned)(v >> 32));
    return (const float*)(const __attribute__((address_space(1))) float*)(((unsigned long long)hi << 32) | lo); }
template <bool DIRECT> DI ConvPtrs conv_ptrs(const Params& p, unsigned char* ws) {
    ConvPtrs c; c.win = uni_ptr(pinT<DIRECT>(p, ws, I_WIN)); c.wuq = uni_ptr(pinT<DIRECT>(p, ws, I_WUQ)); c.qng = uni_ptr(pinT<DIRECT>(p, ws, I_QNG)); c.wukv = uni_ptr(pinT<DIRECT>(p, ws, I_WUKV));
    c.kvng = uni_ptr(pinT<DIRECT>(p, ws, I_KVNG)); c.wout = uni_ptr(pinT<DIRECT>(p, ws, I_WOUT)); c.ewg = uni_ptr(pinT<DIRECT>(p, ws, I_EWG)); c.ewu = uni_ptr(pinT<DIRECT>(p, ws, I_EWU)); c.ewd = uni_ptr(pinT<DIRECT>(p, ws, I_EWD));
    return c;
}
DI ConvItem conv_desc(const ConvPtrs& P, unsigned char* ws, int l, int r) {
    ConvItem c; c.dst1 = nullptr; c.sc = nullptr; int item;
    if (r < IT_WIN) { c.src = P.win + (size_t)l * DM * DIN; c.K = DM; c.N = DIN; c.kind = TK_WIN; c.dst0 = (bf16_t*)(ws + WS_WIN) + (size_t)l * DIN * DM; item = r; }
    else if ((r -= IT_WIN) < IT_WUQ) { c.src = P.wuq + (size_t)l * 512 * 1536; c.K = 512; c.N = 1536; c.kind = TK_WUQ; c.dst0 = (bf16_t*)(ws + WS_WUQ) + (size_t)l * 1536 * 512; c.sc = P.qng + l * 512; item = r; }
    else if ((r -= IT_WUQ) < IT_WUKV) { c.src = P.wukv + (size_t)l * 512 * 2048; c.K = 512; c.N = 2048; c.kind = TK_WUKV; c.dst0 = (bf16_t*)(ws + WS_WUK) + (size_t)l * 1024 * 512; c.dst1 = (bf16_t*)(ws + WS_WUV) + (size_t)l * 1024 * 512; c.sc = P.kvng + l * 512; item = r; }
    else if ((r -= IT_WUKV) < IT_WOUT) { c.src = P.wout + (size_t)l * DM * DM; c.K = DM; c.N = DM; c.kind = TK_WOUT; c.dst0 = (bf16_t*)(ws + WS_WOUT) + (size_t)l * DM * DM; item = r; }
    else { r -= IT_WOUT; const int e = r / (3 * IT_E), r2 = r % (3 * IT_E), ty = r2 / IT_E; item = r2 % IT_E; const size_t le = (size_t)l * NEXP + e;
        if (ty == 0) { c.src = P.ewg + le * DM * DEXP; c.K = DM; c.N = DEXP; c.kind = TK_GATE; c.dst0 = (bf16_t*)(ws + WS_WGU) + le * 1024 * DM; }
        else if (ty == 1) { c.src = P.ewu + le * DM * DEXP; c.K = DM; c.N = DEXP; c.kind = TK_UP; c.dst0 = (bf16_t*)(ws + WS_WGU) + le * 1024 * DM; }
        else { c.src = P.ewd + le * DEXP * DM; c.K = DEXP; c.N = DM; c.kind = TK_DOWN; c.dst0 = (bf16_t*)(ws + WS_WD) + le * DM * DEXP; } }
    const int nblk = c.N / 64; c.k0 = 64 * (item / nblk); c.n0 = 64 * (item % nblk);
    return c;
}
template <bool DIRECT> DI void conv_range(const Params& p, unsigned char* ws, int l, int first, int step, int end, LAS float* scr, int lane) {
    if (first >= end) return;
    const ConvPtrs P = conv_ptrs<DIRECT>(p, ws);
    u32x4 X[8], Z[8];
    if constexpr (DIRECT) {
        for (int it = first; it < end; it += step) { const ConvItem c = conv_desc(P, ws, l, it); conv_load8(c, X, 0, lane); conv_load8(c, Z, 1, lane); conv_wait<0>(X, Z); conv_lds_write(X, Z, scr, lane); conv_out(c, scr, lane); }
        return;
    }
    u32x4 Y[8];
    ConvItem ca = conv_desc(P, ws, l, first), cb = ca;
    conv_load8(ca, X, 0, lane); conv_load8(ca, Z, 1, lane);
    for (int it = first; ; it += 2 * step) {
        const bool hb = it + step < end;
        if (hb) { cb = conv_desc(P, ws, l, it + step); conv_load8(cb, Y, 0, lane); conv_wait<8>(X, Z); } else conv_wait<0>(X, Z);
        conv_lds_write(X, Z, scr, lane);
        if (hb) conv_load8(cb, Z, 1, lane);
        conv_out(ca, scr, lane);
        if (!hb) break;
        const bool ha = it + 2 * step < end;
        if (ha) { ca = conv_desc(P, ws, l, it + 2 * step); conv_load8(ca, X, 0, lane); conv_wait<8>(Y, Z); } else conv_wait<0>(Y, Z);
        conv_lds_write(Y, Z, scr, lane);
        if (ha) conv_load8(ca, Z, 1, lane);
        conv_out(cb, scr, lane);
        if (!ha) break;
    }
}
constexpr int CONV_UNIT = 64, N_CONV_UNITS = (IT_LAYER + CONV_UNIT - 1) / CONV_UNIT;
DI void conv_unit(const Params& p, LAS unsigned char* lds, int l, int u) {
    unsigned char* ws = ows(p);
    const int tid = otid(), lane = tid & 63, wave = __builtin_amdgcn_readfirstlane(tid >> 6);
    LAS float* scr = (LAS float*)(lds + wave * 16640);
    const int hi = (u + 1) * CONV_UNIT < IT_LAYER ? (u + 1) * CONV_UNIT : IT_LAYER;
    conv_range<false>(p, ws, l, u * CONV_UNIT + wave, 8, hi, scr, lane);
}

DI void phase_prologue(const Params& p, LAS unsigned char* lds, int bid, int G) {
    const int tid = otid(), lane = tid & 63, wave = __builtin_amdgcn_readfirstlane(tid >> 6);
    unsigned char* ws = ows(p);
    LAS float* scr = (LAS float*)(lds + wave * 16640);
    const int gw = bid * 8 + wave, NGW = G * 8;
    if (bid == 0 && tid < 25) ((unsigned long long*)(ws + WS_CTL + PTR_TAB_BYTES))[tid] = (unsigned long long)p.in[tid];
    conv_range<true>(p, ws, 0, gw, NGW, IT_LAYER, scr, lane);
    const int gt = bid * NTHR + tid, NG = G * NTHR;
    {
        const f32x4* x4 = (const f32x4*)p.in[I_X]; u32x2* xb = (u32x2*)(ws + WS_XB);
        for (int i = gt; i < NT * DM / 4; i += NG) { const f32x4 v = x4[i]; xb[i] = (u32x2){pk2(v.x, v.y), pk2(v.z, v.w)}; }
    }
    {
        float* cs = (float*)(ws + WS_COS); const int* pos = (const int*)p.in[I_POS];
        for (int i = gt; i < NT * 32; i += NG) {
            const int tok = i >> 5, j = i & 31;
            const float inv = 1.0f / powf(10000.0f, (float)(2 * j) / 64.0f);
            const float ang = (float)pos[tok] * inv;
            const double a = (double)ang; const double k = rint(a * 0.15915494309189535); const double rr = a - k * 6.283185307179586476925;
            const float rf = (float)rr;
            cs[i] = cosf(rf); cs[NT * 32 + i] = sinf(rf);
        }
    }
    {
        float* lb = (float*)(ws + WS_LB); const float* lg = p.in[I_LBLOG];
        for (int c = gt; c < 512; c += NG) {
            float v[DEPTH], mx = -3.0e38f;
            for (int l = 0; l < DEPTH; ++l) { v[l] = lg[l * 512 + c]; mx = fmaxf(mx, v[l]); }
            float s = 0.f; for (int l = 0; l < DEPTH; ++l) { v[l] = expf(v[l] - mx); s += v[l]; }
            float cum = 0.f, first = 0.f;
            for (int l = 0; l < DEPTH; ++l) { cum += v[l] / s; if (l == 0) first = cum; lb[l * 512 + c] = cum - first; }
        }
    }
    {
        bf16_t* o = (bf16_t*)(ws + WS_SGUW); const float* w = p.in[I_SGU_WS];
        for (int i = gt; i < DEPTH * 4 * 128 * 128; i += NG) { const int s = i & 127, t = (i >> 7) & 127; o[i] = f2bf(s <= t ? w[i] : 0.f); }
    }
    {
        const float* rgw = p.in[I_RGW]; const float* rew = p.in[I_REW]; const float* l1g = p.in[I_LN1G]; const float* l1b = p.in[I_LN1B]; const float* rgb = p.in[I_RGB]; const float* reb = p.in[I_REB];
        float* rw = (float*)(ws + WS_ROUTW);
        for (int i = gt; i < DEPTH * 48 * DM; i += NG) {
            const int k = i % DM, n = (i / DM) % 48, l = i / (DM * 48);
            float w = 0.f;
            if (n < 4) w = rgw[((size_t)l * DM + k) * 4 + n]; else if (n < 36) w = rew[((size_t)l * DM + k) * 32 + (n - 4)];
            rw[i] = w * l1g[l * DM + k];
        }
        float* rc = (float*)(ws + WS_ROUTC);
        for (int it = gw; it < DEPTH * 48; it += NGW) {
            const int l = it / 48, n = it % 48; float s1 = 0.f, s0 = 0.f;
            if (n < 36) for (int k = lane; k < DM; k += 64) {
                const float w = (n < 4) ? rgw[((size_t)l * DM + k) * 4 + n] : rew[((size_t)l * DM + k) * 32 + (n - 4)];
                s1 += w * l1g[l * DM + k]; s0 += w * l1b[l * DM + k]; }
            s1 = wave_sum(s1); s0 = wave_sum(s0);
            if (lane == 0) { const float bias = (n < 4) ? rgb[l * 4 + n] : (n < 36 ? reb[l * 32 + n - 4] : 0.f); rc[(l * 2 + 0) * 48 + n] = s0 + bias; rc[(l * 2 + 1) * 48 + n] = s1; }
        }
    }
}

struct EpiInProj {
    static constexpr bool PERM = true;
    bf16_t* HB; float* LOGF; float* SSQ; const float* lb;
    template <int KIND> DI void run(const f32x4 (&acc)[2][2][4][2], const g8::Unit& u, int wr, int wc, int fr, int fq) const {
        const int row0 = u.pm * 256 + wr * 64 + fr, col0 = u.pn * 256 + wc * 32 + 8 * fq;
        float lbv[2][8];
        if constexpr (KIND == 2) {
#pragma unroll
            for (int bj = 0; bj < 2; ++bj)
#pragma unroll
                for (int i = 0; i < 8; ++i) lbv[bj][i] = lb[col0 - 1536 + bj * 128 + i];
        }
#pragma unroll
        for (int ai = 0; ai < 2; ++ai)
#pragma unroll
            for (int m = 0; m < 4; ++m) {
                const int row = row0 + ai * 128 + m * 16; float ssq = 0.f;
#pragma unroll
                for (int bj = 0; bj < 2; ++bj) {
                    float v[8];
#pragma unroll
                    for (int i = 0; i < 4; ++i) { v[i] = acc[ai][bj][m][0][i]; v[4 + i] = acc[ai][bj][m][1][i]; }
                    const int col = col0 + bj * 128;
                    if constexpr (KIND == 0) {
#pragma unroll
                        for (int i = 0; i < 8; ++i) v[i] = geluf_(v[i]);
                    } else if constexpr (KIND == 1) {
#pragma unroll
                        for (int i = 0; i < 8; ++i) v[i] = siluf_(v[i]);
                    } else if constexpr (KIND == 2) {
                        float lf[8];
#pragma unroll
                        for (int i = 0; i < 8; ++i) { const float e = __expf(v[i]), l_ = lbv[bj][i];
                            const float f = l_ + (1.0f - l_) * rcp_(1.0f + __expf(-v[i]));
                            lf[i] = logf(f); v[i] = (1.0f - l_) * rcp_(1.0f + e); }
                        float* lp = LOGF + (size_t)row * 512 + (col - 1536);
                        *(f32x4*)lp = (f32x4){lf[0], lf[1], lf[2], lf[3]}; *(f32x4*)(lp + 4) = (f32x4){lf[4], lf[5], lf[6], lf[7]};
                    } else if constexpr (KIND == 4) {
#pragma unroll
                        for (int i = 0; i < 8; ++i) ssq += v[i] * v[i];
                    }
                    u32x4 w; w.x = pk2(v[0], v[1]); w.y = pk2(v[2], v[3]); w.z = pk2(v[4], v[5]); w.w = pk2(v[6], v[7]);
                    *(u32x4*)(HB + (size_t)row * 4096 + col) = w;
                }
                if constexpr (KIND == 4) {
                    ssq += __shfl_xor(ssq, 16); ssq += __shfl_xor(ssq, 32);
                    if (fq == 0) SSQ[(size_t)row * 16 + (u.pn - 12) * 4 + wc] = ssq;
                }
            }
    }
    DI void operator()(const f32x4 (&acc)[2][2][4][2], const g8::Unit& u, int wr, int wc, int fr, int fq) const {
        const int pn = u.pn;
        if (pn < 4) run<0>(acc, u, wr, wc, fr, fq);
        else if (pn < 6) run<1>(acc, u, wr, wc, fr, fq);
        else if (pn < 8) run<2>(acc, u, wr, wc, fr, fq);
        else if (pn < 10) run<3>(acc, u, wr, wc, fr, fq);
        else if (pn < 12) run<1>(acc, u, wr, wc, fr, fq);
        else run<4>(acc, u, wr, wc, fr, fq);
    }
};
DI void phase_inproj(const Params& p, LAS unsigned char* lds, int bid, int G, int l) {
    unsigned char* ws = ows(p);
    g8::StaticSched S; S.init(ws + WS_XB, (bf16_t*)(ws + WS_WIN) + (size_t)l * DIN * DM, NT, DIN_MAIN, DM, DM, G, bid);
    EpiInProj E{(bf16_t*)(ws + WS_HB), (float*)(ws + WS_LOGF), (float*)(ws + WS_SSQ), (const float*)(ws + WS_LB) + l * 512};
    g8::gemm_phase<EpiInProj, g8::StaticSched, false>(lds, DM, DM, DM, S, E);
}

DI void phase_krope(const Params& p, LAS unsigned char* lds, int bid, int G, int l) {
    unsigned char* ws = ows(p);
    const int tid = otid(), lane = tid & 63, wave = __builtin_amdgcn_readfirstlane(tid >> 6), fr = lane & 15, fq = lane >> 4;
    const bf16_t* X = (const bf16_t*)(ws + WS_XB); const bf16_t* W = (const bf16_t*)(ws + WS_WIN) + ((size_t)l * DIN + 4096) * DM;
    const float* cs = (const float*)(ws + WS_COS); bf16_t* KR = (bf16_t*)(ws + WS_KR);
    LAS float* PART = (LAS float*)lds;
    for (int task = bid; task < NT / 16; task += G) {
        const int r0 = task * 16;
        f32x4 acc[4];
#pragma unroll
        for (int n = 0; n < 4; ++n) acc[n] = (f32x4){0.f, 0.f, 0.f, 0.f};
        const bf16_t* ap = X + (size_t)(r0 + fr) * DM + 256 * wave + 8 * fq;
        const bf16_t* bp = W + (size_t)fr * DM + 256 * wave + 8 * fq;
#pragma unroll
        for (int s2 = 0; s2 < 8; ++s2) {
            const bf16x8 a = *(const bf16x8*)(ap + 32 * s2);
#pragma unroll
            for (int n = 0; n < 4; ++n) { const bf16x8 b = *(const bf16x8*)(bp + (size_t)(16 * n) * DM + 32 * s2); acc[n] = __builtin_amdgcn_mfma_f32_16x16x32_bf16(a, b, acc[n], 0, 0, 0); }
        }
        __syncthreads();
#pragma unroll
        for (int n = 0; n < 4; ++n)
#pragma unroll
            for (int i = 0; i < 4; ++i) PART[(wave * 16 + 4 * fq + i) * 64 + 16 * n + fr] = acc[n][i];
        __syncthreads();
        {
            const int row = tid >> 5, j = tid & 31; float x1 = 0.f, x2 = 0.f;
#pragma unroll
            for (int w = 0; w < 8; ++w) { const f32x2 v = *(const LAS f32x2*)(PART + (w * 16 + row) * 64 + 2 * j); x1 += v.x; x2 += v.y; }
            const size_t grow = (size_t)(r0 + row);
            const float c = cs[grow * 32 + j], sn = cs[(size_t)NT * 32 + grow * 32 + j];
            *(unsigned*)(KR + grow * 64 + 2 * j) = pk2(x1 * c - x2 * sn, x2 * c + x1 * sn);
        }
    }
}

DI void phase_sgu(const Params& p, LAS unsigned char* lds, int bid, int G, int l) {
    unsigned char* ws = ows(p);
    const int tid = otid(), lane = tid & 63, wave = tid >> 6, fr = lane & 15, fq = lane >> 4;
    const bf16_t* HB = (const bf16_t*)(ws + WS_HB); bf16_t* CAT = (bf16_t*)(ws + WS_CAT);
    const bf16_t* SW = (const bf16_t*)(ws + WS_SGUW) + (size_t)l * 4 * 128 * 128;
    const float* lng = pinT<false>(p, ws, I_SGU_LNG) + l * 512; const float* lnb = pinT<false>(p, ws, I_SGU_LNB) + l * 512; const float* sb = pinT<false>(p, ws, I_SGU_B) + l * 512;
    constexpr int TS = 272;
    LAS unsigned char* T = lds;
    for (int unit = bid; unit < 128 * 4; unit += G) {
        const int ci = unit >> 2, g = unit & 3, rbase = ci * 128;
        __syncthreads();
        for (int rr = 0; rr < 4; ++rr) {
            const int s = wave * 16 + rr * 4 + fq, row = rbase + s;
            float v[4][8]; float sm = 0.f;
#pragma unroll
            for (int j = 0; j < 4; ++j) { const u32x4 raw = *(const u32x4*)(HB + (size_t)row * 4096 + 512 + 128 * j + 8 * fr);
                v[j][0] = bflo(raw.x); v[j][1] = bfhi(raw.x); v[j][2] = bflo(raw.y); v[j][3] = bfhi(raw.y); v[j][4] = bflo(raw.z); v[j][5] = bfhi(raw.z); v[j][6] = bflo(raw.w); v[j][7] = bfhi(raw.w);
#pragma unroll
                for (int i = 0; i < 8; ++i) sm += v[j][i]; }
            sm += __shfl_xor(sm, 1); sm += __shfl_xor(sm, 2); sm += __shfl_xor(sm, 4); sm += __shfl_xor(sm, 8);
            const float mean = sm * (1.0f / 512.0f); float sq = 0.f;
#pragma unroll
            for (int j = 0; j < 4; ++j)
#pragma unroll
                for (int i = 0; i < 8; ++i) { v[j][i] -= mean; sq += v[j][i] * v[j][i]; }
            sq += __shfl_xor(sq, 1); sq += __shfl_xor(sq, 2); sq += __shfl_xor(sq, 4); sq += __shfl_xor(sq, 8);
            const float rstd = rsq_(sq * (1.0f / 512.0f) + EPS);
#pragma unroll
            for (int j = 0; j < 4; ++j) if (j == g) {
#pragma unroll
                for (int i = 0; i < 8; ++i) { const int c = 128 * j + 8 * fr + i, d = 8 * fr + i; const float y = v[j][i] * rstd * lng[c] + lnb[c];
                    *(LAS bf16_t*)(T + d * TS + s * 2) = f2bf(y); }
            }
        }
        __syncthreads();
        f32x4 acc[8];
#pragma unroll
        for (int n = 0; n < 8; ++n) acc[n] = (f32x4){0.f, 0.f, 0.f, 0.f};
        const bf16_t* wp = SW + ((size_t)g * 128 + wave * 16 + fr) * 128 + 8 * fq;
        const int ksmax = wave >> 1;
        for (int ks = 0; ks <= ksmax; ++ks) {
            const bf16x8 a = *(const bf16x8*)(wp + 32 * ks);
#pragma unroll
            for (int n = 0; n < 8; ++n) { const bf16x8 b = *(const LAS bf16x8*)(T + (16 * n + fr) * TS + (32 * ks + 8 * fq) * 2); acc[n] = __builtin_amdgcn_mfma_f32_16x16x32_bf16(a, b, acc[n], 0, 0, 0); }
        }
#pragma unroll
        for (int i = 0; i < 4; ++i) {
            const int t = wave * 16 + 4 * fq + i, row = rbase + t; const float bias = sb[g * 128 + t];
#pragma unroll
            for (int n = 0; n < 8; ++n) { const int c = g * 128 + 16 * n + fr; const float uu = bf2f(HB[(size_t)row * 4096 + c]);
                CAT[(size_t)row * DM + c] = f2bf(uu * (acc[n][i] + bias)); }
        }
    }
}

constexpr int HQ_OFF = 0, HK_OFF = 17408, HG_OFF = 34816, HKD_OFF = 52224, HV_OFF = 70656, HP_OFF = 89088, HSEG_OFF = 98304;
constexpr int HS_T = 272, HS_S = 144;
#define HG_BAR() do { asm volatile("s_waitcnt lgkmcnt(0)" ::: "memory"); __builtin_amdgcn_s_barrier(); asm volatile("" ::: "memory"); } while (0)
DI void hgrn_local_unit(const bf16_t* HB, const float* LOGF, float* OI, float* UU, bf16_t* QGg, float* DLg, LAS unsigned char* lds, int b, int h, int c) {
    const int tid = otid(), lane = tid & 63, wave = __builtin_amdgcn_readfirstlane(tid >> 6), fr = lane & 15, fq = lane >> 4;
    const int kp = lane, seg = wave;
    const size_t unit = (size_t)((b * 4 + h) * 64 + c), rowb = (size_t)b * SEQ;
    f32x2 lf[8]; unsigned qr[8], kr[8], vr[8];
#pragma unroll
    for (int i = 0; i < 8; ++i) { const size_t row = rowb + c * 64 + 8 * seg + i;
        lf[i] = *(const f32x2*)(LOGF + row * 512 + h * 128 + 2 * kp); const bf16_t* hp = HB + row * 4096 + h * 128 + 2 * kp;
        qr[i] = *(const unsigned*)(hp + 1024); kr[i] = *(const unsigned*)(hp + 1536); vr[i] = *(const unsigned*)(hp + 2048); }
    __syncthreads();
    if (tid < 128) { const int t = (tid < 64) ? (tid >> 2) : 32 + ((tid - 64) >> 2), s0 = ((tid < 64) ? 16 : 48) + 4 * (tid & 3);
        unsigned z = 0u; asm volatile("" : "+v"(z));
        *(LAS u32x2*)(lds + HP_OFF + t * HS_S + s0 * 2) = (u32x2){z, z}; }
    { float c0 = 0.f, c1 = 0.f;
#pragma unroll
      for (int i = 0; i < 8; ++i) { c0 += lf[i].x; c1 += lf[i].y; lf[i].x = c0; lf[i].y = c1; }
      *(LAS f32x2*)(lds + HSEG_OFF + (seg * 128 + 2 * kp) * 4) = (f32x2){c0, c1}; }
    HG_BAR();
    { f32x2 off = {0.f, 0.f}, R = {0.f, 0.f}, GL = {0.f, 0.f};
#pragma unroll
      for (int j = 0; j < 8; ++j) { const f32x2 tj = *(const LAS f32x2*)(lds + HSEG_OFF + (j * 128 + 2 * kp) * 4); if (j < seg) off += tj; if (j < 4) R += tj; GL += tj; }
      const f32x2 eR = {__expf(R.x), __expf(R.y)}, eGR = {__expf(GL.x - R.x), __expf(GL.y - R.y)};
      float kd0[8], kd1[8];
#pragma unroll
      for (int i = 0; i < 8; ++i) {
          const int t = 8 * seg + i; const float g0 = off.x + lf[i].x, g1 = off.y + lf[i].y;
          const float e10 = __expf(g0 - R.x), e11 = __expf(g1 - R.y), e20 = __expf(R.x - g0), e21 = __expf(R.y - g1), e30 = e10 * eR.x, e31 = e11 * eR.y, e40 = e20 * eGR.x, e41 = e21 * eGR.y;
          const float q0 = bflo(qr[i]), q1 = bfhi(qr[i]), k0 = bflo(kr[i]), k1 = bfhi(kr[i]);
          *(LAS unsigned*)(lds + HQ_OFF + t * HS_T + kp * 4) = pk2(q0 * e10, q1 * e11);
          *(LAS unsigned*)(lds + HK_OFF + t * HS_T + kp * 4) = pk2(k0 * e20, k1 * e21);
          *(LAS unsigned*)(lds + HG_OFF + t * HS_T + kp * 4) = pk2(q0 * e30, q1 * e31);
          kd0[i] = k0 * e40; kd1[i] = k1 * e41;
      }
      *(LAS u32x4*)(lds + HKD_OFF + (2 * kp) * HS_S + 16 * seg) = (u32x4){pk2(kd0[0], kd0[1]), pk2(kd0[2], kd0[3]), pk2(kd0[4], kd0[5]), pk2(kd0[6], kd0[7])};
      *(LAS u32x4*)(lds + HKD_OFF + (2 * kp + 1) * HS_S + 16 * seg) = (u32x4){pk2(kd1[0], kd1[1]), pk2(kd1[2], kd1[3]), pk2(kd1[4], kd1[5]), pk2(kd1[6], kd1[7])};
      u32x4 v0, v1;
      v0.x = (vr[0] & 0xffffu) | (vr[1] << 16); v0.y = (vr[2] & 0xffffu) | (vr[3] << 16); v0.z = (vr[4] & 0xffffu) | (vr[5] << 16); v0.w = (vr[6] & 0xffffu) | (vr[7] << 16);
      v1.x = (vr[0] >> 16) | (vr[1] & 0xffff0000u); v1.y = (vr[2] >> 16) | (vr[3] & 0xffff0000u); v1.z = (vr[4] >> 16) | (vr[5] & 0xffff0000u); v1.w = (vr[6] >> 16) | (vr[7] & 0xffff0000u);
      *(LAS u32x4*)(lds + HV_OFF + (2 * kp) * HS_S + 16 * seg) = v0;
      *(LAS u32x4*)(lds + HV_OFF + (2 * kp + 1) * HS_S + 16 * seg) = v1;
      if (seg == 0) *(f32x2*)(DLg + unit * 128 + 2 * kp) = (f32x2){__expf(GL.x), __expf(GL.y)};
    }
    HG_BAR();
    for (int rep = 0; rep < 2; ++rep) {
        const int idx = wave + 8 * rep; if (idx >= 10) break;
        const int a = (int)((0x3221110000ULL >> (4 * idx)) & 0xf), bt = (int)((0x3323213210ULL >> (4 * idx)) & 0xf);
        f32x4 pacc = {0.f, 0.f, 0.f, 0.f};
#pragma unroll
        for (int ks = 0; ks < 4; ++ks) {
            const bf16x8 af = *(const LAS bf16x8*)(lds + HK_OFF + (16 * a + fr) * HS_T + (32 * ks + 8 * fq) * 2);
            const bf16x8 bf = *(const LAS bf16x8*)(lds + HQ_OFF + (16 * bt + fr) * HS_T + (32 * ks + 8 * fq) * 2);
            pacc = __builtin_amdgcn_mfma_f32_16x16x32_bf16(af, bf, pacc, 0, 0, 0);
        }
        const int t = 16 * bt + fr, s0 = 16 * a + 4 * fq;
#pragma unroll
        for (int i = 0; i < 4; ++i) if (s0 + i > t) pacc[i] = 0.f;
        *(LAS u32x2*)(lds + HP_OFF + t * HS_S + s0 * 2) = (u32x2){pk2(pacc[0], pacc[1]), pk2(pacc[2], pacc[3])};
    }
#pragma unroll
    for (int jj = 0; jj < 2; ++jj) { const int pp = tid + 512 * jj, t = pp >> 4, c16 = pp & 15;
        *(u32x4*)(QGg + unit * 8192 + t * 128 + c16 * 8) = *(const LAS u32x4*)(lds + HG_OFF + t * HS_T + c16 * 16); }
    HG_BAR();
    {
        bf16x8 vf[2];
#pragma unroll
        for (int ss = 0; ss < 2; ++ss) vf[ss] = *(const LAS bf16x8*)(lds + HV_OFF + (16 * wave + fr) * HS_S + (32 * ss + 8 * fq) * 2);
        u32x4* oi = (u32x4*)OI + (unit * 8 + wave) * 2 * 64 + lane;
        f32x4 oacc[4];
#pragma unroll
        for (int bt = 0; bt < 4; ++bt) {
            f32x4 acc = {0.f, 0.f, 0.f, 0.f};
#pragma unroll
            for (int ss = 0; ss < 2; ++ss) if (32 * ss <= 16 * bt + 15) {
                const bf16x8 pf = *(const LAS bf16x8*)(lds + HP_OFF + (16 * bt + fr) * HS_S + (32 * ss + 8 * fq) * 2);
                acc = __builtin_amdgcn_mfma_f32_16x16x32_bf16(pf, vf[ss], acc, 0, 0, 0);
            }
            oacc[bt] = acc;
        }
#pragma unroll
        for (int pr = 0; pr < 2; ++pr) oi[pr * 64] = (u32x4){pk2(oacc[2 * pr][0], oacc[2 * pr][1]), pk2(oacc[2 * pr][2], oacc[2 * pr][3]), pk2(oacc[2 * pr + 1][0], oacc[2 * pr + 1][1]), pk2(oacc[2 * pr + 1][2], oacc[2 * pr + 1][3])};
        u32x4* uu = (u32x4*)UU + (unit * 8 + wave) * 4 * 64 + lane;
        f32x4 uacc[8];
#pragma unroll
        for (int a = 0; a < 8; ++a) {
            f32x4 acc = {0.f, 0.f, 0.f, 0.f};
#pragma unroll
            for (int ss = 0; ss < 2; ++ss) {
                const bf16x8 kf = *(const LAS bf16x8*)(lds + HKD_OFF + (16 * a + fr) * HS_S + (32 * ss + 8 * fq) * 2);
                acc = __builtin_amdgcn_mfma_f32_16x16x32_bf16(kf, vf[ss], acc, 0, 0, 0);
            }
            uacc[a] = acc;
        }
#pragma unroll
        for (int a2 = 0; a2 < 4; ++a2) uu[a2 * 64] = (u32x4){pk2(uacc[2 * a2][0], uacc[2 * a2][1]), pk2(uacc[2 * a2][2], uacc[2 * a2][3]), pk2(uacc[2 * a2 + 1][0], uacc[2 * a2 + 1][1]), pk2(uacc[2 * a2 + 1][2], uacc[2 * a2 + 1][3])};
    }
}
DI void phase_hgrn_local(const Params& p, LAS unsigned char* lds, int bid, int G, int l) {
    unsigned char* ws = ows(p);
    for (int u = bid; u < 1024; u += G) { const int bh = u >> 6, c = u & 63;
        hgrn_local_unit((const bf16_t*)(ws + WS_HB), (const float*)(ws + WS_LOGF), (float*)(ws + WS_OH), (float*)(ws + WS_HU), (bf16_t*)(ws + WS_HQG), (float*)(ws + WS_HDL), lds, bh >> 2, bh & 3, c); }
}
constexpr int SQ_OFF = 0, SOT_OFF = 34816, SSS_OFF = 67584, SDL_OFF = 71680;
struct HsW { u32x4 oi[2], u[4]; };
struct HsQ { u32x4 q[2]; f32x4 d; };
DI void hgrn_seq_unit(const bf16_t* HB, const float* OI, const float* UU, const bf16_t* QGg, const float* DLg, const float* ng, bf16_t* CAT, LAS unsigned char* lds, int b, int h) {
    const int tid = otid(), lane = tid & 63, wave = __builtin_amdgcn_readfirstlane(tid >> 6), fr = lane & 15, fq = lane >> 4;
    const size_t unit0 = (size_t)((b * 4 + h) * 64), rowb = (size_t)b * SEQ;
    f32x4 S[8];
#pragma unroll
    for (int a = 0; a < 8; ++a) S[a] = (f32x4){0.f, 0.f, 0.f, 0.f};
    HsW w0, w1, w2; HsQ q1, q2; u32x4 g0[2], g1[2];
    w2 = HsW{}; q2 = HsQ{};
#define HS_LOADW(W, c) do { const size_t un = unit0 + (c); const u32x4* oi_ = (const u32x4*)OI + (un * 8 + wave) * 2 * 64 + lane; const u32x4* uu_ = (const u32x4*)UU + (un * 8 + wave) * 4 * 64 + lane; \
        asm volatile("" : "+v"(oi_), "+v"(uu_)); W.oi[0] = oi_[0]; W.oi[1] = oi_[64]; W.u[0] = uu_[0]; W.u[1] = uu_[64]; W.u[2] = uu_[128]; W.u[3] = uu_[192]; } while (0)
#define HS_LOADQ(Qs, c) do { _Pragma("unroll") for (int jj = 0; jj < 2; ++jj) { const int pp = tid + 512 * jj; Qs.q[jj] = *(const u32x4*)(QGg + (unit0 + (c)) * 8192 + (pp >> 4) * 128 + (pp & 15) * 8); } \
        Qs.d = (tid < 32) ? *(const f32x4*)(DLg + (unit0 + (c)) * 128 + 4 * (tid & 31)) : (f32x4){0.f, 0.f, 0.f, 0.f}; } while (0)
#define HS_STOREQ(Qs, buf) do { _Pragma("unroll") for (int jj = 0; jj < 2; ++jj) { const int pp = tid + 512 * jj; *(LAS u32x4*)(lds + SQ_OFF + (buf) * 17408 + (pp >> 4) * HS_T + (pp & 15) * 16) = Qs.q[jj]; } \
        if (tid < 32) *(LAS f32x4*)(lds + SDL_OFF + (buf) * 512 + tid * 16) = Qs.d; } while (0)
#define HS_LOADG(Gs, c) do { _Pragma("unroll") for (int jj = 0; jj < 2; ++jj) Gs[jj] = *(const u32x4*)(HB + (rowb + (c) * 64 + (lane >> 1) + 32 * jj) * 4096 + 2560 + h * 128 + 16 * wave + 8 * (lane & 1)); } while (0)
    const int v0 = h * 128 + 16 * wave + 8 * (lane & 1);
    const f32x4 gn0 = *(const f32x4*)(ng + v0), gn1 = *(const f32x4*)(ng + v0 + 4);
    __syncthreads();
    HS_LOADQ(q1, 0); HS_LOADW(w0, 0); HS_LOADG(g0, 0);
    HS_STOREQ(q1, 0);
    HS_LOADQ(q1, 1); HS_LOADW(w1, 1);
    HG_BAR();
    for (int c = 0; c < SEQ / 64; ++c) {
        const int buf = c & 1;
        if (c + 2 < SEQ / 64) { HS_LOADQ(q2, c + 2); HS_LOADW(w2, c + 2); }
        if (c + 1 < SEQ / 64) HS_LOADG(g1, c + 1);
        f32x4 o[4];
        {
            bf16x8 sf[4];
#pragma unroll
            for (int a2 = 0; a2 < 4; ++a2) { const u32x4 w = {pk2(S[2 * a2][0], S[2 * a2][1]), pk2(S[2 * a2][2], S[2 * a2][3]), pk2(S[2 * a2 + 1][0], S[2 * a2 + 1][1]), pk2(S[2 * a2 + 1][2], S[2 * a2 + 1][3])}; sf[a2] = __builtin_bit_cast(bf16x8, w); }
#pragma unroll
            for (int bt = 0; bt < 4; ++bt) {
                const u32x4 ow = w0.oi[bt >> 1];
                f32x4 acc = (bt & 1) ? (f32x4){bflo(ow.z), bfhi(ow.z), bflo(ow.w), bfhi(ow.w)} : (f32x4){bflo(ow.x), bfhi(ow.x), bflo(ow.y), bfhi(ow.y)};
#pragma unroll
                for (int a2 = 0; a2 < 4; ++a2) {
                    const LAS unsigned char* gp = lds + SQ_OFF + buf * 17408 + (16 * bt + fr) * HS_T + (32 * a2 + 4 * fq) * 2;
                    const u32x2 lo = *(const LAS u32x2*)gp, hi = *(const LAS u32x2*)(gp + 32);
                    const u32x4 w = {lo.x, lo.y, hi.x, hi.y};
                    acc = __builtin_amdgcn_mfma_f32_16x16x32_bf16(__builtin_bit_cast(bf16x8, w), sf[a2], acc, 0, 0, 0);
                }
                o[bt] = acc;
            }
#pragma unroll
            for (int a = 0; a < 8; ++a) { const u32x4 uw = w0.u[a >> 1];
                const f32x4 uv = (a & 1) ? (f32x4){bflo(uw.z), bfhi(uw.z), bflo(uw.w), bfhi(uw.w)} : (f32x4){bflo(uw.x), bfhi(uw.x), bflo(uw.y), bfhi(uw.y)};
                S[a] = S[a] * *(const LAS f32x4*)(lds + SDL_OFF + buf * 512 + (16 * a + 4 * fq) * 4) + uv; }
        }
        LAS unsigned char* ot = lds + SOT_OFF + wave * 4096;
#pragma unroll
        for (int bt = 0; bt < 4; ++bt)
#pragma unroll
            for (int i = 0; i < 4; ++i) *(LAS float*)(ot + (16 * bt + 4 * fq + i) * 64 + fr * 4) = o[bt][i];
        asm volatile("s_waitcnt lgkmcnt(0)" ::: "memory");
        f32x4 orow[2][2];
#pragma unroll
        for (int jj = 0; jj < 2; ++jj) {
            const LAS unsigned char* rp = ot + ((lane >> 1) + 32 * jj) * 64 + (lane & 1) * 32;
            orow[jj][0] = *(const LAS f32x4*)rp; orow[jj][1] = *(const LAS f32x4*)(rp + 16);
            const f32x4 a = orow[jj][0], bb = orow[jj][1];
            float q2s = (a.x * a.x + a.y * a.y) + (a.z * a.z + a.w * a.w) + (bb.x * bb.x + bb.y * bb.y) + (bb.z * bb.z + bb.w * bb.w);
            q2s += __shfl_xor(q2s, 1);
            if ((lane & 1) == 0) *(LAS float*)(lds + SSS_OFF + buf * 2048 + (((lane >> 1) + 32 * jj) * 8 + wave) * 4) = q2s;
        }
        if (c + 1 < SEQ / 64) HS_STOREQ(q1, buf ^ 1);
        HG_BAR();
#pragma unroll
        for (int jj = 0; jj < 2; ++jj) {
            const int t = (lane >> 1) + 32 * jj;
            const LAS float* sp = (const LAS float*)(lds + SSS_OFF + buf * 2048 + t * 32);
            const f32x4 s0 = *(const LAS f32x4*)sp, s1 = *(const LAS f32x4*)(sp + 4);
            const float ssum = (s0.x + s0.y) + (s0.z + s0.w) + (s1.x + s1.y) + (s1.z + s1.w);
            const float rstd = rsq_(ssum * (1.0f / 128.0f) + EPS);
            const u32x4 g = g0[jj];
            const f32x4 y0 = orow[jj][0] * rstd * gn0 * (f32x4){bflo(g.x), bfhi(g.x), bflo(g.y), bfhi(g.y)};
            const f32x4 y1 = orow[jj][1] * rstd * gn1 * (f32x4){bflo(g.z), bfhi(g.z), bflo(g.w), bfhi(g.w)};
            *(u32x4*)(CAT + (rowb + c * 64 + t) * DM + 512 + v0) = (u32x4){pk2(y0.x, y0.y), pk2(y0.z, y0.w), pk2(y1.x, y1.y), pk2(y1.z, y1.w)};
        }
        w0 = w1; w1 = w2; q1 = q2; g0[0] = g1[0]; g0[1] = g1[1];
    }
#undef HS_LOADQ
#undef HS_STOREQ
#undef HS_LOADW
#undef HS_LOADG
}
#undef HG_BAR

DI float rstd_from_ssq(const float* SSQ, int row, int which) {
    const f32x4 a = *(const f32x4*)(SSQ + (size_t)row * 16 + which * 8), b = *(const f32x4*)(SSQ + (size_t)row * 16 + which * 8 + 4);
    const float s = (a.x + a.y) + (a.z + a.w) + (b.x + b.y) + (b.z + b.w);
    return rsq_(s * (1.0f / 512.0f) + EPS);
}
struct EpiQ {
    static constexpr bool PERM = true;
    bf16_t* Q; const float* SSQ; const float* cs;
    DI void operator()(const f32x4 (&acc)[2][2][4][2], const g8::Unit& u, int wr, int wc, int fr, int fq) const {
        const int row0 = u.pm * 256 + wr * 64 + fr, col0 = u.pn * 256 + wc * 32 + 8 * fq;
#pragma unroll
        for (int ai = 0; ai < 2; ++ai)
#pragma unroll
            for (int m = 0; m < 4; ++m) {
                const int row = row0 + ai * 128 + m * 16; const float sc = rstd_from_ssq(SSQ, row, 0) * QSCALE;
#pragma unroll
                for (int bj = 0; bj < 2; ++bj) {
                    const int col = col0 + bj * 128, cc = col % 192;
                    float v[8];
#pragma unroll
                    for (int i = 0; i < 4; ++i) { v[i] = acc[ai][bj][m][0][i] * sc; v[4 + i] = acc[ai][bj][m][1][i] * sc; }
                    if (cc >= 128) {
                        const int j0 = (cc - 128) >> 1;
                        const f32x4 c = *(const f32x4*)(cs + (size_t)row * 32 + j0), s = *(const f32x4*)(cs + (size_t)NT * 32 + (size_t)row * 32 + j0);
#pragma unroll
                        for (int i = 0; i < 4; ++i) { const float x1 = v[2 * i], x2 = v[2 * i + 1]; v[2 * i] = x1 * c[i] - x2 * s[i]; v[2 * i + 1] = x2 * c[i] + x1 * s[i]; }
                    }
                    u32x4 w; w.x = pk2(v[0], v[1]); w.y = pk2(v[2], v[3]); w.z = pk2(v[4], v[5]); w.w = pk2(v[6], v[7]);
                    *(u32x4*)(Q + (size_t)row * 1536 + col) = w;
                }
            }
    }
};
struct EpiK {
    static constexpr bool PERM = true;
    bf16_t* KN; const float* SSQ;
    DI void operator()(const f32x4 (&acc)[2][2][4][2], const g8::Unit& u, int wr, int wc, int fr, int fq) const {
        const int row0 = u.pm * 256 + wr * 64 + fr, col0 = u.pn * 256 + wc * 32 + 8 * fq;
#pragma unroll
        for (int ai = 0; ai < 2; ++ai)
#pragma unroll
            for (int m = 0; m < 4; ++m) {
                const int row = row0 + ai * 128 + m * 16; const float sc = rstd_from_ssq(SSQ, row, 1);
#pragma unroll
                for (int bj = 0; bj < 2; ++bj) {
                    const f32x4 v0 = acc[ai][bj][m][0] * sc, v1 = acc[ai][bj][m][1] * sc;
                    u32x4 w; w.x = pk2(v0[0], v0[1]); w.y = pk2(v0[2], v0[3]); w.z = pk2(v1[0], v1[1]); w.w = pk2(v1[2], v1[3]);
                    *(u32x4*)(KN + (size_t)row * 1024 + col0 + bj * 128) = w;
                }
            }
    }
};
struct EpiVT {
    static constexpr bool PERM = true;
    bf16_t* VT; const float* SSQ;
    DI void operator()(const f32x4 (&acc)[2][2][4][2], const g8::Unit& u, int wr, int wc, int fr, int fq) const {
        const int row0 = u.pm * 256 + wr * 64 + fr, col0 = u.pn * 256 + wc * 32 + 8 * fq;
        float sc[2][8];
#pragma unroll
        for (int bj = 0; bj < 2; ++bj)
#pragma unroll
            for (int i = 0; i < 8; ++i) sc[bj][i] = rstd_from_ssq(SSQ, col0 + bj * 128 + i, 1);
#pragma unroll
        for (int ai = 0; ai < 2; ++ai)
#pragma unroll
            for (int m = 0; m < 4; ++m) {
                const int row = row0 + ai * 128 + m * 16, h = row >> 7, d = row & 127;
#pragma unroll
                for (int bj = 0; bj < 2; ++bj) {
                    const int tok = col0 + bj * 128, b = tok >> 12, s = tok & 4095;
                    const f32x4 a0 = acc[ai][bj][m][0], a1 = acc[ai][bj][m][1];
                    u32x4 w; w.x = pk2(a0[0] * sc[bj][0], a0[1] * sc[bj][1]); w.y = pk2(a0[2] * sc[bj][2], a0[3] * sc[bj][3]);
                    w.z = pk2(a1[0] * sc[bj][4], a1[1] * sc[bj][5]); w.w = pk2(a1[2] * sc[bj][6], a1[3] * sc[bj][7]);
                    *(u32x4*)(VT + ((size_t)((b * 8 + h) * 128 + d)) * SEQ + s) = w;
                }
            }
    }
};
DI void phase_mla_proj(const Params& p, LAS unsigned char* lds, int bid, int G, int l) {
    unsigned char* ws = ows(p);
    const float* SSQ = (const float*)(ws + WS_SSQ); const bf16_t* HB = (const bf16_t*)(ws + WS_HB);
    {
        g8::StaticSched S; S.init(HB + 3072, (const bf16_t*)(ws + WS_WUQ) + (size_t)l * 1536 * 512, NT, 1536, 4096, 512, G, bid);
        EpiQ E{(bf16_t*)(ws + WS_Q), SSQ, (const float*)(ws + WS_COS)};
        g8::gemm_phase<EpiQ, g8::StaticSched, false>(lds, 512, 4096, 512, S, E);
    }
    {
        g8::StaticSched S; S.init(HB + 3584, (const bf16_t*)(ws + WS_WUK) + (size_t)l * 1024 * 512, NT, 1024, 4096, 512, G, bid);
        EpiK E{(bf16_t*)(ws + WS_KN), SSQ};
        g8::gemm_phase<EpiK, g8::StaticSched, false>(lds, 512, 4096, 512, S, E);
    }
    {
        g8::StaticSched S; S.init((const bf16_t*)(ws + WS_WUV) + (size_t)l * 1024 * 512, HB + 3584, 1024, NT, 512, 4096, G, bid);
        EpiVT E{(bf16_t*)(ws + WS_VT), SSQ};
        g8::gemm_phase<EpiVT, g8::StaticSched, false>(lds, 512, 512, 4096, S, E);
    }
}

constexpr int AT_KS = 400, AT_VS = 144;
constexpr int AT_KBUF = 64 * AT_KS, AT_VBUF = 128 * AT_VS;
DI void attn_unit(const bf16_t* Qg, const bf16_t* KNg, const bf16_t* KRg, const bf16_t* VTg, bf16_t* CAT, LAS unsigned char* lds, int b, int h, int qb) {
    const int tid = otid(), lane = tid & 63, wave = __builtin_amdgcn_readfirstlane(tid >> 6), c = lane & 31, hi = lane >> 5;
    const int q0 = qb * 256, qmin = q0 + 32 * wave, qrow = qmin + c, ntile = 4 * (qb + 1), jmax = (qmin + 31) >> 6;
    LAS unsigned char* Kb = lds; LAS unsigned char* Vb = lds + 2 * AT_KBUF;
    bf16x8 qf[12];
    { const bf16_t* qp = Qg + (size_t)(b * SEQ + qrow) * 1536 + h * 192 + 8 * hi;
#pragma unroll
      for (int ks = 0; ks < 12; ++ks) qf[ks] = *(const bf16x8*)(qp + 16 * ks); }
    f32x16 o[4];
#pragma unroll
    for (int d = 0; d < 4; ++d)
#pragma unroll
        for (int r = 0; r < 16; ++r) o[d][r] = 0.f;
    float m_run = -1.0e30f, l_run = 0.f;
    int ksrc_off[3], kdst[3]; bool kfromR[3];
#pragma unroll
    for (int i = 0; i < 3; ++i) { const int id = tid + 512 * i, key = id / 24, cc = id % 24; kdst[i] = key * AT_KS + cc * 16; kfromR[i] = cc >= 16;
        ksrc_off[i] = kfromR[i] ? (key * 64 + 8 * (cc - 16)) : (key * 1024 + h * 128 + 8 * cc); }
    int vsrc_off[2], vdst[2];
#pragma unroll
    for (int i = 0; i < 2; ++i) { const int id = tid + 512 * i, d = id >> 3, cc = id & 7; vdst[i] = d * AT_VS + (cc >> 1) * 32 + (cc & 1) * 8; vsrc_off[i] = d * SEQ + 8 * cc; }
    const bf16_t* KNb = KNg + (size_t)b * SEQ * 1024; const bf16_t* KRb = KRg + (size_t)b * SEQ * 64; const bf16_t* VTb = VTg + (size_t)(b * 8 + h) * 128 * SEQ;
    u32x4 kreg[3], vreg[2];
#define AT_LOAD(j) do { _Pragma("unroll") for (int i = 0; i < 3; ++i) kreg[i] = kfromR[i] ? *(const u32x4*)(KRb + (size_t)(j) * 64 * 64 + ksrc_off[i]) : *(const u32x4*)(KNb + (size_t)(j) * 64 * 1024 + ksrc_off[i]); \
                        _Pragma("unroll") for (int i = 0; i < 2; ++i) vreg[i] = *(const u32x4*)(VTb + (size_t)(j) * 64 + vsrc_off[i]); } while (0)
#define AT_STORE(buf) do { _Pragma("unroll") for (int i = 0; i < 3; ++i) *(LAS u32x4*)(Kb + (buf) * AT_KBUF + kdst[i]) = kreg[i]; \
                           _Pragma("unroll") for (int i = 0; i < 2; ++i) { *(LAS u32x2*)(Vb + (buf) * AT_VBUF + vdst[i]) = (u32x2){vreg[i].x, vreg[i].y}; *(LAS u32x2*)(Vb + (buf) * AT_VBUF + vdst[i] + 16) = (u32x2){vreg[i].z, vreg[i].w}; } } while (0)
    __syncthreads();
    AT_LOAD(0); AT_STORE(0);
    __syncthreads();
    for (int j = 0; j < ntile; ++j) {
        const int buf = j & 1;
        if (j + 1 < ntile) AT_LOAD(j + 1);
        if (j <= jmax) {
            const LAS unsigned char* kb_ = Kb + buf * AT_KBUF + c * AT_KS + 16 * hi;
            f32x16 s0, s1;
#pragma unroll
            for (int r = 0; r < 16; ++r) { s0[r] = 0.f; s1[r] = 0.f; }
#pragma unroll
            for (int ks = 0; ks < 12; ++ks) {
                const bf16x8 a0 = *(const LAS bf16x8*)(kb_ + 32 * ks), a1 = *(const LAS bf16x8*)(kb_ + 32 * AT_KS + 32 * ks);
                s0 = __builtin_amdgcn_mfma_f32_32x32x16_bf16(a0, qf[ks], s0, 0, 0, 0);
                s1 = __builtin_amdgcn_mfma_f32_32x32x16_bf16(a1, qf[ks], s1, 0, 0, 0);
            }
            if (64 * j + 63 > qmin) {
                const int dq = qrow - 64 * j - 4 * hi;
#pragma unroll
                for (int r = 0; r < 16; ++r) { const int kk = (r & 3) + 8 * (r >> 2);
                    if (kk > dq) s0[r] = -__builtin_inff();
                    if (kk + 32 > dq) s1[r] = -__builtin_inff(); }
            }
            float mx = s0[0];
#pragma unroll
            for (int r = 1; r < 16; ++r) mx = fmaxf(mx, s0[r]);
#pragma unroll
            for (int r = 0; r < 16; ++r) mx = fmaxf(mx, s1[r]);
            { auto rr = __builtin_amdgcn_permlane32_swap(__float_as_uint(mx), __float_as_uint(mx), false, false); mx = fmaxf(__uint_as_float(rr[0]), __uint_as_float(rr[1])); }
            if (!__all(mx - m_run <= 8.0f)) {
                const float m_new = fmaxf(m_run, mx), alpha = __builtin_amdgcn_exp2f(m_run - m_new);
                m_run = m_new; l_run *= alpha;
#pragma unroll
                for (int d = 0; d < 4; ++d)
#pragma unroll
                    for (int r = 0; r < 16; ++r) o[d][r] *= alpha;
            }
            float ps = 0.f;
#pragma unroll
            for (int r = 0; r < 16; ++r) { s0[r] = __builtin_amdgcn_exp2f(s0[r] - m_run); s1[r] = __builtin_amdgcn_exp2f(s1[r] - m_run); ps += s0[r] + s1[r]; }
            l_run += ps;
            bf16x8 pb[4];
#pragma unroll
            for (int s2 = 0; s2 < 2; ++s2) {
                u32x4 w0, w1;
                w0.x = pk2(s0[8 * s2 + 0], s0[8 * s2 + 1]); w0.y = pk2(s0[8 * s2 + 2], s0[8 * s2 + 3]); w0.z = pk2(s0[8 * s2 + 4], s0[8 * s2 + 5]); w0.w = pk2(s0[8 * s2 + 6], s0[8 * s2 + 7]);
                w1.x = pk2(s1[8 * s2 + 0], s1[8 * s2 + 1]); w1.y = pk2(s1[8 * s2 + 2], s1[8 * s2 + 3]); w1.z = pk2(s1[8 * s2 + 4], s1[8 * s2 + 5]); w1.w = pk2(s1[8 * s2 + 6], s1[8 * s2 + 7]);
                pb[s2] = __builtin_bit_cast(bf16x8, w0); pb[2 + s2] = __builtin_bit_cast(bf16x8, w1);
            }
            const LAS unsigned char* vb_ = Vb + buf * AT_VBUF + c * AT_VS + 16 * hi;
#pragma unroll
            for (int d = 0; d < 4; ++d)
#pragma unroll
                for (int kk = 0; kk < 4; ++kk) {
                    const bf16x8 av = *(const LAS bf16x8*)(vb_ + d * 32 * AT_VS + kk * 32);
                    o[d] = __builtin_amdgcn_mfma_f32_32x32x16_bf16(av, pb[kk], o[d], 0, 0, 0);
                }
        }
        if (j + 1 < ntile) AT_STORE(buf ^ 1);
        __syncthreads();
    }
#undef AT_LOAD
#undef AT_STORE
    float l_tot; { auto rr = __builtin_amdgcn_permlane32_swap(__float_as_uint(l_run), __float_as_uint(l_run), false, false); l_tot = __uint_as_float(rr[0]) + __uint_as_float(rr[1]); }
    const float inv = rcp_(l_tot);
    bf16_t* op = CAT + (size_t)(b * SEQ + qrow) * DM + 1024 + h * 128 + 4 * hi;
#pragma unroll
    for (int d = 0; d < 4; ++d)
#pragma unroll
        for (int g = 0; g < 4; ++g) {
            const u32x2 w = {pk2(o[d][4 * g] * inv, o[d][4 * g + 1] * inv), pk2(o[d][4 * g + 2] * inv, o[d][4 * g + 3] * inv)};
            *(u32x2*)(op + 32 * d + 8 * g) = w;
        }
}
constexpr int CW_QUEUE = 4096;
constexpr int QWORD_OFF = MOE_LDS_OFF + 2048;
constexpr int KCONV = 10;
DI int q_pop(unsigned* head, LAS unsigned char* lds) {
    __syncthreads();
    if (threadIdx.x == 0) *(LAS unsigned*)(lds + QWORD_OFF) = atomicAdd(head, 1u);
    __syncthreads();
    return __builtin_amdgcn_readfirstlane((int)*(LAS unsigned*)(lds + QWORD_OFF));
}
DI void phase_attn_hgrn(const Params& p, LAS unsigned char* lds, int l) {
    unsigned char* ws0 = ows(p);
    unsigned* qa = (unsigned*)(ws0 + WS_CTL) + CW_QUEUE + (l * 3 + 0) * 8 * 16; unsigned* qc = qa + 8 * 16; unsigned* qr = qc + 8 * 16;
    const int x0 = (int)(__builtin_amdgcn_s_getreg((3 << 11) | 20) & 7u);
    const bool has_conv = l + 1 < DEPTH;
    bool conv_first = false;
    if (has_conv) conv_first = q_pop(qr + x0 * 16, lds) < KCONV;
    for (int pass = 0; pass < 2; ++pass) {
        const bool do_conv = (pass == 0) == conv_first;
        if (do_conv && !has_conv) continue;
        for (int dx = 0; dx < 8; ++dx) {
            const int x = (x0 + dx) & 7;
            if (do_conv) {
                const int ncv = (N_CONV_UNITS - x + 7) / 8;
                for (;;) { const int idx = q_pop(qc + x * 16, lds); if (idx >= ncv) break; conv_unit(p, lds, l + 1, x + 8 * idx); }
            } else {
                for (;;) {
                    const int idx = q_pop(qa + x * 16, lds); if (idx >= 66) break;
                    unsigned char* ws = ows(p);
                    if (idx < 2) { const int bh = 2 * x + idx; hgrn_seq_unit((const bf16_t*)(ws + WS_HB), (const float*)(ws + WS_OH), (const float*)(ws + WS_HU), (const bf16_t*)(ws + WS_HQG), (const float*)(ws + WS_HDL),
                                                                               pinT<false>(p, ws, I_HNORM) + l * 512, (bf16_t*)(ws + WS_CAT), lds, bh >> 2, bh & 3); }
                    else { const int j = idx - 2, bh = 4 * x + (j & 3), qb = 15 - (j >> 2);
                           attn_unit((const bf16_t*)(ws + WS_Q), (const bf16_t*)(ws + WS_KN), (const bf16_t*)(ws + WS_KR), (const bf16_t*)(ws + WS_VT), (bf16_t*)(ws + WS_CAT), lds, bh >> 3, bh & 7, qb); }
                }
            }
        }
    }
}

struct EpiOut {
    static constexpr bool PERM = true;
    const float* xres; const bf16_t* xb; float* Y;
    DI void operator()(const f32x4 (&acc)[2][2][4][2], const g8::Unit& u, int wr, int wc, int fr, int fq) const {
        const int row0 = u.pm * 256 + wr * 64 + fr, col0 = u.pn * 256 + wc * 32 + 8 * fq;
#pragma unroll
        for (int ai = 0; ai < 2; ++ai)
#pragma unroll
            for (int m = 0; m < 4; ++m) {
                const size_t rb = (size_t)(row0 + ai * 128 + m * 16) * DM;
#pragma unroll
                for (int bj = 0; bj < 2; ++bj) {
                    const int col = col0 + bj * 128; f32x4 x0, x1;
                    if (xres) { x0 = *(const f32x4*)(xres + rb + col); x1 = *(const f32x4*)(xres + rb + col + 4); }
                    else { const u32x4 r = *(const u32x4*)(xb + rb + col); x0 = (f32x4){bflo(r.x), bfhi(r.x), bflo(r.y), bfhi(r.y)}; x1 = (f32x4){bflo(r.z), bfhi(r.z), bflo(r.w), bfhi(r.w)}; }
                    *(f32x4*)(Y + rb + col) = x0 * ALPHA + acc[ai][bj][m][0]; *(f32x4*)(Y + rb + col + 4) = x1 * ALPHA + acc[ai][bj][m][1];
                }
            }
    }
};
DI void phase_outproj(const Params& p, LAS unsigned char* lds, int bid, int G, int l) {
    unsigned char* ws = ows(p);
    g8::StaticSched S; S.init(ws + WS_CAT, (const bf16_t*)(ws + WS_WOUT) + (size_t)l * DM * DM, NT, DM, DM, DM, G, bid);
    EpiOut E{l == 0 ? pinT<false>(p, ws, I_X) : nullptr, (const bf16_t*)(ws + WS_XB), (float*)(ws + WS_Y)};
    g8::gemm_phase<EpiOut, g8::StaticSched, false>(lds, DM, DM, DM, S, E);
}

constexpr int L1_RS = 8208;
constexpr int L1_PART = 16 * L1_RS, L1_STAT = L1_PART + 8 * 16 * 48 * 4, L1_LG = L1_STAT + 128;
static_assert(L1_LG + 16 * 48 * 4 <= MOE_LDS_OFF, "ln1 LDS map");
DI void phase_ln1_router(const Params& p, LAS unsigned char* lds, int bid, int G, int l) {
    unsigned char* ws = ows(p);
    const int tid = otid(), lane = tid & 63, wave = __builtin_amdgcn_readfirstlane(tid >> 6), fr = lane & 15, fq = lane >> 4;
    float* Y = (float*)(ws + WS_Y); bf16_t* X1B = (bf16_t*)(ws + WS_X1B);
    const float* RW = (const float*)(ws + WS_ROUTW) + (size_t)l * 48 * DM; const float* rc0 = (const float*)(ws + WS_ROUTC) + (l * 2 + 0) * 48; const float* rc1 = rc0 + 48;
    unsigned* cnt = (unsigned*)(ws + WS_CTL) + CW_CNT + l * 32 * 16;
    int* TOK = (int*)(ws + WS_TOK); int* ROUTE = (int*)(ws + WS_ROUTE);
    const f32x4 gg = *(const f32x4*)(pinT<false>(p, ws, I_LN1G) + l * DM + 4 * tid), bb = *(const f32x4*)(pinT<false>(p, ws, I_LN1B) + l * DM + 4 * tid);
    LAS float* PART = (LAS float*)(lds + L1_PART); LAS float* STAT = (LAS float*)(lds + L1_STAT); LAS float* LG = (LAS float*)(lds + L1_LG);
    for (int task = bid; task < NT / 16; task += G) {
        const int r0 = task * 16;
        f32x4 xr[16], wbuf[8][3];
        const float* wp = RW + (size_t)fr * DM + 256 * wave + 4 * fq;
        asm volatile("" : "+v"(wp));
#pragma unroll
        for (int s2 = 0; s2 < 8; ++s2)
#pragma unroll
            for (int n = 0; n < 3; ++n) wbuf[s2][n] = *(const f32x4*)(wp + (size_t)(16 * n) * DM + 16 * s2);
#pragma unroll
        for (int i = 0; i < 16; ++i) xr[i] = *(const f32x4*)(Y + (size_t)(r0 + i) * DM + 4 * tid);
        __syncthreads();
#pragma unroll
        for (int i = 0; i < 16; ++i) *(LAS f32x4*)(lds + i * L1_RS + tid * 16) = xr[i];
        __syncthreads();
#pragma unroll
        for (int rr = 0; rr < 2; ++rr) {
            const int row = 2 * wave + rr; float sm = 0.f, sq = 0.f;
#pragma unroll
            for (int j = 0; j < 8; ++j) { const f32x4 v = *(const LAS f32x4*)(lds + row * L1_RS + (4 * lane + 256 * j) * 4); sm += (v.x + v.y) + (v.z + v.w); sq += (v.x * v.x + v.y * v.y) + (v.z * v.z + v.w * v.w); }
            sm = wave_sum(sm); sq = wave_sum(sq);
            const float mean = sm * (1.0f / DM), var = fmaxf(sq * (1.0f / DM) - mean * mean, 0.f);
            if (lane == 0) { STAT[2 * row] = mean; STAT[2 * row + 1] = rsq_(var + EPS); }
        }
        f32x4 acc[3];
#pragma unroll
        for (int n = 0; n < 3; ++n) acc[n] = (f32x4){0.f, 0.f, 0.f, 0.f};
        const LAS unsigned char* ap = lds + fr * L1_RS + (256 * wave + 4 * fq) * 4;
#pragma unroll
        for (int hf = 0; hf < 2; ++hf) {
            if (hf == 1) {
#pragma unroll
                for (int s2 = 0; s2 < 8; ++s2)
#pragma unroll
                    for (int n = 0; n < 3; ++n) wbuf[s2][n] = *(const f32x4*)(wp + (size_t)(16 * n) * DM + 16 * (8 + s2));
            }
#pragma unroll
            for (int s2 = 0; s2 < 8; ++s2) {
                const f32x4 xa = *(const LAS f32x4*)(ap + 64 * (8 * hf + s2));
#pragma unroll
                for (int n = 0; n < 3; ++n)
#pragma unroll
                    for (int i = 0; i < 4; ++i) acc[n] = __builtin_amdgcn_mfma_f32_16x16x4f32(xa[i], wbuf[s2][n][i], acc[n], 0, 0, 0);
            }
        }
#pragma unroll
        for (int n = 0; n < 3; ++n)
#pragma unroll
            for (int i = 0; i < 4; ++i) PART[(wave * 16 + 4 * fq + i) * 48 + 16 * n + fr] = acc[n][i];
        __syncthreads();
#pragma unroll
        for (int rep = 0; rep < 2; ++rep) {
            const int pp = tid + 512 * rep;
            if (pp < 768) { const int row = pp / 48, col = pp % 48; float sacc = 0.f;
#pragma unroll
                for (int w = 0; w < 8; ++w) sacc += PART[(w * 16 + row) * 48 + col];
                LG[pp] = STAT[2 * row + 1] * (sacc - STAT[2 * row] * rc1[col]) + rc0[col]; }
        }
        __syncthreads();
        if (tid < 16) {
            const LAS float* L = LG + tid * 48; const int token = r0 + tid;
            float gm = L[0]; int gi = 0;
#pragma unroll
            for (int j = 1; j < 4; ++j) if (L[j] > gm) { gm = L[j]; gi = j; }
            float gs = 0.f;
#pragma unroll
            for (int j = 0; j < 4; ++j) gs += expf(L[j] - gm);
            const float gval = 1.0f / gs;
            const LAS float* E = L + 4 + gi * 8;
            float v1 = E[0]; int i1 = 0;
#pragma unroll
            for (int j = 1; j < 8; ++j) if (E[j] > v1) { v1 = E[j]; i1 = j; }
            float v2 = -3.0e38f; int i2 = 0;
#pragma unroll
            for (int j = 0; j < 8; ++j) if (j != i1 && E[j] > v2) { v2 = E[j]; i2 = j; }
            const float ex = expf(v2 - v1), p1 = 1.0f / (1.0f + ex), p2 = ex / (1.0f + ex);
            const int e0 = gi * 8 + i1, e1 = gi * 8 + i2;
            const int pos0 = (int)atomicAdd(cnt + e0 * 16, 1u), pos1 = (int)atomicAdd(cnt + e1 * 16, 1u);
            TOK[(size_t)e0 * NT + pos0] = token; TOK[(size_t)e1 * NT + pos1] = token;
            int* rp = ROUTE + (size_t)token * 8;
            rp[0] = e0; rp[1] = pos0; rp[2] = e1; rp[3] = pos1; rp[4] = __float_as_int(gval * p1); rp[5] = __float_as_int(gval * p2);
        }
#pragma unroll
        for (int i = 0; i < 16; ++i) {
            const float mean = STAT[2 * i], rstd = STAT[2 * i + 1];
            const f32x4 xv = *(const LAS f32x4*)(lds + i * L1_RS + tid * 16);
            const f32x4 y = (xv - mean) * rstd * gg + bb;
            *(u32x2*)(X1B + (size_t)(r0 + i) * DM + 4 * tid) = (u32x2){pk2(y.x, y.y), pk2(y.z, y.w)};
        }
    }
}

DI void moe_tables(const Params& p, LAS unsigned char* lds, int l) {
    LAS int* mc = (LAS int*)(lds + MOE_LDS_OFF); LAS int* mp = mc + 32;
    __syncthreads();
    if (threadIdx.x == 0) {
        const unsigned* cnt = (const unsigned*)(ows(p) + WS_CTL) + CW_CNT + l * 32 * 16; int acc = 0;
        for (int e = 0; e < 32; ++e) { int c = (int)__hip_atomic_load(cnt + e * 16, __ATOMIC_RELAXED, __HIP_MEMORY_SCOPE_AGENT); if (c > NT) c = NT; mc[e] = c; mp[e] = acc; acc += (c + 255) >> 8; }
        mp[32] = acc;
    }
    __syncthreads();
}
template <int NCT_SHIFT> struct MoeSched {
    const char* A; const char* Bt; const int* TOK; LAS const int* mc; LAS const int* mp; size_t bexp, btile, atile; int G, c;
    DI bool next(int i, g8::Unit& u) const {
        int rt, ct, e = 0;
        if (G == 256) {
            const int x = c & 7, slot = c >> 3, t0 = mp[4 * x], nt = mp[4 * x + 4] - t0, L = i * 32 + slot;
            if (L >= (nt << NCT_SHIFT)) return false;
            rt = t0 + (L >> NCT_SHIFT); ct = L & ((1 << NCT_SHIFT) - 1);
            e = 4 * x;
            for (int j = 4 * x + 1; j < 4 * x + 4; ++j) if (mp[j] <= rt) e = j;
        } else {
            const int L = i * G + c, T = mp[32]; if (L >= (T << NCT_SHIFT)) return false;
            rt = L >> NCT_SHIFT; ct = L & ((1 << NCT_SHIFT) - 1);
            for (int j = 1; j < 32; ++j) if (mp[j] <= rt) e = j;
        }
        u.pm = rt; u.pn = ct; u.x0 = e; u.x1 = rt - mp[e];
        u.a = A + (size_t)rt * atile; u.b = Bt + (size_t)e * bexp + (size_t)ct * btile; return true;
    }
    DI int tok(const g8::Unit& u, int R) const { const int idx = u.x1 * 256 + R; return idx < mc[u.x0] ? TOK[(size_t)u.x0 * NT + idx] : 0; }
};
struct EpiMoe1 {
    static constexpr bool PERM = true;
    bf16_t* HM;
    DI void operator()(const f32x4 (&acc)[2][2][4][2], const g8::Unit& u, int wr, int wc, int fr, int fq) const {
        const int row0 = u.pm * 256 + wr * 64 + fr, col0 = u.pn * 128 + wc * 32 + 8 * fq;
#pragma unroll
        for (int ai = 0; ai < 2; ++ai)
#pragma unroll
            for (int m = 0; m < 4; ++m) {
                float v[8];
#pragma unroll
                for (int i = 0; i < 4; ++i) { v[i] = siluf_(acc[ai][0][m][0][i]) * acc[ai][1][m][0][i]; v[4 + i] = siluf_(acc[ai][0][m][1][i]) * acc[ai][1][m][1][i]; }
                u32x4 w; w.x = pk2(v[0], v[1]); w.y = pk2(v[2], v[3]); w.z = pk2(v[4], v[5]); w.w = pk2(v[6], v[7]);
                *(u32x4*)(HM + (size_t)(row0 + ai * 128 + m * 16) * DEXP + col0) = w;
            }
    }
};
struct EpiMoe2 {
    static constexpr bool PERM = true;
    bf16_t* YB;
    DI void operator()(const f32x4 (&acc)[2][2][4][2], const g8::Unit& u, int wr, int wc, int fr, int fq) const {
        const int row0 = u.pm * 256 + wr * 64 + fr, col0 = u.pn * 256 + wc * 32 + 8 * fq;
#pragma unroll
        for (int ai = 0; ai < 2; ++ai)
#pragma unroll
            for (int m = 0; m < 4; ++m)
#pragma unroll
                for (int bj = 0; bj < 2; ++bj) {
                    const f32x4 v0 = acc[ai][bj][m][0], v1 = acc[ai][bj][m][1];
                    u32x4 w; w.x = pk2(v0[0], v0[1]); w.y = pk2(v0[2], v0[3]); w.z = pk2(v1[0], v1[1]); w.w = pk2(v1[2], v1[3]);
                    *(u32x4*)(YB + (size_t)(row0 + ai * 128 + m * 16) * DM + col0 + bj * 128) = w;
                }
    }
};
DI void phase_moe1(const Params& p, LAS unsigned char* lds, int bid, int G, int l) {
    unsigned char* ws = ows(p);
    moe_tables(p, lds, l);
    MoeSched<2> S{(const char*)(ws + WS_X1B), (const char*)(ws + WS_WGU) + (size_t)l * NEXP * 1024 * DM * 2, (const int*)(ws + WS_TOK), (LAS const int*)(lds + MOE_LDS_OFF), (LAS const int*)(lds + MOE_LDS_OFF) + 32,
                  (size_t)1024 * DM * 2, (size_t)256 * DM * 2, 0, G, bid};
    EpiMoe1 E{(bf16_t*)(ws + WS_HM)};
    g8::gemm_phase<EpiMoe1, MoeSched<2>, true>(lds, DM, DM, DM, S, E);
}
DI void phase_moe2(const Params& p, LAS unsigned char* lds, int bid, int G, int l) {
    unsigned char* ws = ows(p);
    moe_tables(p, lds, l);
    MoeSched<3> S{(const char*)(ws + WS_HM), (const char*)(ws + WS_WD) + (size_t)l * NEXP * DM * DEXP * 2, nullptr, (LAS const int*)(lds + MOE_LDS_OFF), (LAS const int*)(lds + MOE_LDS_OFF) + 32,
                  (size_t)DM * DEXP * 2, (size_t)256 * DEXP * 2, (size_t)256 * DEXP * 2, G, bid};
    EpiMoe2 E{(bf16_t*)(ws + WS_YB)};
    g8::gemm_phase<EpiMoe2, MoeSched<3>, false>(lds, DEXP, DEXP, DEXP, S, E);
}

DI void phase_ln2(const Params& p, LAS unsigned char* lds, int bid, int G, int l) {
    unsigned char* ws = ows(p);
    moe_tables(p, lds, l);
    LAS const int* mp = (LAS const int*)(lds + MOE_LDS_OFF) + 32;
    const int tid = otid(), lane = tid & 63, wave = tid >> 6;
    const bf16_t* X1B = (const bf16_t*)(ws + WS_X1B); const bf16_t* YB = (const bf16_t*)(ws + WS_YB); const int* ROUTE = (const int*)(ws + WS_ROUTE);
    const float* g = pinT<false>(p, ws, I_LN2G) + l * DM; const float* bt = pinT<false>(p, ws, I_LN2B) + l * DM;
    float* out = p.out; bf16_t* XB = (bf16_t*)(ws + WS_XB);
    for (int row = bid * 8 + wave; row < NT; row += G * 8) {
        const int* rp = ROUTE + (size_t)row * 8;
        const int e0 = rp[0], pos0 = rp[1], e1 = rp[2], pos1 = rp[3]; const float g0 = __int_as_float(rp[4]), g1 = __int_as_float(rp[5]);
        const size_t s0 = (size_t)(256 * mp[e0] + pos0), s1 = (size_t)(256 * mp[e1] + pos1);
        f32x4 v[8]; float sm = 0.f;
#pragma unroll
        for (int j = 0; j < 8; ++j) {
            const int col = 4 * lane + 256 * j;
            const u32x2 xr_ = *(const u32x2*)(X1B + (size_t)row * DM + col); const f32x4 x = {bflo(xr_.x), bfhi(xr_.x), bflo(xr_.y), bfhi(xr_.y)};
            const u32x2 a = *(const u32x2*)(YB + s0 * DM + col), b = *(const u32x2*)(YB + s1 * DM + col);
            const f32x4 ya = {bflo(a.x), bfhi(a.x), bflo(a.y), bfhi(a.y)}, yb = {bflo(b.x), bfhi(b.x), bflo(b.y), bfhi(b.y)};
            v[j] = x * ALPHA + (ya * g0 + yb * g1);
            sm += (v[j].x + v[j].y) + (v[j].z + v[j].w);
        }
        const float mean = wave_sum(sm) * (1.0f / DM); float sq = 0.f;
#pragma unroll
        for (int j = 0; j < 8; ++j) { v[j] = v[j] - mean; sq += (v[j].x * v[j].x + v[j].y * v[j].y) + (v[j].z * v[j].z + v[j].w * v[j].w); }
        const float rstd = rsq_(wave_sum(sq) * (1.0f / DM) + EPS);
#pragma unroll
        for (int j = 0; j < 8; ++j) {
            const int col = 4 * lane + 256 * j;
            const f32x4 y = v[j] * rstd * *(const f32x4*)(g + col) + *(const f32x4*)(bt + col);
            if (l == DEPTH - 1) *(f32x4*)(out + (size_t)row * DM + col) = y;
            else *(u32x2*)(XB + (size_t)row * DM + col) = (u32x2){pk2(y.x, y.y), pk2(y.z, y.w)};
        }
    }
}


#define GAS __attribute__((address_space(1)))
typedef GAS unsigned gu32;
#define XB_TMO      128
#define XB_XCNT(j)  (256  + 64 * (j))
#define XB_XSUB(j)  (1280 + 64 * (j))
#define XB_XGEN(j)  (2304 + 64 * (j))
#define XB_TOP      3328
#define XB_TOPGEN   3392
#define XCD_BAR_WORDS 3456
#define XB_SPIN_CAP (1u << 18)

__device__ __forceinline__ unsigned xb_ld(unsigned* p)              { return __hip_atomic_load(p, __ATOMIC_RELAXED, __HIP_MEMORY_SCOPE_AGENT); }
__device__ __forceinline__ unsigned xb_add(unsigned* p, unsigned v) { return __hip_atomic_fetch_add(p, v, __ATOMIC_RELAXED, __HIP_MEMORY_SCOPE_AGENT); }
__device__ __forceinline__ unsigned xb_xcc_id() { return (unsigned)__builtin_amdgcn_s_getreg((3 << 11) | 20) & 0xFu; }
#define XB_SPIN(cond, bar) do { unsigned _sp = 0; while (cond) { __builtin_amdgcn_s_sleep(1); \
    if ((++_sp & 255u) == 0u) { if (xb_ld(&(bar)[XB_TMO])) break; if (_sp > XB_SPIN_CAP) { atomicAdd(&(bar)[XB_TMO], 1u); break; } } } } while (0)

struct XcdBarrier {
    unsigned* bar; unsigned x;
    volatile LAS unsigned* st;
};

__device__ __forceinline__ XcdBarrier xcd_barrier_post(unsigned* bar, volatile LAS unsigned* st) {
    XcdBarrier b; b.bar = bar; b.x = xb_xcc_id(); b.st = st;
    if (threadIdx.x == 0) (void)xb_add(&bar[XB_XCNT(b.x)], 1u);
    return b;
}
__device__ __forceinline__ void xcd_barrier_complete(unsigned* bar, unsigned x, unsigned& nloc, unsigned& nx) {
    const unsigned G = gridDim.x * gridDim.y * gridDim.z;
    unsigned sum, cnt, mine, sp = 0u;
    for (;;) {
        sum = 0u; cnt = 0u; mine = 0u;
#pragma unroll
        for (unsigned j = 0; j < 16; ++j) { const unsigned c = xb_ld(&bar[XB_XCNT(j)]); sum += c; cnt += (c > 0u) ? 1u : 0u; mine = (j == x) ? c : mine; }
        if (sum == G) break;
        __builtin_amdgcn_s_sleep(1);
        if ((++sp & 255u) == 0u) { if (xb_ld(&bar[XB_TMO])) break; if (sp > XB_SPIN_CAP) { atomicAdd(&bar[XB_TMO], 1u); break; } }
    }
    nloc = mine > 0u ? mine : 1u; nx = cnt > 0u ? cnt : 1u;
}

__device__ __forceinline__ void xcd_barrier(const XcdBarrier& b) {
    __attribute__((address_space(1))) unsigned* barp = (__attribute__((address_space(1))) unsigned*)b.bar; asm volatile("" : "+s"(barp));
    asm volatile("s_waitcnt vmcnt(0)" ::: "memory");
    __syncthreads();
    if (threadIdx.x == 0) {
        unsigned* bar = (unsigned*)barp;
        __builtin_amdgcn_s_waitcnt(0);
        unsigned nloc = b.st[0], nx = b.st[1];
        if (nloc == 0u) { xcd_barrier_complete(bar, xb_xcc_id(), nloc, nx); b.st[0] = nloc; b.st[1] = nx; }
        const unsigned bx = xb_xcc_id();
        const unsigned old = xb_add(&bar[XB_XSUB(bx)], 1u);
        const unsigned gen = old / nloc;
        if (old + 1u == (gen + 1u) * nloc) {
            __builtin_amdgcn_fence(__ATOMIC_RELEASE, "agent");
            asm volatile("s_waitcnt vmcnt(0)" ::: "memory");
            const unsigned og = xb_add(&bar[XB_TOP], 1u);
            const unsigned tg = og / nx;
            if (og + 1u == (tg + 1u) * nx) xb_add(&bar[XB_TOPGEN], 1u);
            else XB_SPIN(xb_ld(&bar[XB_TOPGEN]) == tg, bar);
            __builtin_amdgcn_fence(__ATOMIC_ACQUIRE, "agent");
            xb_add(&bar[XB_XGEN(bx)], 1u);
            asm volatile("s_waitcnt vmcnt(0)" ::: "memory");
        } else {
            XB_SPIN(xb_ld(&bar[XB_XGEN(bx)]) == gen, bar);
            __builtin_amdgcn_fence(__ATOMIC_ACQUIRE, "agent");
            asm volatile("s_waitcnt vmcnt(0)" ::: "memory");
        }
    }
    __syncthreads();
}


constexpr int BARST_OFF = MOE_LDS_OFF + 1024;
#ifndef REP_KS
#define REP_KS 1
#endif
#ifndef REP_LN2
#define REP_LN2 1
#endif
#ifndef REP_INP
#define REP_INP 1
#endif
#ifndef REP_MOE1
#define REP_MOE1 1
#endif
__global__ void __launch_bounds__(NTHR, 2) mega_fwd(Params p) {
    extern __shared__ __attribute__((aligned(16))) unsigned char lds_[];
    LAS unsigned char* lds = (LAS unsigned char*)lds_;
    const int bid0 = blockIdx.x, G0 = gridDim.x;
    if (threadIdx.x == 0) *(LAS u32x4*)(lds + BARST_OFF) = (u32x4){0u, 0u, 0u, 0u};
    __syncthreads();
    XcdBarrier bar = xcd_barrier_post((unsigned*)(p.ws + WS_CTL) + CW_BAR, (volatile LAS unsigned*)(lds + BARST_OFF));
#define OPQ() do { bid = bid0; G = G0; asm volatile("" : "+s"(bid), "+s"(G)); } while (0)
    int bid, G; OPQ();
    phase_prologue(p, lds, bid, G);
    xcd_barrier(bar);
    for (int l = 0; l < DEPTH; ++l) {
        for (int r_ = 0; r_ < REP_INP; ++r_) { OPQ(); phase_inproj(p, lds, bid, G, l); }
        xcd_barrier(bar);
        for (int r_ = 0; r_ < REP_KS; ++r_) { OPQ(); phase_krope(p, lds, bid, G, l);
        OPQ(); phase_sgu(p, lds, bid, G, l);
        OPQ(); phase_hgrn_local(p, lds, bid, G, l); }
        __syncthreads();
        OPQ(); phase_mla_proj(p, lds, bid, G, l);
        xcd_barrier(bar);
        OPQ(); phase_attn_hgrn(p, lds, l);
        xcd_barrier(bar);
        OPQ(); phase_outproj(p, lds, bid, G, l);
        xcd_barrier(bar);
        OPQ(); phase_ln1_router(p, lds, bid, G, l);
        xcd_barrier(bar);
        for (int r_ = 0; r_ < REP_MOE1; ++r_) { OPQ(); phase_moe1(p, lds, bid, G, l); }
        xcd_barrier(bar);
        OPQ(); phase_moe2(p, lds, bid, G, l);
        xcd_barrier(bar);
        for (int r_ = 0; r_ < REP_LN2; ++r_) { OPQ(); phase_ln2(p, lds, bid, G, l); }
        xcd_barrier(bar);
    }
#undef OPQ
}

extern "C" void kernel_launch(void* const* d_in, const int* in_sizes, int n_in, void* d_out, int out_size, void* d_ws, size_t ws_size, hipStream_t stream) {
    static int grid = 0;
    if (grid == 0) {
        if (n_in != 25 || out_size != NT * DM || ws_size < WS_END) { fprintf(stderr, "kernel_launch: unexpected sizes n_in %d out %d ws %zu (need %zu)\n", n_in, out_size, ws_size, (size_t)WS_END); grid = -1; return; }
        int dev = 0, cus = 0, per_cu = 0;
        if (hipGetDevice(&dev) != hipSuccess || hipDeviceGetAttribute(&cus, hipDeviceAttributeMultiprocessorCount, dev) != hipSuccess) { grid = -1; return; }
        if (hipFuncSetAttribute((const void*)mega_fwd, hipFuncAttributeMaxDynamicSharedMemorySize, LDS_BYTES) != hipSuccess) { fprintf(stderr, "kernel_launch: hipFuncSetAttribute failed\n"); grid = -1; return; }
        if (hipOccupancyMaxActiveBlocksPerMultiprocessor(&per_cu, (const void*)mega_fwd, NTHR, LDS_BYTES) != hipSuccess || per_cu < 1) { fprintf(stderr, "kernel_launch: occupancy query says %d blocks per CU\n", per_cu); (void)hipGetLastError(); grid = -1; return; }
        grid = cus;
    }
    if (grid < 0) return;
    (void)hipMemsetAsync((char*)d_ws + WS_CTL, 0, CTL_BYTES, stream);
    Params p{};
    for (int i = 0; i < 25; ++i) p.in[i] = (const float*)d_in[i];
    p.out = (float*)d_out; p.ws = (unsigned char*)d_ws; p.layer = 0; p.pad = 0;
    hipLaunchKernelGGL(mega_fwd, dim3(grid), dim3(NTHR), LDS_BYTES, stream, p);
}
```

```cpp
#include <hip/hip_runtime.h>
#include <cstdio>
#include <cstdint>

#define DI __device__ __forceinline__
#define LAS __attribute__((address_space(3)))
typedef unsigned short bf16_t;
typedef short bf16x8 __attribute__((ext_vector_type(8)));
typedef short s16x4 __attribute__((ext_vector_type(4)));
typedef float f32x2 __attribute__((ext_vector_type(2)));
typedef float f32x4 __attribute__((ext_vector_type(4)));
typedef float f32x16 __attribute__((ext_vector_type(16)));
typedef unsigned u32x2 __attribute__((ext_vector_type(2)));
typedef unsigned u32x4 __attribute__((ext_vector_type(4)));
typedef __bf16 bf2_t __attribute__((ext_vector_type(2)));

constexpr int DM = 2048, BATCH = 4, SEQ = 4096, NT = BATCH * SEQ, DEPTH = 4;
constexpr int DIN = 4160, DIN_MAIN = 4096;
constexpr int NEXP = 32, DEXP = 512;
constexpr int MAXSLOT = 40960;
constexpr float ALPHA = 1.681792830507429f;
constexpr float EPS = 1e-5f;
constexpr float QSCALE = 0.07216878364870323f * 1.4426950408889634f;

constexpr size_t MiB = 1u << 20;
constexpr size_t al(size_t x) { return (x + MiB - 1) / MiB * MiB; }
constexpr size_t WS_CTL = 0, CTL_BYTES = 1 * MiB;
constexpr size_t WS_WIN = WS_CTL + CTL_BYTES;
constexpr size_t WS_WUQ = WS_WIN + al((size_t)DEPTH * DIN * DM * 2);
constexpr size_t WS_WUK = WS_WUQ + al((size_t)DEPTH * 1536 * 512 * 2);
constexpr size_t WS_WUV = WS_WUK + al((size_t)DEPTH * 1024 * 512 * 2);
constexpr size_t WS_WOUT = WS_WUV + al((size_t)DEPTH * 1024 * 512 * 2);
constexpr size_t WS_WGU = WS_WOUT + al((size_t)DEPTH * DM * DM * 2);
constexpr size_t WS_WD = WS_WGU + al((size_t)DEPTH * NEXP * 1024 * DM * 2);
constexpr size_t WS_SGUW = WS_WD + al((size_t)DEPTH * NEXP * DM * DEXP * 2);
constexpr size_t WS_ROUTW = WS_SGUW + al((size_t)DEPTH * 4 * 128 * 128 * 2);
constexpr size_t WS_ROUTC = WS_ROUTW + al((size_t)DEPTH * 48 * DM * 4);
constexpr size_t WS_LB = WS_ROUTC + MiB;
constexpr size_t WS_COS = WS_LB + MiB;
constexpr size_t WS_XB = WS_COS + al((size_t)NT * 64 * 4);
constexpr size_t WS_Y = WS_XB + al((size_t)NT * DM * 2);
constexpr size_t WS_X1B = WS_Y + al((size_t)NT * DM * 4);
constexpr size_t WS_HB = WS_X1B + al((size_t)NT * DM * 2);
constexpr size_t WS_LOGF = WS_HB + al((size_t)NT * 4096 * 2);
constexpr size_t WS_KR = WS_LOGF + al((size_t)NT * 512 * 4);
constexpr size_t WS_SSQ = WS_KR + al((size_t)NT * 64 * 2);
constexpr size_t WS_Q = WS_SSQ + al((size_t)NT * 16 * 4);
constexpr size_t WS_KN = WS_Q + al((size_t)NT * 1536 * 2);
constexpr size_t WS_VT = WS_KN + al((size_t)NT * 1024 * 2);
constexpr size_t WS_OH = WS_VT + al((size_t)NT * 1024 * 2);
constexpr size_t WS_CAT = WS_OH + al((size_t)NT * 512 * 4);
constexpr size_t WS_ROUTE = WS_CAT + al((size_t)NT * DM * 2);
constexpr size_t WS_TOK = WS_ROUTE + al((size_t)NT * 8 * 4);
constexpr size_t WS_HM = WS_TOK + al((size_t)NEXP * NT * 4);
constexpr size_t WS_YB = WS_HM + al((size_t)MAXSLOT * DEXP * 2);
constexpr size_t WS_HU = WS_YB + al((size_t)MAXSLOT * DM * 2);
constexpr size_t WS_HQG = WS_HU + al((size_t)1024 * 65536);
constexpr size_t WS_HDL = WS_HQG + al((size_t)1024 * 16384);
constexpr size_t WS_END = WS_HDL + al((size_t)1024 * 512);

constexpr int CW_TMO = 0;
constexpr int CW_CNT = 1024;
constexpr int CW_BAR = 8192;

constexpr int MOE_LDS_OFF = 159744;
constexpr int LDS_BYTES = 163840;
constexpr int NTHR = 512;

DI unsigned pk2(float lo, float hi) { bf2_t b = __builtin_convertvector((f32x2){lo, hi}, bf2_t); return __builtin_bit_cast(unsigned, b); }
DI bf16_t f2bf(float f) { return (bf16_t)(pk2(f, 0.f) & 0xffffu); }
DI float bflo(unsigned u) { return __uint_as_float(u << 16); }
DI float bfhi(unsigned u) { return __uint_as_float(u & 0xffff0000u); }
DI float bf2f(bf16_t h) { return __uint_as_float((unsigned)h << 16); }
DI float wave_sum(float v) {
#pragma unroll
    for (int o = 1; o < 64; o <<= 1) v += __shfl_xor(v, o);
    return v;
}
DI int otid() { int t = (int)threadIdx.x; asm volatile("" : "+v"(t)); return t; }
DI float rcp_(float x) { return __builtin_amdgcn_rcpf(x); }
DI float rsq_(float x) { return __builtin_amdgcn_rsqf(x); }
DI float sigmoidf_(float x) { return rcp_(1.0f + __expf(-x)); }
DI float siluf_(float x) { return x * rcp_(1.0f + __expf(-x)); }
DI float geluf_(float x) { const float u = 1.5957691216057308f * (x + 0.044715f * x * x * x); return x * rcp_(1.0f + __expf(-u)); }

struct Params {
    const float* in[25];
    float* out;
    unsigned char* ws;
    int layer;
    int pad;
};
constexpr size_t PTR_TAB_BYTES = 65536;
template <bool DIRECT> DI const float* pinT(const Params& p, unsigned char* ws, int i) {
    if constexpr (DIRECT) return p.in[i];
    else return (const float*)(const __attribute__((address_space(1))) float*)(((const unsigned long long*)(ws + WS_CTL + PTR_TAB_BYTES))[i]);
}
DI unsigned char* ows(const Params& p) { __attribute__((address_space(1))) unsigned char* w = (__attribute__((address_space(1))) unsigned char*)p.ws; asm volatile("" : "+s"(w)); return (unsigned char*)w; }

namespace g8 {
constexpr int BM = 256, BK = 64, HALF = 128, HTB = HALF * BK * 2, STAGE_BYTES = 8 * HTB, NXCD = 8, WGM = 8;
DI int lds_byte(int r, int c) { const int st = (r >> 4) * 2 + (c >> 5), rr = r & 15, cc = c & 31, ob = rr * 64 + cc * 2; return st * 1024 + (ob ^ (((ob >> 9) & 1) << 5)); }
DI void stage_rc(int b, int& R, int& C) { const int st = b / 1024, sb = b % 1024, swz = sb ^ (((sb >> 9) & 1) << 5); R = (st >> 1) * 16 + swz / 64; C = (st & 1) * 32 + (swz % 64) / 2; }
DI int perm32(int rho) { const int n = rho >> 4, i = rho & 15; return 8 * (i >> 2) + 4 * n + (i & 3); }

struct Unit { const char* a; const char* b; int pm, pn, x0, x1; };

struct StaticSched {
    const char* A; const char* Bt; int lda, ldb, nM, nN, nwg, G, c;
    DI void init(const void* A_, const void* Bt_, int M, int N, int lda_, int ldb_, int G_, int c_) { A = (const char*)A_; Bt = (const char*)Bt_; lda = lda_; ldb = ldb_; nM = M / BM; nN = N / BM; nwg = nM * nN; G = G_; c = c_; }
    DI bool next(int i, Unit& u) const {
        const long L = (long)i * G + c; if (L >= nwg) return false;
        int wgid = (int)L; { const int q = nwg / NXCD, r = nwg % NXCD, xcd = wgid % NXCD, off = wgid / NXCD; wgid = (xcd < r ? xcd * (q + 1) : r * (q + 1) + (xcd - r) * q) + off; }
        const int nig = WGM * nN, gid = wgid / nig, fm = gid * WGM, gsz = (nM - fm) < WGM ? (nM - fm) : WGM;
        u.pm = fm + ((wgid % nig) % gsz); u.pn = (wgid % nig) / gsz; u.x0 = 0; u.x1 = 0;
        u.a = A + (size_t)u.pm * BM * lda * 2; u.b = Bt + (size_t)u.pn * BM * ldb * 2; return true;
    }
    DI int tok(const Unit&, int) const { return 0; }
};

template <class Epi, class Sched, bool GATHER>
DI void gemm_phase(LAS unsigned char* lds, const int K, const int lda, const int ldb, const Sched& S, const Epi& E) {
    const int tid = otid(), wid = __builtin_amdgcn_readfirstlane(tid >> 6), lane = tid & 63, wr = wid >> 2, wc = wid & 3, fr = lane & 15, fq = lane >> 4;
    const int nt = K / BK;
    unsigned voffA[2], voffB[2]; int RA[2], CA[2];
#pragma unroll
    for (int i = 0; i < 2; ++i) { int R, C; stage_rc(tid * 16 + i * 8192, R, C); const int Rb = Epi::PERM ? ((R & ~31) + perm32(R & 31)) : R;
        voffA[i] = (unsigned)(R * lda + C) * 2u; voffB[i] = (unsigned)(Rb * ldb + C) * 2u; RA[i] = R; CA[i] = C; }
    const size_t kstep = (size_t)(BK * 2);
    const size_t hstepA = (size_t)HALF * lda * 2, hstep = (size_t)HALF * ldb * 2;
    const unsigned ldsw = (unsigned)wid * 1024u;
    const int aoff = lds_byte(wr * 64 + fr, fq * 8), boff = lds_byte(wc * 32 + fr, fq * 8);
    unsigned gC[2][2], gN[2][2], g2[2][2];
#define G8_SA(b, h) (((b) * 2 + (h)) * HTB)
#define G8_SB(b, h) ((4 + (b) * 2 + (h)) * HTB)
#define G8_DMA(bufoff, ptr, _i) __builtin_amdgcn_global_load_lds((const unsigned*)(ptr), (LAS unsigned*)(lds + (bufoff) + ldsw + (_i) * 8192), 16, 0, 0)
#define G8_STAGE_B(bufoff, gbase) do { _Pragma("unroll") for (int _i = 0; _i < 2; ++_i) G8_DMA(bufoff, (const char*)(gbase) + voffB[_i], _i); } while (0)
#define G8_STAGE_A(bufoff, gbase, h, GO) do { _Pragma("unroll") for (int _i = 0; _i < 2; ++_i) { \
        if constexpr (GATHER) G8_DMA(bufoff, (const char*)(gbase) + GO[h][_i], _i); else G8_DMA(bufoff, (const char*)(gbase) + (h) * hstepA + voffA[_i], _i); } } while (0)
#define G8_LDA(dst, b, h) do { _Pragma("unroll") for (int m = 0; m < 4; ++m) _Pragma("unroll") for (int k = 0; k < 2; ++k) dst[m][k] = *(const LAS bf16x8*)(lds + G8_SA(b, h) + aoff + m * 2048 + k * 1024); } while (0)
#define G8_LDB(dst, b, h) do { _Pragma("unroll") for (int n = 0; n < 2; ++n) _Pragma("unroll") for (int k = 0; k < 2; ++k) dst[n][k] = *(const LAS bf16x8*)(lds + G8_SB(b, h) + boff + n * 2048 + k * 1024); } while (0)
#define G8_MMA(ai, bj, At, Bt) do { __builtin_amdgcn_s_setprio(1); _Pragma("unroll") for (int m = 0; m < 4; ++m) _Pragma("unroll") for (int n = 0; n < 2; ++n) _Pragma("unroll") for (int k = 0; k < 2; ++k) \
        acc[ai][bj][m][n] = __builtin_amdgcn_mfma_f32_16x16x32_bf16(Bt[n][k], At[m][k], acc[ai][bj][m][n], 0, 0, 0); __builtin_amdgcn_s_setprio(0); } while (0)
#define G8_WAIT_V(n) asm volatile("s_waitcnt vmcnt(" #n ")" ::: "memory")
#define G8_WAIT_L(n) asm volatile("s_waitcnt lgkmcnt(" #n ")" ::: "memory")
#define G8_BAR __builtin_amdgcn_s_barrier()
#define G8_SCHED __builtin_amdgcn_sched_barrier(0)
#define G8_GOFF(dst, u) do { if constexpr (GATHER) { _Pragma("unroll") for (int _h = 0; _h < 2; ++_h) _Pragma("unroll") for (int _i = 0; _i < 2; ++_i) \
        dst[_h][_i] = (unsigned)(S.tok(u, _h * HALF + RA[_i]) * lda + CA[_i]) * 2u; } } while (0)
    Unit cur, nxt; int ui = 0;
    if (!S.next(0, cur)) return;
    f32x4 acc[2][2][4][2];
#pragma unroll
    for (int a = 0; a < 2; ++a)
#pragma unroll
        for (int b = 0; b < 2; ++b)
#pragma unroll
            for (int m = 0; m < 4; ++m)
#pragma unroll
                for (int n = 0; n < 2; ++n) acc[a][b][m][n] = (f32x4){0.f, 0.f, 0.f, 0.f};
    bf16x8 At[4][2], B0[2][2], B1[2][2];
    const char* cA = cur.a; const char* cB = cur.b;
#pragma unroll
    for (int h = 0; h < 2; ++h)
#pragma unroll
        for (int i = 0; i < 2; ++i) { gC[h][i] = 0u; gN[h][i] = 0u; g2[h][i] = 0u; }
    G8_GOFF(gC, cur);
    G8_STAGE_B(G8_SB(0, 0), cB); G8_STAGE_B(G8_SB(0, 1), cB + hstep); G8_STAGE_A(G8_SA(0, 0), cA, 0, gC); G8_STAGE_A(G8_SA(0, 1), cA, 1, gC);
    if (wr == 1) G8_BAR;
    G8_WAIT_V(2); G8_BAR;
    G8_STAGE_B(G8_SB(1, 0), cB + kstep); G8_STAGE_A(G8_SA(1, 0), cA + kstep, 0, gC); G8_STAGE_B(G8_SB(1, 1), cB + hstep + kstep);
    G8_WAIT_V(6); G8_BAR;
    for (;;) {
        const bool has_next = S.next(ui + 1, nxt);
        const char* nA = has_next ? nxt.a : cA; const char* nB = has_next ? nxt.b : cB;
        if constexpr (GATHER) { if (has_next) { G8_GOFF(gN, nxt); } else {
#pragma unroll
            for (int h = 0; h < 2; ++h)
#pragma unroll
                for (int i = 0; i < 2; ++i) gN[h][i] = gC[h][i]; } }
        for (int t = 0; t < nt; t += 2) {
            const bool last = (t == nt - 2);
            const char* a1 = cA + (size_t)(t + 1) * kstep;
            const char* a2 = last ? nA : cA + (size_t)(t + 2) * kstep; const char* b2 = last ? nB : cB + (size_t)(t + 2) * kstep;
            const char* a3 = a2 + kstep; const char* b3 = b2 + kstep;
            if constexpr (GATHER) {
#pragma unroll
                for (int h = 0; h < 2; ++h)
#pragma unroll
                    for (int i = 0; i < 2; ++i) g2[h][i] = last ? gN[h][i] : gC[h][i]; }
            G8_LDB(B0, 0, 0); G8_LDB(B1, 0, 1); G8_SCHED; G8_LDA(At, 0, 0); G8_STAGE_A(G8_SA(1, 1), a1, 1, gC);
            G8_WAIT_V(8); G8_WAIT_L(0); G8_BAR; G8_MMA(0, 0, At, B0); G8_MMA(0, 1, At, B1); G8_BAR; G8_SCHED;
            G8_LDA(At, 0, 1); G8_STAGE_B(G8_SB(0, 0), b2); G8_STAGE_B(G8_SB(0, 1), b2 + hstep); G8_STAGE_A(G8_SA(0, 0), a2, 0, g2);
            G8_WAIT_V(8); G8_WAIT_L(0); G8_BAR; G8_MMA(1, 0, At, B0); G8_MMA(1, 1, At, B1); G8_BAR; G8_SCHED;
            G8_LDB(B0, 1, 0); G8_LDB(B1, 1, 1); G8_SCHED; G8_LDA(At, 1, 0); G8_STAGE_A(G8_SA(0, 1), a2, 1, g2);
            G8_WAIT_V(8); G8_WAIT_L(0); G8_BAR; G8_MMA(0, 0, At, B0); G8_MMA(0, 1, At, B1); G8_BAR; G8_SCHED;
            G8_LDA(At, 1, 1); G8_STAGE_B(G8_SB(1, 0), b3); G8_STAGE_B(G8_SB(1, 1), b3 + hstep); G8_STAGE_A(G8_SA(1, 0), a3, 0, g2);
            G8_WAIT_V(8); G8_WAIT_L(0); G8_BAR; G8_MMA(1, 0, At, B0); G8_MMA(1, 1, At, B1); G8_BAR; G8_SCHED;
        }
        if (wr == 0) G8_BAR;
        E(acc, cur, wr, wc, fr, fq);
        if (!has_next) break;
#pragma unroll
        for (int a = 0; a < 2; ++a)
#pragma unroll
            for (int b = 0; b < 2; ++b)
#pragma unroll
                for (int m = 0; m < 4; ++m)
#pragma unroll
                    for (int n = 0; n < 2; ++n) acc[a][b][m][n] = (f32x4){0.f, 0.f, 0.f, 0.f};
        cur = nxt; cA = nA; cB = nB; ++ui;
        if constexpr (GATHER) {
#pragma unroll
            for (int h = 0; h < 2; ++h)
#pragma unroll
                for (int i = 0; i < 2; ++i) gC[h][i] = gN[h][i]; }
        if (wr == 1) G8_BAR;
    }
    G8_WAIT_V(0);
    G8_BAR;
#undef G8_SA
#undef G8_SB
#undef G8_DMA
#undef G8_STAGE_A
#undef G8_STAGE_B
#undef G8_LDA
#undef G8_LDB
#undef G8_MMA
#undef G8_WAIT_V
#undef G8_WAIT_L
#undef G8_BAR
#undef G8_SCHED
#undef G8_GOFF
}
}

enum { I_X = 0, I_POS, I_WIN, I_SGU_LNG, I_SGU_LNB, I_SGU_WS, I_SGU_B, I_LBLOG, I_HNORM, I_QNG, I_WUQ, I_KVNG, I_WUKV, I_WOUT, I_LN1G, I_LN1B,
       I_RGW, I_RGB, I_REW, I_REB, I_EWG, I_EWU, I_EWD, I_LN2G, I_LN2B };

enum { TK_WIN = 0, TK_WUQ, TK_WUKV, TK_WOUT, TK_GATE, TK_UP, TK_DOWN };
struct ConvItem { const float* src; bf16_t* dst0; bf16_t* dst1; const float* sc; int K, N, kind, k0, n0; };
DI void conv_load8(const ConvItem& c, u32x4 (&v)[8], int half, int lane) {
    const int c16 = lane & 15, r4 = lane >> 4;
    const unsigned voff = (unsigned)(((r4 + 32 * half) * c.N + 4 * c16) * 4);
    const char* base = (const char*)(c.src + (size_t)c.k0 * c.N + c.n0);
    const unsigned rstep = (unsigned)c.N * 16u;
#pragma unroll
    for (int i = 0; i < 8; ++i) { const unsigned vo = voff + (unsigned)i * rstep; asm volatile("global_load_dwordx4 %0, %1, %2 nt" : "=v"(v[i]) : "v"(vo), "s"(base) : "memory"); }
}
template <int N> DI void conv_wait(u32x4 (&a)[8], u32x4 (&b)[8]) {
    static_assert(N == 0 || N == 8, "conv_wait");
    if constexpr (N == 8) asm volatile("s_waitcnt vmcnt(8)" : "+v"(a[0]), "+v"(a[1]), "+v"(a[2]), "+v"(a[3]), "+v"(a[4]), "+v"(a[5]), "+v"(a[6]), "+v"(a[7]) :: "memory");
    else asm volatile("s_waitcnt vmcnt(0)" : "+v"(a[0]), "+v"(a[1]), "+v"(a[2]), "+v"(a[3]), "+v"(a[4]), "+v"(a[5]), "+v"(a[6]), "+v"(a[7]) :: "memory");
    asm volatile("" : "+v"(b[0]), "+v"(b[1]), "+v"(b[2]), "+v"(b[3]), "+v"(b[4]), "+v"(b[5]), "+v"(b[6]), "+v"(b[7]) :: "memory");
}
DI void conv_lds_write(const u32x4 (&lo)[8], const u32x4 (&hi)[8], LAS float* scr, int lane) {
    const int c16 = lane & 15, r4 = lane >> 4;
#pragma unroll
    for (int i = 0; i < 8; ++i) { LAS unsigned* d = (LAS unsigned*)scr + (4 * i + r4) * 65 + 4 * c16; d[0] = lo[i].x; d[1] = lo[i].y; d[2] = lo[i].z; d[3] = lo[i].w;
                                  LAS unsigned* e = d + 32 * 65; e[0] = hi[i].x; e[1] = hi[i].y; e[2] = hi[i].z; e[3] = hi[i].w; }
    asm volatile("s_waitcnt lgkmcnt(0)" ::: "memory");
}
DI void conv_out(const ConvItem& ci, LAS float* scr, int lane) {
    const int K = ci.K, kind = ci.kind;
    const int c = lane & 7;
    float s8[8];
#pragma unroll
    for (int i = 0; i < 8; ++i) s8[i] = ci.sc ? ci.sc[ci.k0 + 8 * c + i] : 1.0f;
#pragma unroll
    for (int j = 0; j < 8; ++j) {
        const int nl = (lane >> 3) + 8 * j, n = ci.n0 + nl; const LAS float* s = scr + (8 * c) * 65 + nl;
        u32x4 o; o.x = pk2(s[0 * 65] * s8[0], s[1 * 65] * s8[1]); o.y = pk2(s[2 * 65] * s8[2], s[3 * 65] * s8[3]); o.z = pk2(s[4 * 65] * s8[4], s[5 * 65] * s8[5]); o.w = pk2(s[6 * 65] * s8[6], s[7 * 65] * s8[7]);
        bf16_t* d = ci.dst0; int row = n;
        if (kind == TK_WIN) { if (n >= 4096) { const int jj = n - 4096; row = 4096 + 2 * (jj & 31) + (jj >> 5); } }
        else if (kind == TK_WUQ) { const int h = n / 192, cc = n % 192; if (cc >= 128) { const int jj = cc - 128; row = h * 192 + 128 + 2 * (jj & 31) + (jj >> 5); } }
        else if (kind == TK_WUKV) { const int h = n >> 8, cc = n & 255; if (cc < 128) row = h * 128 + cc; else { d = ci.dst1; row = h * 128 + cc - 128; } }
        else if (kind == TK_GATE) row = (n >> 7) * 256 + (n & 127);
        else if (kind == TK_UP) row = (n >> 7) * 256 + 128 + (n & 127);
        *(u32x4*)(d + (size_t)row * K + ci.k0 + 8 * c) = o;
    }
    asm volatile("s_waitcnt lgkmcnt(0)" ::: "memory");
}

constexpr int IT_WIN = 32 * 65, IT_WUQ = 8 * 24, IT_WUKV = 8 * 32, IT_WOUT = 32 * 32, IT_E = 256, IT_LAYER = IT_WIN + IT_WUQ + IT_WUKV + IT_WOUT + NEXP * 3 * IT_E;
struct ConvPtrs { const float *win, *wuq, *qng, *wukv, *kvng, *wout, *ewg, *ewu, *ewd; };
DI const float* uni_ptr(const float* q) { unsigned long long v = (unsigned long long)q; const unsigned lo = __builtin_amdgcn_readfirstlane((unsigned)v), hi = __builtin_amdgcn_readfirstlane((unsigned)(v >> 32));
    return (const float*)(const __attribute__((address_space(1))) float*)(((unsigned long long)hi << 32) | lo); }
template <bool DIRECT> DI ConvPtrs conv_ptrs(const Params& p, unsigned char* ws) {
    ConvPtrs c; c.win = uni_ptr(pinT<DIRECT>(p, ws, I_WIN)); c.wuq = uni_ptr(pinT<DIRECT>(p, ws, I_WUQ)); c.qng = uni_ptr(pinT<DIRECT>(p, ws, I_QNG)); c.wukv = uni_ptr(pinT<DIRECT>(p, ws, I_WUKV));
    c.kvng = uni_ptr(pinT<DIRECT>(p, ws, I_KVNG)); c.wout = uni_ptr(pinT<DIRECT>(p, ws, I_WOUT)); c.ewg = uni_ptr(pinT<DIRECT>(p, ws, I_EWG)); c.ewu = uni_ptr(pinT<DIRECT>(p, ws, I_EWU)); c.ewd = uni_ptr(pinT<DIRECT>(p, ws, I_EWD));
    return c;
}
DI ConvItem conv_desc(const ConvPtrs& P, unsigned char* ws, int l, int r) {
    ConvItem c; c.dst1 = nullptr; c.sc = nullptr; int item;
    if (r < IT_WIN) { c.src = P.win + (size_t)l * DM * DIN; c.K = DM; c.N = DIN; c.kind = TK_WIN; c.dst0 = (bf16_t*)(ws + WS_WIN) + (size_t)l * DIN * DM; item = r; }
    else if ((r -= IT_WIN) < IT_WUQ) { c.src = P.wuq + (size_t)l * 512 * 1536; c.K = 512; c.N = 1536; c.kind = TK_WUQ; c.dst0 = (bf16_t*)(ws + WS_WUQ) + (size_t)l * 1536 * 512; c.sc = P.qng + l * 512; item = r; }
    else if ((r -= IT_WUQ) < IT_WUKV) { c.src = P.wukv + (size_t)l * 512 * 2048; c.K = 512; c.N = 2048; c.kind = TK_WUKV; c.dst0 = (bf16_t*)(ws + WS_WUK) + (size_t)l * 1024 * 512; c.dst1 = (bf16_t*)(ws + WS_WUV) + (size_t)l * 1024 * 512; c.sc = P.kvng + l * 512; item = r; }
    else if ((r -= IT_WUKV) < IT_WOUT) { c.src = P.wout + (size_t)l * DM * DM; c.K = DM; c.N = DM; c.kind = TK_WOUT; c.dst0 = (bf16_t*)(ws + WS_WOUT) + (size_t)l * DM * DM; item = r; }
    else { r -= IT_WOUT; const int e = r / (3 * IT_E), r2 = r % (3 * IT_E), ty = r2 / IT_E; item = r2 % IT_E; const size_t le = (size_t)l * NEXP + e;
        if (ty == 0) { c.src = P.ewg + le * DM * DEXP; c.K = DM; c.N = DEXP; c.kind = TK_GATE; c.dst0 = (bf16_t*)(ws + WS_WGU) + le * 1024 * DM; }
        else if (ty == 1) { c.src = P.ewu + le * DM * DEXP; c.K = DM; c.N = DEXP; c.kind = TK_UP; c.dst0 = (bf16_t*)(ws + WS_WGU) + le * 1024 * DM; }
        else { c.src = P.ewd + le * DEXP * DM; c.K = DEXP; c.N = DM; c.kind = TK_DOWN; c.dst0 = (bf16_t*)(ws + WS_WD) + le * DM * DEXP; } }
    const int nblk = c.N / 64; c.k0 = 64 * (item / nblk); c.n0 = 64 * (item % nblk);
    return c;
}
template <bool DIRECT> DI void conv_range(const Params& p, unsigned char* ws, int l, int first, int step, int end, LAS float* scr, int lane) {
    if (first >= end) return;
    const ConvPtrs P = conv_ptrs<DIRECT>(p, ws);
    u32x4 X[8], Z[8];
    if constexpr (DIRECT) {
        for (int it = first; it < end; it += step) { const ConvItem c = conv_desc(P, ws, l, it); conv_load8(c, X, 0, lane); conv_load8(c, Z, 1, lane); conv_wait<0>(X, Z); conv_lds_write(X, Z, scr, lane); conv_out(c, scr, lane); }
        return;
    }
    u32x4 Y[8];
    ConvItem ca = conv_desc(P, ws, l, first), cb = ca;
    conv_load8(ca, X, 0, lane); conv_load8(ca, Z, 1, lane);
    for (int it = first; ; it += 2 * step) {
        const bool hb = it + step < end;
        if (hb) { cb = conv_desc(P, ws, l, it + step); conv_load8(cb, Y, 0, lane); conv_wait<8>(X, Z); } else conv_wait<0>(X, Z);
        conv_lds_write(X, Z, scr, lane);
        if (hb) conv_load8(cb, Z, 1, lane);
        conv_out(ca, scr, lane);
        if (!hb) break;
        const bool ha = it + 2 * step < end;
        if (ha) { ca = conv_desc(P, ws, l, it + 2 * step); conv_load8(ca, X, 0, lane); conv_wait<8>(Y, Z); } else conv_wait<0>(Y, Z);
        conv_lds_write(Y, Z, scr, lane);
        if (ha) conv_load8(ca, Z, 1, lane);
        conv_out(cb, scr, lane);
        if (!ha) break;
    }
}
constexpr int CONV_UNIT = 64, N_CONV_UNITS = (IT_LAYER + CONV_UNIT - 1) / CONV_UNIT;
DI void conv_unit(const Params& p, LAS unsigned char* lds, int l, int u) {
    unsigned char* ws = ows(p);
    const int tid = otid(), lane = tid & 63, wave = __builtin_amdgcn_readfirstlane(tid >> 6);
    LAS float* scr = (LAS float*)(lds + wave * 16640);
    const int hi = (u + 1) * CONV_UNIT < IT_LAYER ? (u + 1) * CONV_UNIT : IT_LAYER;
    conv_range<false>(p, ws, l, u * CONV_UNIT + wave, 8, hi, scr, lane);
}

DI void phase_prologue(const Params& p, LAS unsigned char* lds, int bid, int G) {
    const int tid = otid(), lane = tid & 63, wave = __builtin_amdgcn_readfirstlane(tid >> 6);
    unsigned char* ws = ows(p);
    LAS float* scr = (LAS float*)(lds + wave * 16640);
    const int gw = bid * 8 + wave, NGW = G * 8;
    if (bid == 0 && tid < 25) ((unsigned long long*)(ws + WS_CTL + PTR_TAB_BYTES))[tid] = (unsigned long long)p.in[tid];
    conv_range<true>(p, ws, 0, gw, NGW, IT_LAYER, scr, lane);
    const int gt = bid * NTHR + tid, NG = G * NTHR;
    {
        const f32x4* x4 = (const f32x4*)p.in[I_X]; u32x2* xb = (u32x2*)(ws + WS_XB);
        for (int i = gt; i < NT * DM / 4; i += NG) { const f32x4 v = x4[i]; xb[i] = (u32x2){pk2(v.x, v.y), pk2(v.z, v.w)}; }
    }
    {
        float* cs = (float*)(ws + WS_COS); const int* pos = (const int*)p.in[I_POS];
        for (int i = gt; i < NT * 32; i += NG) {
            const int tok = i >> 5, j = i & 31;
            const float inv = 1.0f / powf(10000.0f, (float)(2 * j) / 64.0f);
            const float ang = (float)pos[tok] * inv;
            const double a = (double)ang; const double k = rint(a * 0.15915494309189535); const double rr = a - k * 6.283185307179586476925;
            const float rf = (float)rr;
            cs[i] = cosf(rf); cs[NT * 32 + i] = sinf(rf);
        }
    }
    {
        float* lb = (float*)(ws + WS_LB); const float* lg = p.in[I_LBLOG];
        for (int c = gt; c < 512; c += NG) {
            float v[DEPTH], mx = -3.0e38f;
            for (int l = 0; l < DEPTH; ++l) { v[l] = lg[l * 512 + c]; mx = fmaxf(mx, v[l]); }
            float s = 0.f; for (int l = 0; l < DEPTH; ++l) { v[l] = expf(v[l] - mx); s += v[l]; }
            float cum = 0.f, first = 0.f;
            for (int l = 0; l < DEPTH; ++l) { cum += v[l] / s; if (l == 0) first = cum; lb[l * 512 + c] = cum - first; }
        }
    }
    {
        bf16_t* o = (bf16_t*)(ws + WS_SGUW); const float* w = p.in[I_SGU_WS];
        for (int i = gt; i < DEPTH * 4 * 128 * 128; i += NG) { const int s = i & 127, t = (i >> 7) & 127; o[i] = f2bf(s <= t ? w[i] : 0.f); }
    }
    {
        const float* rgw = p.in[I_RGW]; const float* rew = p.in[I_REW]; const float* l1g = p.in[I_LN1G]; const float* l1b = p.in[I_LN1B]; const float* rgb = p.in[I_RGB]; const float* reb = p.in[I_REB];
        float* rw = (float*)(ws + WS_ROUTW);
        for (int i = gt; i < DEPTH * 48 * DM; i += NG) {
            const int k = i % DM, n = (i / DM) % 48, l = i / (DM * 48);
            float w = 0.f;
            if (n < 4) w = rgw[((size_t)l * DM + k) * 4 + n]; else if (n < 36) w = rew[((size_t)l * DM + k) * 32 + (n - 4)];
            rw[i] = w * l1g[l * DM + k];
        }
        float* rc = (float*)(ws + WS_ROUTC);
        for (int it = gw; it < DEPTH * 48; it += NGW) {
            const int l = it / 48, n = it % 48; float s1 = 0.f, s0 = 0.f;
            if (n < 36) for (int k = lane; k < DM; k += 64) {
                const float w = (n < 4) ? rgw[((size_t)l * DM + k) * 4 + n] : rew[((size_t)l * DM + k) * 32 + (n - 4)];
                s1 += w * l1g[l * DM + k]; s0 += w * l1b[l * DM + k]; }
            s1 = wave_sum(s1); s0 = wave_sum(s0);
            if (lane == 0) { const float bias = (n < 4) ? rgb[l * 4 + n] : (n < 36 ? reb[l * 32 + n - 4] : 0.f); rc[(l * 2 + 0) * 48 + n] = s0 + bias; rc[(l * 2 + 1) * 48 + n] = s1; }
        }
    }
}

struct EpiInProj {
    static constexpr bool PERM = true;
    bf16_t* HB; float* LOGF; float* SSQ; const float* lb;
    template <int KIND> DI void run(const f32x4 (&acc)[2][2][4][2], const g8::Unit& u, int wr, int wc, int fr, int fq) const {
        const int row0 = u.pm * 256 + wr * 64 + fr, col0 = u.pn * 256 + wc * 32 + 8 * fq;
        float lbv[2][8];
        if constexpr (KIND == 2) {
#pragma unroll
            for (int bj = 0; bj < 2; ++bj)
#pragma unroll
                for (int i = 0; i < 8; ++i) lbv[bj][i] = lb[col0 - 1536 + bj * 128 + i];
        }
#pragma unroll
        for (int ai = 0; ai < 2; ++ai)
#pragma unroll
            for (int m = 0; m < 4; ++m) {
                const int row = row0 + ai * 128 + m * 16; float ssq = 0.f;
#pragma unroll
                for (int bj = 0; bj < 2; ++bj) {
                    float v[8];
#pragma unroll
                    for (int i = 0; i < 4; ++i) { v[i] = acc[ai][bj][m][0][i]; v[4 + i] = acc[ai][bj][m][1][i]; }
                    const int col = col0 + bj * 128;
                    if constexpr (KIND == 0) {
#pragma unroll
                        for (int i = 0; i < 8; ++i) v[i] = geluf_(v[i]);
                    } else if constexpr (KIND == 1) {
#pragma unroll
                        for (int i = 0; i < 8; ++i) v[i] = siluf_(v[i]);
                    } else if constexpr (KIND == 2) {
                        float lf[8];
#pragma unroll
                        for (int i = 0; i < 8; ++i) { const float e = __expf(v[i]), l_ = lbv[bj][i];
                            const float f = l_ + (1.0f - l_) * rcp_(1.0f + __expf(-v[i]));
                            lf[i] = __logf(f); v[i] = (1.0f - l_) * rcp_(1.0f + e); }
                        float* lp = LOGF + (size_t)row * 512 + (col - 1536);
                        *(f32x4*)lp = (f32x4){lf[0], lf[1], lf[2], lf[3]}; *(f32x4*)(lp + 4) = (f32x4){lf[4], lf[5], lf[6], lf[7]};
                    } else if constexpr (KIND == 4) {
#pragma unroll
                        for (int i = 0; i < 8; ++i) ssq += v[i] * v[i];
                    }
                    u32x4 w; w.x = pk2(v[0], v[1]); w.y = pk2(v[2], v[3]); w.z = pk2(v[4], v[5]); w.w = pk2(v[6], v[7]);
                    *(u32x4*)(HB + (size_t)row * 4096 + col) = w;
                }
                if constexpr (KIND == 4) {
                    ssq += __shfl_xor(ssq, 16); ssq += __shfl_xor(ssq, 32);
                    if (fq == 0) SSQ[(size_t)row * 16 + (u.pn - 12) * 4 + wc] = ssq;
                }
            }
    }
    DI void operator()(const f32x4 (&acc)[2][2][4][2], const g8::Unit& u, int wr, int wc, int fr, int fq) const {
        const int pn = u.pn;
        if (pn < 4) run<0>(acc, u, wr, wc, fr, fq);
        else if (pn < 6) run<1>(acc, u, wr, wc, fr, fq);
        else if (pn < 8) run<2>(acc, u, wr, wc, fr, fq);
        else if (pn < 10) run<3>(acc, u, wr, wc, fr, fq);
        else if (pn < 12) run<1>(acc, u, wr, wc, fr, fq);
        else run<4>(acc, u, wr, wc, fr, fq);
    }
};
DI void phase_inproj(const Params& p, LAS unsigned char* lds, int bid, int G, int l) {
    unsigned char* ws = ows(p);
    g8::StaticSched S; S.init(ws + WS_XB, (bf16_t*)(ws + WS_WIN) + (size_t)l * DIN * DM, NT, DIN_MAIN, DM, DM, G, bid);
    EpiInProj E{(bf16_t*)(ws + WS_HB), (float*)(ws + WS_LOGF), (float*)(ws + WS_SSQ), (const float*)(ws + WS_LB) + l * 512};
    g8::gemm_phase<EpiInProj, g8::StaticSched, false>(lds, DM, DM, DM, S, E);
}

DI void phase_krope(const Params& p, LAS unsigned char* lds, int bid, int G, int l) {
    unsigned char* ws = ows(p);
    const int tid = otid(), lane = tid & 63, wave = __builtin_amdgcn_readfirstlane(tid >> 6), fr = lane & 15, fq = lane >> 4;
    const bf16_t* X = (const bf16_t*)(ws + WS_XB); const bf16_t* W = (const bf16_t*)(ws + WS_WIN) + ((size_t)l * DIN + 4096) * DM;
    const float* cs = (const float*)(ws + WS_COS); bf16_t* KR = (bf16_t*)(ws + WS_KR);
    LAS float* PART = (LAS float*)lds;
    for (int task = bid; task < NT / 16; task += G) {
        const int r0 = task * 16;
        f32x4 acc[4];
#pragma unroll
        for (int n = 0; n < 4; ++n) acc[n] = (f32x4){0.f, 0.f, 0.f, 0.f};
        const bf16_t* ap = X + (size_t)(r0 + fr) * DM + 256 * wave + 8 * fq;
        const bf16_t* bp = W + (size_t)fr * DM + 256 * wave + 8 * fq;
#pragma unroll
        for (int s2 = 0; s2 < 8; ++s2) {
            const bf16x8 a = *(const bf16x8*)(ap + 32 * s2);
#pragma unroll
            for (int n = 0; n < 4; ++n) { const bf16x8 b = *(const bf16x8*)(bp + (size_t)(16 * n) * DM + 32 * s2); acc[n] = __builtin_amdgcn_mfma_f32_16x16x32_bf16(a, b, acc[n], 0, 0, 0); }
        }
        __syncthreads();
#pragma unroll
        for (int n = 0; n < 4; ++n)
#pragma unroll
            for (int i = 0; i < 4; ++i) PART[(wave * 16 + 4 * fq + i) * 64 + 16 * n + fr] = acc[n][i];
        __syncthreads();
        {
            const int row = tid >> 5, j = tid & 31; float x1 = 0.f, x2 = 0.f;
#pragma unroll
            for (int w = 0; w < 8; ++w) { const f32x2 v = *(const LAS f32x2*)(PART + (w * 16 + row) * 64 + 2 * j); x1 += v.x; x2 += v.y; }
            const size_t grow = (size_t)(r0 + row);
            const float c = cs[grow * 32 + j], sn = cs[(size_t)NT * 32 + grow * 32 + j];
            *(unsigned*)(KR + grow * 64 + 2 * j) = pk2(x1 * c - x2 * sn, x2 * c + x1 * sn);
        }
    }
}

DI void phase_sgu(const Params& p, LAS unsigned char* lds, int bid, int G, int l) {
    unsigned char* ws = ows(p);
    const int tid = otid(), lane = tid & 63, wave = tid >> 6, fr = lane & 15, fq = lane >> 4;
    const bf16_t* HB = (const bf16_t*)(ws + WS_HB); bf16_t* CAT = (bf16_t*)(ws + WS_CAT);
    const bf16_t* SW = (const bf16_t*)(ws + WS_SGUW) + (size_t)l * 4 * 128 * 128;
    const float* lng = pinT<false>(p, ws, I_SGU_LNG) + l * 512; const float* lnb = pinT<false>(p, ws, I_SGU_LNB) + l * 512; const float* sb = pinT<false>(p, ws, I_SGU_B) + l * 512;
    constexpr int TS = 272;
    LAS unsigned char* T = lds;
    for (int unit = bid; unit < 128 * 4; unit += G) {
        const int ci = unit >> 2, g = unit & 3, rbase = ci * 128;
        __syncthreads();
        for (int rr = 0; rr < 4; ++rr) {
            const int s = wave * 16 + rr * 4 + fq, row = rbase + s;
            float v[4][8]; float sm = 0.f;
#pragma unroll
            for (int j = 0; j < 4; ++j) { const u32x4 raw = *(const u32x4*)(HB + (size_t)row * 4096 + 512 + 128 * j + 8 * fr);
                v[j][0] = bflo(raw.x); v[j][1] = bfhi(raw.x); v[j][2] = bflo(raw.y); v[j][3] = bfhi(raw.y); v[j][4] = bflo(raw.z); v[j][5] = bfhi(raw.z); v[j][6] = bflo(raw.w); v[j][7] = bfhi(raw.w);
#pragma unroll
                for (int i = 0; i < 8; ++i) sm += v[j][i]; }
            sm += __shfl_xor(sm, 1); sm += __shfl_xor(sm, 2); sm += __shfl_xor(sm, 4); sm += __shfl_xor(sm, 8);
            const float mean = sm * (1.0f / 512.0f); float sq = 0.f;
#pragma unroll
            for (int j = 0; j < 4; ++j)
#pragma unroll
                for (int i = 0; i < 8; ++i) { v[j][i] -= mean; sq += v[j][i] * v[j][i]; }
            sq += __shfl_xor(sq, 1); sq += __shfl_xor(sq, 2); sq += __shfl_xor(sq, 4); sq += __shfl_xor(sq, 8);
            const float rstd = rsq_(sq * (1.0f / 512.0f) + EPS);
#pragma unroll
            for (int j = 0; j < 4; ++j) if (j == g) {
#pragma unroll
                for (int i = 0; i < 8; ++i) { const int c = 128 * j + 8 * fr + i, d = 8 * fr + i; const float y = v[j][i] * rstd * lng[c] + lnb[c];
                    *(LAS bf16_t*)(T + d * TS + s * 2) = f2bf(y); }
            }
        }
        __syncthreads();
        f32x4 acc[8];
#pragma unroll
        for (int n = 0; n < 8; ++n) acc[n] = (f32x4){0.f, 0.f, 0.f, 0.f};
        const bf16_t* wp = SW + ((size_t)g * 128 + wave * 16 + fr) * 128 + 8 * fq;
        const int ksmax = wave >> 1;
        for (int ks = 0; ks <= ksmax; ++ks) {
            const bf16x8 a = *(const bf16x8*)(wp + 32 * ks);
#pragma unroll
            for (int n = 0; n < 8; ++n) { const bf16x8 b = *(const LAS bf16x8*)(T + (16 * n + fr) * TS + (32 * ks + 8 * fq) * 2); acc[n] = __builtin_amdgcn_mfma_f32_16x16x32_bf16(a, b, acc[n], 0, 0, 0); }
        }
#pragma unroll
        for (int i = 0; i < 4; ++i) {
            const int t = wave * 16 + 4 * fq + i, row = rbase + t; const float bias = sb[g * 128 + t];
#pragma unroll
            for (int n = 0; n < 8; ++n) { const int c = g * 128 + 16 * n + fr; const float uu = bf2f(HB[(size_t)row * 4096 + c]);
                CAT[(size_t)row * DM + c] = f2bf(uu * (acc[n][i] + bias)); }
        }
    }
}

constexpr int HQ_OFF = 0, HK_OFF = 17408, HG_OFF = 34816, HKD_OFF = 52224, HV_OFF = 70656, HP_OFF = 89088, HSEG_OFF = 98304;
constexpr int HS_T = 272, HS_S = 144;
#define HG_BAR() do { asm volatile("s_waitcnt lgkmcnt(0)" ::: "memory"); __builtin_amdgcn_s_barrier(); asm volatile("" ::: "memory"); } while (0)
DI void hgrn_local_unit(const bf16_t* HB, const float* LOGF, float* OI, float* UU, bf16_t* QGg, float* DLg, LAS unsigned char* lds, int b, int h, int c) {
    const int tid = otid(), lane = tid & 63, wave = __builtin_amdgcn_readfirstlane(tid >> 6), fr = lane & 15, fq = lane >> 4;
    const int kp = lane, seg = wave;
    const size_t unit = (size_t)((b * 4 + h) * 64 + c), rowb = (size_t)b * SEQ;
    f32x2 lf[8]; unsigned qr[8], kr[8], vr[8];
#pragma unroll
    for (int i = 0; i < 8; ++i) { const size_t row = rowb + c * 64 + 8 * seg + i;
        lf[i] = *(const f32x2*)(LOGF + row * 512 + h * 128 + 2 * kp); const bf16_t* hp = HB + row * 4096 + h * 128 + 2 * kp;
        qr[i] = *(const unsigned*)(hp + 1024); kr[i] = *(const unsigned*)(hp + 1536); vr[i] = *(const unsigned*)(hp + 2048); }
    __syncthreads();
    if (tid < 128) { const int t = (tid < 64) ? (tid >> 2) : 32 + ((tid - 64) >> 2), s0 = ((tid < 64) ? 16 : 48) + 4 * (tid & 3);
        unsigned z = 0u; asm volatile("" : "+v"(z));
        *(LAS u32x2*)(lds + HP_OFF + t * HS_S + s0 * 2) = (u32x2){z, z}; }
    { float c0 = 0.f, c1 = 0.f;
#pragma unroll
      for (int i = 0; i < 8; ++i) { c0 += lf[i].x; c1 += lf[i].y; lf[i].x = c0; lf[i].y = c1; }
      *(LAS f32x2*)(lds + HSEG_OFF + (seg * 128 + 2 * kp) * 4) = (f32x2){c0, c1}; }
    HG_BAR();
    { f32x2 off = {0.f, 0.f}, R = {0.f, 0.f}, GL = {0.f, 0.f};
#pragma unroll
      for (int j = 0; j < 8; ++j) { const f32x2 tj = *(const LAS f32x2*)(lds + HSEG_OFF + (j * 128 + 2 * kp) * 4); if (j < seg) off += tj; if (j < 4) R += tj; GL += tj; }
      const f32x2 eR = {__expf(R.x), __expf(R.y)}, eGR = {__expf(GL.x - R.x), __expf(GL.y - R.y)};
      float kd0[8], kd1[8];
#pragma unroll
      for (int i = 0; i < 8; ++i) {
          const int t = 8 * seg + i; const float g0 = off.x + lf[i].x, g1 = off.y + lf[i].y;
          const float e10 = __expf(g0 - R.x), e11 = __expf(g1 - R.y), e20 = __expf(R.x - g0), e21 = __expf(R.y - g1), e30 = e10 * eR.x, e31 = e11 * eR.y, e40 = e20 * eGR.x, e41 = e21 * eGR.y;
          const float q0 = bflo(qr[i]), q1 = bfhi(qr[i]), k0 = bflo(kr[i]), k1 = bfhi(kr[i]);
          *(LAS unsigned*)(lds + HQ_OFF + t * HS_T + kp * 4) = pk2(q0 * e10, q1 * e11);
          *(LAS unsigned*)(lds + HK_OFF + t * HS_T + kp * 4) = pk2(k0 * e20, k1 * e21);
          *(LAS unsigned*)(lds + HG_OFF + t * HS_T + kp * 4) = pk2(q0 * e30, q1 * e31);
          kd0[i] = k0 * e40; kd1[i] = k1 * e41;
      }
      *(LAS u32x4*)(lds + HKD_OFF + (2 * kp) * HS_S + 16 * seg) = (u32x4){pk2(kd0[0], kd0[1]), pk2(kd0[2], kd0[3]), pk2(kd0[4], kd0[5]), pk2(kd0[6], kd0[7])};
      *(LAS u32x4*)(lds + HKD_OFF + (2 * kp + 1) * HS_S + 16 * seg) = (u32x4){pk2(kd1[0], kd1[1]), pk2(kd1[2], kd1[3]), pk2(kd1[4], kd1[5]), pk2(kd1[6], kd1[7])};
      u32x4 v0, v1;
      v0.x = (vr[0] & 0xffffu) | (vr[1] << 16); v0.y = (vr[2] & 0xffffu) | (vr[3] << 16); v0.z = (vr[4] & 0xffffu) | (vr[5] << 16); v0.w = (vr[6] & 0xffffu) | (vr[7] << 16);
      v1.x = (vr[0] >> 16) | (vr[1] & 0xffff0000u); v1.y = (vr[2] >> 16) | (vr[3] & 0xffff0000u); v1.z = (vr[4] >> 16) | (vr[5] & 0xffff0000u); v1.w = (vr[6] >> 16) | (vr[7] & 0xffff0000u);
      *(LAS u32x4*)(lds + HV_OFF + (2 * kp) * HS_S + 16 * seg) = v0;
      *(LAS u32x4*)(lds + HV_OFF + (2 * kp + 1) * HS_S + 16 * seg) = v1;
      if (seg == 0) *(f32x2*)(DLg + unit * 128 + 2 * kp) = (f32x2){__expf(GL.x), __expf(GL.y)};
    }
    HG_BAR();
    for (int rep = 0; rep < 2; ++rep) {
        const int idx = wave + 8 * rep; if (idx >= 10) break;
        const int a = (int)((0x3221110000ULL >> (4 * idx)) & 0xf), bt = (int)((0x3323213210ULL >> (4 * idx)) & 0xf);
        f32x4 pacc = {0.f, 0.f, 0.f, 0.f};
#pragma unroll
        for (int ks = 0; ks < 4; ++ks) {
            const bf16x8 af = *(const LAS bf16x8*)(lds + HK_OFF + (16 * a + fr) * HS_T + (32 * ks + 8 * fq) * 2);
            const bf16x8 bf = *(const LAS bf16x8*)(lds + HQ_OFF + (16 * bt + fr) * HS_T + (32 * ks + 8 * fq) * 2);
            pacc = __builtin_amdgcn_mfma_f32_16x16x32_bf16(af, bf, pacc, 0, 0, 0);
        }
        const int t = 16 * bt + fr, s0 = 16 * a + 4 * fq;
#pragma unroll
        for (int i = 0; i < 4; ++i) if (s0 + i > t) pacc[i] = 0.f;
        *(LAS u32x2*)(lds + HP_OFF + t * HS_S + s0 * 2) = (u32x2){pk2(pacc[0], pacc[1]), pk2(pacc[2], pacc[3])};
    }
#pragma unroll
    for (int jj = 0; jj < 2; ++jj) { const int pp = tid + 512 * jj, t = pp >> 4, c16 = pp & 15;
        *(u32x4*)(QGg + unit * 8192 + t * 128 + c16 * 8) = *(const LAS u32x4*)(lds + HG_OFF + t * HS_T + c16 * 16); }
    HG_BAR();
    {
        bf16x8 vf[2];
#pragma unroll
        for (int ss = 0; ss < 2; ++ss) vf[ss] = *(const LAS bf16x8*)(lds + HV_OFF + (16 * wave + fr) * HS_S + (32 * ss + 8 * fq) * 2);
        u32x4* oi = (u32x4*)OI + (unit * 8 + wave) * 2 * 64 + lane;
        f32x4 oacc[4];
#pragma unroll
        for (int bt = 0; bt < 4; ++bt) {
            f32x4 acc = {0.f, 0.f, 0.f, 0.f};
#pragma unroll
            for (int ss = 0; ss < 2; ++ss) if (32 * ss <= 16 * bt + 15) {
                const bf16x8 pf = *(const LAS bf16x8*)(lds + HP_OFF + (16 * bt + fr) * HS_S + (32 * ss + 8 * fq) * 2);
                acc = __builtin_amdgcn_mfma_f32_16x16x32_bf16(pf, vf[ss], acc, 0, 0, 0);
            }
            oacc[bt] = acc;
        }
#pragma unroll
        for (int pr = 0; pr < 2; ++pr) oi[pr * 64] = (u32x4){pk2(oacc[2 * pr][0], oacc[2 * pr][1]), pk2(oacc[2 * pr][2], oacc[2 * pr][3]), pk2(oacc[2 * pr + 1][0], oacc[2 * pr + 1][1]), pk2(oacc[2 * pr + 1][2], oacc[2 * pr + 1][3])};
        u32x4* uu = (u32x4*)UU + (unit * 8 + wave) * 4 * 64 + lane;
        f32x4 uacc[8];
#pragma unroll
        for (int a = 0; a < 8; ++a) {
            f32x4 acc = {0.f, 0.f, 0.f, 0.f};
#pragma unroll
            for (int ss = 0; ss < 2; ++ss) {
                const bf16x8 kf = *(const LAS bf16x8*)(lds + HKD_OFF + (16 * a + fr) * HS_S + (32 * ss + 8 * fq) * 2);
                acc = __builtin_amdgcn_mfma_f32_16x16x32_bf16(kf, vf[ss], acc, 0, 0, 0);
            }
            uacc[a] = acc;
        }
#pragma unroll
        for (int a2 = 0; a2 < 4; ++a2) uu[a2 * 64] = (u32x4){pk2(uacc[2 * a2][0], uacc[2 * a2][1]), pk2(uacc[2 * a2][2], uacc[2 * a2][3]), pk2(uacc[2 * a2 + 1][0], uacc[2 * a2 + 1][1]), pk2(uacc[2 * a2 + 1][2], uacc[2 * a2 + 1][3])};
    }
}
DI void phase_hgrn_local(const Params& p, LAS unsigned char* lds, int bid, int G, int l) {
    unsigned char* ws = ows(p);
    for (int u = bid; u < 1024; u += G) { const int bh = u >> 6, c = u & 63;
        hgrn_local_unit((const bf16_t*)(ws + WS_HB), (const float*)(ws + WS_LOGF), (float*)(ws + WS_OH), (float*)(ws + WS_HU), (bf16_t*)(ws + WS_HQG), (float*)(ws + WS_HDL), lds, bh >> 2, bh & 3, c); }
}
constexpr int SQ_OFF = 0, SOT_OFF = 34816, SSS_OFF = 67584, SDL_OFF = 71680;
struct HsW { u32x4 oi[2], u[4]; };
struct HsQ { u32x4 q[2]; f32x4 d; };
DI void hgrn_seq_unit(const bf16_t* HB, const float* OI, const float* UU, const bf16_t* QGg, const float* DLg, const float* ng, bf16_t* CAT, LAS unsigned char* lds, int b, int h) {
    const int tid = otid(), lane = tid & 63, wave = __builtin_amdgcn_readfirstlane(tid >> 6), fr = lane & 15, fq = lane >> 4;
    const size_t unit0 = (size_t)((b * 4 + h) * 64), rowb = (size_t)b * SEQ;
    f32x4 S[8];
#pragma unroll
    for (int a = 0; a < 8; ++a) S[a] = (f32x4){0.f, 0.f, 0.f, 0.f};
    HsW w0, w1, w2; HsQ q1, q2; u32x4 g0[2], g1[2];
    w2 = HsW{}; q2 = HsQ{};
#define HS_LOADW(W, c) do { const size_t un = unit0 + (c); const u32x4* oi_ = (const u32x4*)OI + (un * 8 + wave) * 2 * 64 + lane; const u32x4* uu_ = (const u32x4*)UU + (un * 8 + wave) * 4 * 64 + lane; \
        asm volatile("" : "+v"(oi_), "+v"(uu_)); W.oi[0] = oi_[0]; W.oi[1] = oi_[64]; W.u[0] = uu_[0]; W.u[1] = uu_[64]; W.u[2] = uu_[128]; W.u[3] = uu_[192]; } while (0)
#define HS_LOADQ(Qs, c) do { _Pragma("unroll") for (int jj = 0; jj < 2; ++jj) { const int pp = tid + 512 * jj; Qs.q[jj] = *(const u32x4*)(QGg + (unit0 + (c)) * 8192 + (pp >> 4) * 128 + (pp & 15) * 8); } \
        Qs.d = (tid < 32) ? *(const f32x4*)(DLg + (unit0 + (c)) * 128 + 4 * (tid & 31)) : (f32x4){0.f, 0.f, 0.f, 0.f}; } while (0)
#define HS_STOREQ(Qs, buf) do { _Pragma("unroll") for (int jj = 0; jj < 2; ++jj) { const int pp = tid + 512 * jj; *(LAS u32x4*)(lds + SQ_OFF + (buf) * 17408 + (pp >> 4) * HS_T + (pp & 15) * 16) = Qs.q[jj]; } \
        if (tid < 32) *(LAS f32x4*)(lds + SDL_OFF + (buf) * 512 + tid * 16) = Qs.d; } while (0)
#define HS_LOADG(Gs, c) do { _Pragma("unroll") for (int jj = 0; jj < 2; ++jj) Gs[jj] = *(const u32x4*)(HB + (rowb + (c) * 64 + (lane >> 1) + 32 * jj) * 4096 + 2560 + h * 128 + 16 * wave + 8 * (lane & 1)); } while (0)
    const int v0 = h * 128 + 16 * wave + 8 * (lane & 1);
    const f32x4 gn0 = *(const f32x4*)(ng + v0), gn1 = *(const f32x4*)(ng + v0 + 4);
    __syncthreads();
    HS_LOADQ(q1, 0); HS_LOADW(w0, 0); HS_LOADG(g0, 0);
    HS_STOREQ(q1, 0);
    HS_LOADQ(q1, 1); HS_LOADW(w1, 1);
    HG_BAR();
    for (int c = 0; c < SEQ / 64; ++c) {
        const int buf = c & 1;
        if (c + 2 < SEQ / 64) { HS_LOADQ(q2, c + 2); HS_LOADW(w2, c + 2); }
        if (c + 1 < SEQ / 64) HS_LOADG(g1, c + 1);
        f32x4 o[4];
        {
            bf16x8 sf[4];
#pragma unroll
            for (int a2 = 0; a2 < 4; ++a2) { const u32x4 w = {pk2(S[2 * a2][0], S[2 * a2][1]), pk2(S[2 * a2][2], S[2 * a2][3]), pk2(S[2 * a2 + 1][0], S[2 * a2 + 1][1]), pk2(S[2 * a2 + 1][2], S[2 * a2 + 1][3])}; sf[a2] = __builtin_bit_cast(bf16x8, w); }
#pragma unroll
            for (int bt = 0; bt < 4; ++bt) {
                const u32x4 ow = w0.oi[bt >> 1];
                f32x4 acc = (bt & 1) ? (f32x4){bflo(ow.z), bfhi(ow.z), bflo(ow.w), bfhi(ow.w)} : (f32x4){bflo(ow.x), bfhi(ow.x), bflo(ow.y), bfhi(ow.y)};
#pragma unroll
                for (int a2 = 0; a2 < 4; ++a2) {
                    const LAS unsigned char* gp = lds + SQ_OFF + buf * 17408 + (16 * bt + fr) * HS_T + (32 * a2 + 4 * fq) * 2;
                    const u32x2 lo = *(const LAS u32x2*)gp, hi = *(const LAS u32x2*)(gp + 32);
                    const u32x4 w = {lo.x, lo.y, hi.x, hi.y};
                    acc = __builtin_amdgcn_mfma_f32_16x16x32_bf16(__builtin_bit_cast(bf16x8, w), sf[a2], acc, 0, 0, 0);
                }
                o[bt] = acc;
            }
#pragma unroll
            for (int a = 0; a < 8; ++a) { const u32x4 uw = w0.u[a >> 1];
                const f32x4 uv = (a & 1) ? (f32x4){bflo(uw.z), bfhi(uw.z), bflo(uw.w), bfhi(uw.w)} : (f32x4){bflo(uw.x), bfhi(uw.x), bflo(uw.y), bfhi(uw.y)};
                S[a] = S[a] * *(const LAS f32x4*)(lds + SDL_OFF + buf * 512 + (16 * a + 4 * fq) * 4) + uv; }
        }
        LAS unsigned char* ot = lds + SOT_OFF + wave * 4096;
#pragma unroll
        for (int bt = 0; bt < 4; ++bt)
#pragma unroll
            for (int i = 0; i < 4; ++i) *(LAS float*)(ot + (16 * bt + 4 * fq + i) * 64 + fr * 4) = o[bt][i];
        asm volatile("s_waitcnt lgkmcnt(0)" ::: "memory");
        f32x4 orow[2][2];
#pragma unroll
        for (int jj = 0; jj < 2; ++jj) {
            const LAS unsigned char* rp = ot + ((lane >> 1) + 32 * jj) * 64 + (lane & 1) * 32;
            orow[jj][0] = *(const LAS f32x4*)rp; orow[jj][1] = *(const LAS f32x4*)(rp + 16);
            const f32x4 a = orow[jj][0], bb = orow[jj][1];
            float q2s = (a.x * a.x + a.y * a.y) + (a.z * a.z + a.w * a.w) + (bb.x * bb.x + bb.y * bb.y) + (bb.z * bb.z + bb.w * bb.w);
            q2s += __shfl_xor(q2s, 1);
            if ((lane & 1) == 0) *(LAS float*)(lds + SSS_OFF + buf * 2048 + (((lane >> 1) + 32 * jj) * 8 + wave) * 4) = q2s;
        }
        if (c + 1 < SEQ / 64) HS_STOREQ(q1, buf ^ 1);
        HG_BAR();
#pragma unroll
        for (int jj = 0; jj < 2; ++jj) {
            const int t = (lane >> 1) + 32 * jj;
            const LAS float* sp = (const LAS float*)(lds + SSS_OFF + buf * 2048 + t * 32);
            const f32x4 s0 = *(const LAS f32x4*)sp, s1 = *(const LAS f32x4*)(sp + 4);
            const float ssum = (s0.x + s0.y) + (s0.z + s0.w) + (s1.x + s1.y) + (s1.z + s1.w);
            const float rstd = rsq_(ssum * (1.0f / 128.0f) + EPS);
            const u32x4 g = g0[jj];
            const f32x4 y0 = orow[jj][0] * rstd * gn0 * (f32x4){bflo(g.x), bfhi(g.x), bflo(g.y), bfhi(g.y)};
            const f32x4 y1 = orow[jj][1] * rstd * gn1 * (f32x4){bflo(g.z), bfhi(g.z), bflo(g.w), bfhi(g.w)};
            *(u32x4*)(CAT + (rowb + c * 64 + t) * DM + 512 + v0) = (u32x4){pk2(y0.x, y0.y), pk2(y0.z, y0.w), pk2(y1.x, y1.y), pk2(y1.z, y1.w)};
        }
        w0 = w1; w1 = w2; q1 = q2; g0[0] = g1[0]; g0[1] = g1[1];
    }
#undef HS_LOADQ
#undef HS_STOREQ
#undef HS_LOADW
#undef HS_LOADG
}
#undef HG_BAR

DI float rstd_from_ssq(const float* SSQ, int row, int which) {
    const f32x4 a = *(const f32x4*)(SSQ + (size_t)row * 16 + which * 8), b = *(const f32x4*)(SSQ + (size_t)row * 16 + which * 8 + 4);
    const float s = (a.x + a.y) + (a.z + a.w) + (b.x + b.y) + (b.z + b.w);
    return rsq_(s * (1.0f / 512.0f) + EPS);
}
struct EpiQ {
    static constexpr bool PERM = true;
    bf16_t* Q; const float* SSQ; const float* cs;
    DI void operator()(const f32x4 (&acc)[2][2][4][2], const g8::Unit& u, int wr, int wc, int fr, int fq) const {
        const int row0 = u.pm * 256 + wr * 64 + fr, col0 = u.pn * 256 + wc * 32 + 8 * fq;
#pragma unroll
        for (int ai = 0; ai < 2; ++ai)
#pragma unroll
            for (int m = 0; m < 4; ++m) {
                const int row = row0 + ai * 128 + m * 16; const float sc = rstd_from_ssq(SSQ, row, 0) * QSCALE;
#pragma unroll
                for (int bj = 0; bj < 2; ++bj) {
                    const int col = col0 + bj * 128, cc = col % 192;
                    float v[8];
#pragma unroll
                    for (int i = 0; i < 4; ++i) { v[i] = acc[ai][bj][m][0][i] * sc; v[4 + i] = acc[ai][bj][m][1][i] * sc; }
                    if (cc >= 128) {
                        const int j0 = (cc - 128) >> 1;
                        const f32x4 c = *(const f32x4*)(cs + (size_t)row * 32 + j0), s = *(const f32x4*)(cs + (size_t)NT * 32 + (size_t)row * 32 + j0);
#pragma unroll
                        for (int i = 0; i < 4; ++i) { const float x1 = v[2 * i], x2 = v[2 * i + 1]; v[2 * i] = x1 * c[i] - x2 * s[i]; v[2 * i + 1] = x2 * c[i] + x1 * s[i]; }
                    }
                    u32x4 w; w.x = pk2(v[0], v[1]); w.y = pk2(v[2], v[3]); w.z = pk2(v[4], v[5]); w.w = pk2(v[6], v[7]);
                    *(u32x4*)(Q + (size_t)row * 1536 + col) = w;
                }
            }
    }
};
struct EpiK {
    static constexpr bool PERM = true;
    bf16_t* KN; const float* SSQ;
    DI void operator()(const f32x4 (&acc)[2][2][4][2], const g8::Unit& u, int wr, int wc, int fr, int fq) const {
        const int row0 = u.pm * 256 + wr * 64 + fr, col0 = u.pn * 256 + wc * 32 + 8 * fq;
#pragma unroll
        for (int ai = 0; ai < 2; ++ai)
#pragma unroll
            for (int m = 0; m < 4; ++m) {
                const int row = row0 + ai * 128 + m * 16; const float sc = rstd_from_ssq(SSQ, row, 1);
#pragma unroll
                for (int bj = 0; bj < 2; ++bj) {
                    const f32x4 v0 = acc[ai][bj][m][0] * sc, v1 = acc[ai][bj][m][1] * sc;
                    u32x4 w; w.x = pk2(v0[0], v0[1]); w.y = pk2(v0[2], v0[3]); w.z = pk2(v1[0], v1[1]); w.w = pk2(v1[2], v1[3]);
                    *(u32x4*)(KN + (size_t)row * 1024 + col0 + bj * 128) = w;
                }
            }
    }
};
struct EpiVT {
    static constexpr bool PERM = true;
    bf16_t* VT; const float* SSQ;
    DI void operator()(const f32x4 (&acc)[2][2][4][2], const g8::Unit& u, int wr, int wc, int fr, int fq) const {
        const int row0 = u.pm * 256 + wr * 64 + fr, col0 = u.pn * 256 + wc * 32 + 8 * fq;
        float sc[2][8];
#pragma unroll
        for (int bj = 0; bj < 2; ++bj)
#pragma unroll
            for (int i = 0; i < 8; ++i) sc[bj][i] = rstd_from_ssq(SSQ, col0 + bj * 128 + i, 1);
#pragma unroll
        for (int ai = 0; ai < 2; ++ai)
#pragma unroll
            for (int m = 0; m < 4; ++m) {
                const int row = row0 + ai * 128 + m * 16, h = row >> 7, d = row & 127;
#pragma unroll
                for (int bj = 0; bj < 2; ++bj) {
                    const int tok = col0 + bj * 128, b = tok >> 12, s = tok & 4095;
                    const f32x4 a0 = acc[ai][bj][m][0], a1 = acc[ai][bj][m][1];
                    u32x4 w; w.x = pk2(a0[0] * sc[bj][0], a0[1] * sc[bj][1]); w.y = pk2(a0[2] * sc[bj][2], a0[3] * sc[bj][3]);
                    w.z = pk2(a1[0] * sc[bj][4], a1[1] * sc[bj][5]); w.w = pk2(a1[2] * sc[bj][6], a1[3] * sc[bj][7]);
                    *(u32x4*)(VT + ((size_t)((b * 8 + h) * 128 + d)) * SEQ + s) = w;
                }
            }
    }
};
DI void phase_mla_proj(const Params& p, LAS unsigned char* lds, int bid, int G, int l) {
    unsigned char* ws = ows(p);
    const float* SSQ = (const float*)(ws + WS_SSQ); const bf16_t* HB = (const bf16_t*)(ws + WS_HB);
    {
        g8::StaticSched S; S.init(HB + 3072, (const bf16_t*)(ws + WS_WUQ) + (size_t)l * 1536 * 512, NT, 1536, 4096, 512, G, bid);
        EpiQ E{(bf16_t*)(ws + WS_Q), SSQ, (const float*)(ws + WS_COS)};
        g8::gemm_phase<EpiQ, g8::StaticSched, false>(lds, 512, 4096, 512, S, E);
    }
    {
        g8::StaticSched S; S.init(HB + 3584, (const bf16_t*)(ws + WS_WUK) + (size_t)l * 1024 * 512, NT, 1024, 4096, 512, G, bid);
        EpiK E{(bf16_t*)(ws + WS_KN), SSQ};
        g8::gemm_phase<EpiK, g8::StaticSched, false>(lds, 512, 4096, 512, S, E);
    }
    {
        g8::StaticSched S; S.init((const bf16_t*)(ws + WS_WUV) + (size_t)l * 1024 * 512, HB + 3584, 1024, NT, 512, 4096, G, bid);
        EpiVT E{(bf16_t*)(ws + WS_VT), SSQ};
        g8::gemm_phase<EpiVT, g8::StaticSched, false>(lds, 512, 512, 4096, S, E);
    }
}

constexpr int AT_KS = 400, AT_VS = 144;
constexpr int AT_KBUF = 64 * AT_KS, AT_VBUF = 128 * AT_VS;
DI void attn_unit(const bf16_t* Qg, const bf16_t* KNg, const bf16_t* KRg, const bf16_t* VTg, bf16_t* CAT, LAS unsigned char* lds, int b, int h, int qb) {
    const int tid = otid(), lane = tid & 63, wave = __builtin_amdgcn_readfirstlane(tid >> 6), c = lane & 31, hi = lane >> 5;
    const int q0 = qb * 256, qmin = q0 + 32 * wave, qrow = qmin + c, ntile = 4 * (qb + 1), jmax = (qmin + 31) >> 6;
    LAS unsigned char* Kb = lds; LAS unsigned char* Vb = lds + 2 * AT_KBUF;
    bf16x8 qf[12];
    { const bf16_t* qp = Qg + (size_t)(b * SEQ + qrow) * 1536 + h * 192 + 8 * hi;
#pragma unroll
      for (int ks = 0; ks < 12; ++ks) qf[ks] = *(const bf16x8*)(qp + 16 * ks); }
    f32x16 o[4];
#pragma unroll
    for (int d = 0; d < 4; ++d)
#pragma unroll
        for (int r = 0; r < 16; ++r) o[d][r] = 0.f;
    float m_run = -1.0e30f, l_run = 0.f;
    int ksrc_off[3], kdst[3]; bool kfromR[3];
#pragma unroll
    for (int i = 0; i < 3; ++i) { const int id = tid + 512 * i, key = id / 24, cc = id % 24; kdst[i] = key * AT_KS + cc * 16; kfromR[i] = cc >= 16;
        ksrc_off[i] = kfromR[i] ? (key * 64 + 8 * (cc - 16)) : (key * 1024 + h * 128 + 8 * cc); }
    int vsrc_off[2], vdst[2];
#pragma unroll
    for (int i = 0; i < 2; ++i) { const int id = tid + 512 * i, d = id >> 3, cc = id & 7; vdst[i] = d * AT_VS + (cc >> 1) * 32 + (cc & 1) * 8; vsrc_off[i] = d * SEQ + 8 * cc; }
    const bf16_t* KNb = KNg + (size_t)b * SEQ * 1024; const bf16_t* KRb = KRg + (size_t)b * SEQ * 64; const bf16_t* VTb = VTg + (size_t)(b * 8 + h) * 128 * SEQ;
    u32x4 kreg[3], vreg[2];
#define AT_LOAD(j) do { _Pragma("unroll") for (int i = 0; i < 3; ++i) kreg[i] = kfromR[i] ? *(const u32x4*)(KRb + (size_t)(j) * 64 * 64 + ksrc_off[i]) : *(const u32x4*)(KNb + (size_t)(j) * 64 * 1024 + ksrc_off[i]); \
                        _Pragma("unroll") for (int i = 0; i < 2; ++i) vreg[i] = *(const u32x4*)(VTb + (size_t)(j) * 64 + vsrc_off[i]); } while (0)
#define AT_STORE(buf) do { _Pragma("unroll") for (int i = 0; i < 3; ++i) *(LAS u32x4*)(Kb + (buf) * AT_KBUF + kdst[i]) = kreg[i]; \
                           _Pragma("unroll") for (int i = 0; i < 2; ++i) { *(LAS u32x2*)(Vb + (buf) * AT_VBUF + vdst[i]) = (u32x2){vreg[i].x, vreg[i].y}; *(LAS u32x2*)(Vb + (buf) * AT_VBUF + vdst[i] + 16) = (u32x2){vreg[i].z, vreg[i].w}; } } while (0)
    __syncthreads();
    AT_LOAD(0); AT_STORE(0);
    __syncthreads();
    for (int j = 0; j < ntile; ++j) {
        const int buf = j & 1;
        if (j + 1 < ntile) AT_LOAD(j + 1);
        if (j <= jmax) {
            const LAS unsigned char* kb_ = Kb + buf * AT_KBUF + c * AT_KS + 16 * hi;
            f32x16 s0, s1;
#pragma unroll
            for (int r = 0; r < 16; ++r) { s0[r] = 0.f; s1[r] = 0.f; }
#pragma unroll
            for (int ks = 0; ks < 12; ++ks) {
                const bf16x8 a0 = *(const LAS bf16x8*)(kb_ + 32 * ks), a1 = *(const LAS bf16x8*)(kb_ + 32 * AT_KS + 32 * ks);
                s0 = __builtin_amdgcn_mfma_f32_32x32x16_bf16(a0, qf[ks], s0, 0, 0, 0);
                s1 = __builtin_amdgcn_mfma_f32_32x32x16_bf16(a1, qf[ks], s1, 0, 0, 0);
            }
            if (64 * j + 63 > qmin) {
                const int dq = qrow - 64 * j - 4 * hi;
#pragma unroll
                for (int r = 0; r < 16; ++r) { const int kk = (r & 3) + 8 * (r >> 2);
                    if (kk > dq) s0[r] = -__builtin_inff();
                    if (kk + 32 > dq) s1[r] = -__builtin_inff(); }
            }
            float mx = s0[0];
#pragma unroll
            for (int r = 1; r < 16; ++r) mx = fmaxf(mx, s0[r]);
#pragma unroll
            for (int r = 0; r < 16; ++r) mx = fmaxf(mx, s1[r]);
            { auto rr = __builtin_amdgcn_permlane32_swap(__float_as_uint(mx), __float_as_uint(mx), false, false); mx = fmaxf(__uint_as_float(rr[0]), __uint_as_float(rr[1])); }
            if (!__all(mx - m_run <= 8.0f)) {
                const float m_new = fmaxf(m_run, mx), alpha = __builtin_amdgcn_exp2f(m_run - m_new);
                m_run = m_new; l_run *= alpha;
#pragma unroll
                for (int d = 0; d < 4; ++d)
#pragma unroll
                    for (int r = 0; r < 16; ++r) o[d][r] *= alpha;
            }
            float ps = 0.f;
#pragma unroll
            for (int r = 0; r < 16; ++r) { s0[r] = __builtin_amdgcn_exp2f(s0[r] - m_run); s1[r] = __builtin_amdgcn_exp2f(s1[r] - m_run); ps += s0[r] + s1[r]; }
            l_run += ps;
            bf16x8 pb[4];
#pragma unroll
            for (int s2 = 0; s2 < 2; ++s2) {
                u32x4 w0, w1;
                w0.x = pk2(s0[8 * s2 + 0], s0[8 * s2 + 1]); w0.y = pk2(s0[8 * s2 + 2], s0[8 * s2 + 3]); w0.z = pk2(s0[8 * s2 + 4], s0[8 * s2 + 5]); w0.w = pk2(s0[8 * s2 + 6], s0[8 * s2 + 7]);
                w1.x = pk2(s1[8 * s2 + 0], s1[8 * s2 + 1]); w1.y = pk2(s1[8 * s2 + 2], s1[8 * s2 + 3]); w1.z = pk2(s1[8 * s2 + 4], s1[8 * s2 + 5]); w1.w = pk2(s1[8 * s2 + 6], s1[8 * s2 + 7]);
                pb[s2] = __builtin_bit_cast(bf16x8, w0); pb[2 + s2] = __builtin_bit_cast(bf16x8, w1);
            }
            const LAS unsigned char* vb_ = Vb + buf * AT_VBUF + c * AT_VS + 16 * hi;
#pragma unroll
            for (int d = 0; d < 4; ++d)
#pragma unroll
                for (int kk = 0; kk < 4; ++kk) {
                    const bf16x8 av = *(const LAS bf16x8*)(vb_ + d * 32 * AT_VS + kk * 32);
                    o[d] = __builtin_amdgcn_mfma_f32_32x32x16_bf16(av, pb[kk], o[d], 0, 0, 0);
                }
        }
        if (j + 1 < ntile) AT_STORE(buf ^ 1);
        __syncthreads();
    }
#undef AT_LOAD
#undef AT_STORE
    float l_tot; { auto rr = __builtin_amdgcn_permlane32_swap(__float_as_uint(l_run), __float_as_uint(l_run), false, false); l_tot = __uint_as_float(rr[0]) + __uint_as_float(rr[1]); }
    const float inv = rcp_(l_tot);
    bf16_t* op = CAT + (size_t)(b * SEQ + qrow) * DM + 1024 + h * 128 + 4 * hi;
#pragma unroll
    for (int d = 0; d < 4; ++d)
#pragma unroll
        for (int g = 0; g < 4; ++g) {
            const u32x2 w = {pk2(o[d][4 * g] * inv, o[d][4 * g + 1] * inv), pk2(o[d][4 * g + 2] * inv, o[d][4 * g + 3] * inv)};
            *(u32x2*)(op + 32 * d + 8 * g) = w;
        }
}
constexpr int CW_QUEUE = 4096;
constexpr int QWORD_OFF = MOE_LDS_OFF + 2048;
constexpr int KCONV = 10;
DI int q_pop(unsigned* head, LAS unsigned char* lds) {
    __syncthreads();
    if (threadIdx.x == 0) *(LAS unsigned*)(lds + QWORD_OFF) = atomicAdd(head, 1u);
    __syncthreads();
    return __builtin_amdgcn_readfirstlane((int)*(LAS unsigned*)(lds + QWORD_OFF));
}
DI void phase_attn_hgrn(const Params& p, LAS unsigned char* lds, int l) {
    unsigned char* ws0 = ows(p);
    unsigned* qa = (unsigned*)(ws0 + WS_CTL) + CW_QUEUE + (l * 3 + 0) * 8 * 16; unsigned* qc = qa + 8 * 16; unsigned* qr = qc + 8 * 16;
    const int x0 = (int)(__builtin_amdgcn_s_getreg((3 << 11) | 20) & 7u);
    const bool has_conv = l + 1 < DEPTH;
    bool conv_first = false;
    if (has_conv) conv_first = q_pop(qr + x0 * 16, lds) < KCONV;
    for (int pass = 0; pass < 2; ++pass) {
        const bool do_conv = (pass == 0) == conv_first;
        if (do_conv && !has_conv) continue;
        for (int dx = 0; dx < 8; ++dx) {
            const int x = (x0 + dx) & 7;
            if (do_conv) {
                const int ncv = (N_CONV_UNITS - x + 7) / 8;
                for (;;) { const int idx = q_pop(qc + x * 16, lds); if (idx >= ncv) break; conv_unit(p, lds, l + 1, x + 8 * idx); }
            } else {
                for (;;) {
                    const int idx = q_pop(qa + x * 16, lds); if (idx >= 66) break;
                    unsigned char* ws = ows(p);
                    if (idx < 2) { const int bh = 2 * x + idx; hgrn_seq_unit((const bf16_t*)(ws + WS_HB), (const float*)(ws + WS_OH), (const float*)(ws + WS_HU), (const bf16_t*)(ws + WS_HQG), (const float*)(ws + WS_HDL),
                                                                               pinT<false>(p, ws, I_HNORM) + l * 512, (bf16_t*)(ws + WS_CAT), lds, bh >> 2, bh & 3); }
                    else { const int j = idx - 2, bh = 4 * x + (j & 3), qb = 15 - (j >> 2);
                           attn_unit((const bf16_t*)(ws + WS_Q), (const bf16_t*)(ws + WS_KN), (const bf16_t*)(ws + WS_KR), (const bf16_t*)(ws + WS_VT), (bf16_t*)(ws + WS_CAT), lds, bh >> 3, bh & 7, qb); }
                }
            }
        }
    }
}

struct EpiOut {
    static constexpr bool PERM = true;
    const float* xres; const bf16_t* xb; float* Y;
    DI void operator()(const f32x4 (&acc)[2][2][4][2], const g8::Unit& u, int wr, int wc, int fr, int fq) const {
        const int row0 = u.pm * 256 + wr * 64 + fr, col0 = u.pn * 256 + wc * 32 + 8 * fq;
#pragma unroll
        for (int ai = 0; ai < 2; ++ai)
#pragma unroll
            for (int m = 0; m < 4; ++m) {
                const size_t rb = (size_t)(row0 + ai * 128 + m * 16) * DM;
#pragma unroll
                for (int bj = 0; bj < 2; ++bj) {
                    const int col = col0 + bj * 128; f32x4 x0, x1;
                    if (xres) { x0 = *(const f32x4*)(xres + rb + col); x1 = *(const f32x4*)(xres + rb + col + 4); }
                    else { const u32x4 r = *(const u32x4*)(xb + rb + col); x0 = (f32x4){bflo(r.x), bfhi(r.x), bflo(r.y), bfhi(r.y)}; x1 = (f32x4){bflo(r.z), bfhi(r.z), bflo(r.w), bfhi(r.w)}; }
                    *(f32x4*)(Y + rb + col) = x0 * ALPHA + acc[ai][bj][m][0]; *(f32x4*)(Y + rb + col + 4) = x1 * ALPHA + acc[ai][bj][m][1];
                }
            }
    }
};
DI void phase_outproj(const Params& p, LAS unsigned char* lds, int bid, int G, int l) {
    unsigned char* ws = ows(p);
    g8::StaticSched S; S.init(ws + WS_CAT, (const bf16_t*)(ws + WS_WOUT) + (size_t)l * DM * DM, NT, DM, DM, DM, G, bid);
    EpiOut E{l == 0 ? pinT<false>(p, ws, I_X) : nullptr, (const bf16_t*)(ws + WS_XB), (float*)(ws + WS_Y)};
    g8::gemm_phase<EpiOut, g8::StaticSched, false>(lds, DM, DM, DM, S, E);
}

constexpr int L1_RS = 8208;
constexpr int L1_PART = 16 * L1_RS, L1_STAT = L1_PART + 8 * 16 * 48 * 4, L1_LG = L1_STAT + 128;
static_assert(L1_LG + 16 * 48 * 4 <= MOE_LDS_OFF, "ln1 LDS map");
DI void phase_ln1_router(const Params& p, LAS unsigned char* lds, int bid, int G, int l) {
    unsigned char* ws = ows(p);
    const int tid = otid(), lane = tid & 63, wave = __builtin_amdgcn_readfirstlane(tid >> 6), fr = lane & 15, fq = lane >> 4;
    float* Y = (float*)(ws + WS_Y); bf16_t* X1B = (bf16_t*)(ws + WS_X1B);
    const float* RW = (const float*)(ws + WS_ROUTW) + (size_t)l * 48 * DM; const float* rc0 = (const float*)(ws + WS_ROUTC) + (l * 2 + 0) * 48; const float* rc1 = rc0 + 48;
    unsigned* cnt = (unsigned*)(ws + WS_CTL) + CW_CNT + l * 32 * 16;
    int* TOK = (int*)(ws + WS_TOK); int* ROUTE = (int*)(ws + WS_ROUTE);
    const f32x4 gg = *(const f32x4*)(pinT<false>(p, ws, I_LN1G) + l * DM + 4 * tid), bb = *(const f32x4*)(pinT<false>(p, ws, I_LN1B) + l * DM + 4 * tid);
    LAS float* PART = (LAS float*)(lds + L1_PART); LAS float* STAT = (LAS float*)(lds + L1_STAT); LAS float* LG = (LAS float*)(lds + L1_LG);
    for (int task = bid; task < NT / 16; task += G) {
        const int r0 = task * 16;
        f32x4 xr[16], wbuf[8][3];
        const float* wp = RW + (size_t)fr * DM + 256 * wave + 4 * fq;
        asm volatile("" : "+v"(wp));
#pragma unroll
        for (int s2 = 0; s2 < 8; ++s2)
#pragma unroll
            for (int n = 0; n < 3; ++n) wbuf[s2][n] = *(const f32x4*)(wp + (size_t)(16 * n) * DM + 16 * s2);
#pragma unroll
        for (int i = 0; i < 16; ++i) xr[i] = *(const f32x4*)(Y + (size_t)(r0 + i) * DM + 4 * tid);
        __syncthreads();
#pragma unroll
        for (int i = 0; i < 16; ++i) *(LAS f32x4*)(lds + i * L1_RS + tid * 16) = xr[i];
        __syncthreads();
#pragma unroll
        for (int rr = 0; rr < 2; ++rr) {
            const int row = 2 * wave + rr; float sm = 0.f, sq = 0.f;
#pragma unroll
            for (int j = 0; j < 8; ++j) { const f32x4 v = *(const LAS f32x4*)(lds + row * L1_RS + (4 * lane + 256 * j) * 4); sm += (v.x + v.y) + (v.z + v.w); sq += (v.x * v.x + v.y * v.y) + (v.z * v.z + v.w * v.w); }
            sm = wave_sum(sm); sq = wave_sum(sq);
            const float mean = sm * (1.0f / DM), var = fmaxf(sq * (1.0f / DM) - mean * mean, 0.f);
            if (lane == 0) { STAT[2 * row] = mean; STAT[2 * row + 1] = rsq_(var + EPS); }
        }
        f32x4 acc[3];
#pragma unroll
        for (int n = 0; n < 3; ++n) acc[n] = (f32x4){0.f, 0.f, 0.f, 0.f};
        const LAS unsigned char* ap = lds + fr * L1_RS + (256 * wave + 4 * fq) * 4;
#pragma unroll
        for (int hf = 0; hf < 2; ++hf) {
            if (hf == 1) {
#pragma unroll
                for (int s2 = 0; s2 < 8; ++s2)
#pragma unroll
                    for (int n = 0; n < 3; ++n) wbuf[s2][n] = *(const f32x4*)(wp + (size_t)(16 * n) * DM + 16 * (8 + s2));
            }
#pragma unroll
            for (int s2 = 0; s2 < 8; ++s2) {
                const f32x4 xa = *(const LAS f32x4*)(ap + 64 * (8 * hf + s2));
#pragma unroll
                for (int n = 0; n < 3; ++n)
#pragma unroll
                    for (int i = 0; i < 4; ++i) acc[n] = __builtin_amdgcn_mfma_f32_16x16x4f32(xa[i], wbuf[s2][n][i], acc[n], 0, 0, 0);
            }
        }
#pragma unroll
        for (int n = 0; n < 3; ++n)
#pragma unroll
            for (int i = 0; i < 4; ++i) PART[(wave * 16 + 4 * fq + i) * 48 + 16 * n + fr] = acc[n][i];
        __syncthreads();
#pragma unroll
        for (int rep = 0; rep < 2; ++rep) {
            const int pp = tid + 512 * rep;
            if (pp < 768) { const int row = pp / 48, col = pp % 48; float sacc = 0.f;
#pragma unroll
                for (int w = 0; w < 8; ++w) sacc += PART[(w * 16 + row) * 48 + col];
                LG[pp] = STAT[2 * row + 1] * (sacc - STAT[2 * row] * rc1[col]) + rc0[col]; }
        }
        __syncthreads();
        if (tid < 16) {
            const LAS float* L = LG + tid * 48; const int token = r0 + tid;
            float gm = L[0]; int gi = 0;
#pragma unroll
            for (int j = 1; j < 4; ++j) if (L[j] > gm) { gm = L[j]; gi = j; }
            float gs = 0.f;
#pragma unroll
            for (int j = 0; j < 4; ++j) gs += expf(L[j] - gm);
            const float gval = 1.0f / gs;
            const LAS float* E = L + 4 + gi * 8;
            float v1 = E[0]; int i1 = 0;
#pragma unroll
            for (int j = 1; j < 8; ++j) if (E[j] > v1) { v1 = E[j]; i1 = j; }
            float v2 = -3.0e38f; int i2 = 0;
#pragma unroll
            for (int j = 0; j < 8; ++j) if (j != i1 && E[j] > v2) { v2 = E[j]; i2 = j; }
            const float ex = expf(v2 - v1), p1 = 1.0f / (1.0f + ex), p2 = ex / (1.0f + ex);
            const int e0 = gi * 8 + i1, e1 = gi * 8 + i2;
            const int pos0 = (int)atomicAdd(cnt + e0 * 16, 1u), pos1 = (int)atomicAdd(cnt + e1 * 16, 1u);
            TOK[(size_t)e0 * NT + pos0] = token; TOK[(size_t)e1 * NT + pos1] = token;
            int* rp = ROUTE + (size_t)token * 8;
            rp[0] = e0; rp[1] = pos0; rp[2] = e1; rp[3] = pos1; rp[4] = __float_as_int(gval * p1); rp[5] = __float_as_int(gval * p2);
        }
#pragma unroll
        for (int i = 0; i < 16; ++i) {
            const float mean = STAT[2 * i], rstd = STAT[2 * i + 1];
            const f32x4 xv = *(const LAS f32x4*)(lds + i * L1_RS + tid * 16);
            const f32x4 y = (xv - mean) * rstd * gg + bb;
            *(u32x2*)(X1B + (size_t)(r0 + i) * DM + 4 * tid) = (u32x2){pk2(y.x, y.y), pk2(y.z, y.w)};
        }
    }
}

DI void moe_tables(const Params& p, LAS unsigned char* lds, int l) {
    LAS int* mc = (LAS int*)(lds + MOE_LDS_OFF); LAS int* mp = mc + 32;
    __syncthreads();
    if (threadIdx.x == 0) {
        const unsigned* cnt = (const unsigned*)(ows(p) + WS_CTL) + CW_CNT + l * 32 * 16; int acc = 0;
        for (int e = 0; e < 32; ++e) { int c = (int)__hip_atomic_load(cnt + e * 16, __ATOMIC_RELAXED, __HIP_MEMORY_SCOPE_AGENT); if (c > NT) c = NT; mc[e] = c; mp[e] = acc; acc += (c + 255) >> 8; }
        mp[32] = acc;
    }
    __syncthreads();
}
template <int NCT_SHIFT> struct MoeSched {
    const char* A; const char* Bt; const int* TOK; LAS const int* mc; LAS const int* mp; size_t bexp, btile, atile; int G, c;
    DI bool next(int i, g8::Unit& u) const {
        int rt, ct, e = 0;
        if (G == 256) {
            const int x = c & 7, slot = c >> 3, t0 = mp[4 * x], nt = mp[4 * x + 4] - t0, L = i * 32 + slot;
            if (L >= (nt << NCT_SHIFT)) return false;
            rt = t0 + (L >> NCT_SHIFT); ct = L & ((1 << NCT_SHIFT) - 1);
            e = 4 * x;
            for (int j = 4 * x + 1; j < 4 * x + 4; ++j) if (mp[j] <= rt) e = j;
        } else {
            const int L = i * G + c, T = mp[32]; if (L >= (T << NCT_SHIFT)) return false;
            rt = L >> NCT_SHIFT; ct = L & ((1 << NCT_SHIFT) - 1);
            for (int j = 1; j < 32; ++j) if (mp[j] <= rt) e = j;
        }
        u.pm = rt; u.pn = ct; u.x0 = e; u.x1 = rt - mp[e];
        u.a = A + (size_t)rt * atile; u.b = Bt + (size_t)e * bexp + (size_t)ct * btile; return true;
    }
    DI int tok(const g8::Unit& u, int R) const { const int idx = u.x1 * 256 + R; return idx < mc[u.x0] ? TOK[(size_t)u.x0 * NT + idx] : 0; }
};
struct EpiMoe1 {
    static constexpr bool PERM = true;
    bf16_t* HM;
    DI void operator()(const f32x4 (&acc)[2][2][4][2], const g8::Unit& u, int wr, int wc, int fr, int fq) const {
        const int row0 = u.pm * 256 + wr * 64 + fr, col0 = u.pn * 128 + wc * 32 + 8 * fq;
#pragma unroll
        for (int ai = 0; ai < 2; ++ai)
#pragma unroll
            for (int m = 0; m < 4; ++m) {
                float v[8];
#pragma unroll
                for (int i = 0; i < 4; ++i) { v[i] = siluf_(acc[ai][0][m][0][i]) * acc[ai][1][m][0][i]; v[4 + i] = siluf_(acc[ai][0][m][1][i]) * acc[ai][1][m][1][i]; }
                u32x4 w; w.x = pk2(v[0], v[1]); w.y = pk2(v[2], v[3]); w.z = pk2(v[4], v[5]); w.w = pk2(v[6], v[7]);
                *(u32x4*)(HM + (size_t)(row0 + ai * 128 + m * 16) * DEXP + col0) = w;
            }
    }
};
struct EpiMoe2 {
    static constexpr bool PERM = true;
    bf16_t* YB;
    DI void operator()(const f32x4 (&acc)[2][2][4][2], const g8::Unit& u, int wr, int wc, int fr, int fq) const {
        const int row0 = u.pm * 256 + wr * 64 + fr, col0 = u.pn * 256 + wc * 32 + 8 * fq;
#pragma unroll
        for (int ai = 0; ai < 2; ++ai)
#pragma unroll
            for (int m = 0; m < 4; ++m)
#pragma unroll
                for (int bj = 0; bj < 2; ++bj) {
                    const f32x4 v0 = acc[ai][bj][m][0], v1 = acc[ai][bj][m][1];
                    u32x4 w; w.x = pk2(v0[0], v0[1]); w.y = pk2(v0[2], v0[3]); w.z = pk2(v1[0], v1[1]); w.w = pk2(v1[2], v1[3]);
                    *(u32x4*)(YB + (size_t)(row0 + ai * 128 + m * 16) * DM + col0 + bj * 128) = w;
                }
    }
};
DI void phase_moe1(const Params& p, LAS unsigned char* lds, int bid, int G, int l) {
    unsigned char* ws = ows(p);
    moe_tables(p, lds, l);
    MoeSched<2> S{(const char*)(ws + WS_X1B), (const char*)(ws + WS_WGU) + (size_t)l * NEXP * 1024 * DM * 2, (const int*)(ws + WS_TOK), (LAS const int*)(lds + MOE_LDS_OFF), (LAS const int*)(lds + MOE_LDS_OFF) + 32,
                  (size_t)1024 * DM * 2, (size_t)256 * DM * 2, 0, G, bid};
    EpiMoe1 E{(bf16_t*)(ws + WS_HM)};
    g8::gemm_phase<EpiMoe1, MoeSched<2>, true>(lds, DM, DM, DM, S, E);
}
DI void phase_moe2(const Params& p, LAS unsigned char* lds, int bid, int G, int l) {
    unsigned char* ws = ows(p);
    moe_tables(p, lds, l);
    MoeSched<3> S{(const char*)(ws + WS_HM), (const char*)(ws + WS_WD) + (size_t)l * NEXP * DM * DEXP * 2, nullptr, (LAS const int*)(lds + MOE_LDS_OFF), (LAS const int*)(lds + MOE_LDS_OFF) + 32,
                  (size_t)DM * DEXP * 2, (size_t)256 * DEXP * 2, (size_t)256 * DEXP * 2, G, bid};
    EpiMoe2 E{(bf16_t*)(ws + WS_YB)};
    g8::gemm_phase<EpiMoe2, MoeSched<3>, false>(lds, DEXP, DEXP, DEXP, S, E);
}

DI void phase_ln2(const Params& p, LAS unsigned char* lds, int bid, int G, int l) {
    unsigned char* ws = ows(p);
    moe_tables(p, lds, l);
    LAS const int* mp = (LAS const int*)(lds + MOE_LDS_OFF) + 32;
    const int tid = otid(), lane = tid & 63, wave = tid >> 6;
    const bf16_t* X1B = (const bf16_t*)(ws + WS_X1B); const bf16_t* YB = (const bf16_t*)(ws + WS_YB); const int* ROUTE = (const int*)(ws + WS_ROUTE);
    const float* g = pinT<false>(p, ws, I_LN2G) + l * DM; const float* bt = pinT<false>(p, ws, I_LN2B) + l * DM;
    float* out = p.out; bf16_t* XB = (bf16_t*)(ws + WS_XB);
    for (int row = bid * 8 + wave; row < NT; row += G * 8) {
        const int* rp = ROUTE + (size_t)row * 8;
        const int e0 = rp[0], pos0 = rp[1], e1 = rp[2], pos1 = rp[3]; const float g0 = __int_as_float(rp[4]), g1 = __int_as_float(rp[5]);
        const size_t s0 = (size_t)(256 * mp[e0] + pos0), s1 = (size_t)(256 * mp[e1] + pos1);
        f32x4 v[8]; float sm = 0.f;
#pragma unroll
        for (int j = 0; j < 8; ++j) {
            const int col = 4 * lane + 256 * j;
            const u32x2 xr_ = *(const u32x2*)(X1B + (size_t)row * DM + col); const f32x4 x = {bflo(xr_.x), bfhi(xr_.x), bflo(xr_.y), bfhi(xr_.y)};
            const u32x2 a = *(const u32x2*)(YB + s0 * DM + col), b = *(const u32x2*)(YB + s1 * DM + col);
            const f32x4 ya = {bflo(a.x), bfhi(a.x), bflo(a.y), bfhi(a.y)}, yb = {bflo(b.x), bfhi(b.x), bflo(b.y), bfhi(b.y)};
            v[j] = x * ALPHA + (ya * g0 + yb * g1);
            sm += (v[j].x + v[j].y) + (v[j].z + v[j].w);
        }
        const float mean = wave_sum(sm) * (1.0f / DM); float sq = 0.f;
#pragma unroll
        for (int j = 0; j < 8; ++j) { v[j] = v[j] - mean; sq += (v[j].x * v[j].x + v[j].y * v[j].y) + (v[j].z * v[j].z + v[j].w * v[j].w); }
        const float rstd = rsq_(wave_sum(sq) * (1.0f / DM) + EPS);
#pragma unroll
        for (int j = 0; j < 8; ++j) {
            const int col = 4 * lane + 256 * j;
            const f32x4 y = v[j] * rstd * *(const f32x4*)(g + col) + *(const f32x4*)(bt + col);
            if (l == DEPTH - 1) *(f32x4*)(out + (size_t)row * DM + col) = y;
            else *(u32x2*)(XB + (size_t)row * DM + col) = (u32x2){pk2(y.x, y.y), pk2(y.z, y.w)};
        }
    }
}


#define GAS __attribute__((address_space(1)))
typedef GAS unsigned gu32;
#define XB_TMO      128
#define XB_XCNT(j)  (256  + 64 * (j))
#define XB_XSUB(j)  (1280 + 64 * (j))
#define XB_XGEN(j)  (2304 + 64 * (j))
#define XB_TOP      3328
#define XB_TOPGEN   3392
#define XCD_BAR_WORDS 3456
#define XB_SPIN_CAP (1u << 18)

__device__ __forceinline__ unsigned xb_ld(unsigned* p)              { return __hip_atomic_load(p, __ATOMIC_RELAXED, __HIP_MEMORY_SCOPE_AGENT); }
__device__ __forceinline__ unsigned xb_add(unsigned* p, unsigned v) { return __hip_atomic_fetch_add(p, v, __ATOMIC_RELAXED, __HIP_MEMORY_SCOPE_AGENT); }
__device__ __forceinline__ unsigned xb_xcc_id() { return (unsigned)__builtin_amdgcn_s_getreg((3 << 11) | 20) & 0xFu; }
#define XB_SPIN(cond, bar) do { unsigned _sp = 0; while (cond) { __builtin_amdgcn_s_sleep(1); \
    if ((++_sp & 255u) == 0u) { if (xb_ld(&(bar)[XB_TMO])) break; if (_sp > XB_SPIN_CAP) { atomicAdd(&(bar)[XB_TMO], 1u); break; } } } } while (0)

struct XcdBarrier {
    unsigned* bar; unsigned x;
    volatile LAS unsigned* st;
};

__device__ __forceinline__ XcdBarrier xcd_barrier_post(unsigned* bar, volatile LAS unsigned* st) {
    XcdBarrier b; b.bar = bar; b.x = xb_xcc_id(); b.st = st;
    if (threadIdx.x == 0) (void)xb_add(&bar[XB_XCNT(b.x)], 1u);
    return b;
}
__device__ __forceinline__ void xcd_barrier_complete(unsigned* bar, unsigned x, unsigned& nloc, unsigned& nx) {
    const unsigned G = gridDim.x * gridDim.y * gridDim.z;
    unsigned sum, cnt, mine, sp = 0u;
    for (;;) {
        sum = 0u; cnt = 0u; mine = 0u;
#pragma unroll
        for (unsigned j = 0; j < 16; ++j) { const unsigned c = xb_ld(&bar[XB_XCNT(j)]); sum += c; cnt += (c > 0u) ? 1u : 0u; mine = (j == x) ? c : mine; }
        if (sum == G) break;
        __builtin_amdgcn_s_sleep(1);
        if ((++sp & 255u) == 0u) { if (xb_ld(&bar[XB_TMO])) break; if (sp > XB_SPIN_CAP) { atomicAdd(&bar[XB_TMO], 1u); break; } }
    }
    nloc = mine > 0u ? mine : 1u; nx = cnt > 0u ? cnt : 1u;
}

__device__ __forceinline__ void xcd_barrier(const XcdBarrier& b) {
    __attribute__((address_space(1))) unsigned* barp = (__attribute__((address_space(1))) unsigned*)b.bar; asm volatile("" : "+s"(barp));
    asm volatile("s_waitcnt vmcnt(0)" ::: "memory");
    __syncthreads();
    if (threadIdx.x == 0) {
        unsigned* bar = (unsigned*)barp;
        __builtin_amdgcn_s_waitcnt(0);
        unsigned nloc = b.st[0], nx = b.st[1];
        if (nloc == 0u) { xcd_barrier_complete(bar, xb_xcc_id(), nloc, nx); b.st[0] = nloc; b.st[1] = nx; }
        const unsigned bx = xb_xcc_id();
        const unsigned old = xb_add(&bar[XB_XSUB(bx)], 1u);
        const unsigned gen = old / nloc;
        if (old + 1u == (gen + 1u) * nloc) {
            __builtin_amdgcn_fence(__ATOMIC_RELEASE, "agent");
            asm volatile("s_waitcnt vmcnt(0)" ::: "memory");
            const unsigned og = xb_add(&bar[XB_TOP], 1u);
            const unsigned tg = og / nx;
            if (og + 1u == (tg + 1u) * nx) xb_add(&bar[XB_TOPGEN], 1u);
            else XB_SPIN(xb_ld(&bar[XB_TOPGEN]) == tg, bar);
            __builtin_amdgcn_fence(__ATOMIC_ACQUIRE, "agent");
            xb_add(&bar[XB_XGEN(bx)], 1u);
            asm volatile("s_waitcnt vmcnt(0)" ::: "memory");
        } else {
            XB_SPIN(xb_ld(&bar[XB_XGEN(bx)]) == gen, bar);
            __builtin_amdgcn_fence(__ATOMIC_ACQUIRE, "agent");
            asm volatile("s_waitcnt vmcnt(0)" ::: "memory");
        }
    }
    __syncthreads();
}


constexpr int BARST_OFF = MOE_LDS_OFF + 1024;
#ifndef REP_KS
#define REP_KS 1
#endif
#ifndef REP_LN2
#define REP_LN2 1
#endif
#ifndef REP_INP
#define REP_INP 1
#endif
#ifndef REP_MOE1
#define REP_MOE1 1
#endif
__global__ void __launch_bounds__(NTHR, 2) mega_fwd(Params p) {
    extern __shared__ __attribute__((aligned(16))) unsigned char lds_[];
    LAS unsigned char* lds = (LAS unsigned char*)lds_;
    const int bid0 = blockIdx.x, G0 = gridDim.x;
    if (threadIdx.x == 0) *(LAS u32x4*)(lds + BARST_OFF) = (u32x4){0u, 0u, 0u, 0u};
    __syncthreads();
    XcdBarrier bar = xcd_barrier_post((unsigned*)(p.ws + WS_CTL) + CW_BAR, (volatile LAS unsigned*)(lds + BARST_OFF));
#define OPQ() do { bid = bid0; G = G0; asm volatile("" : "+s"(bid), "+s"(G)); } while (0)
    int bid, G; OPQ();
    phase_prologue(p, lds, bid, G);
    xcd_barrier(bar);
    for (int l = 0; l < DEPTH; ++l) {
        for (int r_ = 0; r_ < REP_INP; ++r_) { OPQ(); phase_inproj(p, lds, bid, G, l); }
        xcd_barrier(bar);
        for (int r_ = 0; r_ < REP_KS; ++r_) { OPQ(); phase_krope(p, lds, bid, G, l);
        OPQ(); phase_sgu(p, lds, bid, G, l);
        OPQ(); phase_hgrn_local(p, lds, bid, G, l); }
        __syncthreads();
        OPQ(); phase_mla_proj(p, lds, bid, G, l);
        xcd_barrier(bar);
        OPQ(); phase_attn_hgrn(p, lds, l);
        xcd_barrier(bar);
        OPQ(); phase_outproj(p, lds, bid, G, l);
        xcd_barrier(bar);
        OPQ(); phase_ln1_router(p, lds, bid, G, l);
        xcd_barrier(bar);
        for (int r_ = 0; r_ < REP_MOE1; ++r_) { OPQ(); phase_moe1(p, lds, bid, G, l); }
        xcd_barrier(bar);
        OPQ(); phase_moe2(p, lds, bid, G, l);
        xcd_barrier(bar);
        for (int r_ = 0; r_ < REP_LN2; ++r_) { OPQ(); phase_ln2(p, lds, bid, G, l); }
        xcd_barrier(bar);
    }
#undef OPQ
}

extern "C" void kernel_launch(void* const* d_in, const int* in_sizes, int n_in, void* d_out, int out_size, void* d_ws, size_t ws_size, hipStream_t stream) {
    static int grid = 0;
    if (grid == 0) {
        if (n_in != 25 || out_size != NT * DM || ws_size < WS_END) { fprintf(stderr, "kernel_launch: unexpected sizes n_in %d out %d ws %zu (need %zu)\n", n_in, out_size, ws_size, (size_t)WS_END); grid = -1; return; }
        int dev = 0, cus = 0, per_cu = 0;
        if (hipGetDevice(&dev) != hipSuccess || hipDeviceGetAttribute(&cus, hipDeviceAttributeMultiprocessorCount, dev) != hipSuccess) { grid = -1; return; }
        if (hipFuncSetAttribute((const void*)mega_fwd, hipFuncAttributeMaxDynamicSharedMemorySize, LDS_BYTES) != hipSuccess) { fprintf(stderr, "kernel_launch: hipFuncSetAttribute failed\n"); grid = -1; return; }
        if (hipOccupancyMaxActiveBlocksPerMultiprocessor(&per_cu, (const void*)mega_fwd, NTHR, LDS_BYTES) != hipSuccess || per_cu < 1) { fprintf(stderr, "kernel_launch: occupancy query says %d blocks per CU\n", per_cu); (void)hipGetLastError(); grid = -1; return; }
        grid = cus;
    }
    if (grid < 0) return;
    (void)hipMemsetAsync((char*)d_ws + WS_CTL, 0, CTL_BYTES, stream);
    Params p{};
    for (int i = 0; i < 25; ++i) p.in[i] = (const float*)d_in[i];
    p.out = (float*)d_out; p.ws = (unsigned char*)d_ws; p.layer = 0; p.pad = 0;
    hipLaunchKernelGGL(mega_fwd, dim3(grid), dim3(NTHR), LDS_BYTES, stream, p);
}
```
